# Optimizing an MI355X kernel written in HIP

```python
import jax
import jax.numpy as jnp
from jax import lax
import numpy as np

D_MODEL = 1024
BATCH = 2
SEQ = 16384
DEPTH = 2

GRID_W = 64
CTX_LEN = 256
N_BRANCH = 4
BR = 512
HD = 64
EPS = 1e-6
ROPE_BASE = 10000.0
Q_BLOCK = 128

NA_HEADS = BR // HD
NA_WIN_R = 8
NA_WIN_C = 16

RW_HS = 64
RW_HEADS = BR // RW_HS
RW_DECAY_LORA = 64
RW_AAA_LORA = 64
RW_GN_EPS = 64e-5

MLA_HEADS = 8
MLA_Q_RANK = 256
MLA_KV_RANK = 256
MLA_NOPE = 64
MLA_ROPE = 32
MLA_V = BR // MLA_HEADS

GQA_HEADS = BR // HD
GQA_KV_HEADS = 2

A_IN = 4 * BR
B_SHIFT = 3 * BR + 2 * (RW_DECAY_LORA + RW_AAA_LORA)
B_IN = B_SHIFT + BR
C_IN = MLA_Q_RANK + MLA_KV_RANK + MLA_ROPE + BR
D_IN = (GQA_HEADS + 2 * GQA_KV_HEADS) * HD + BR
N_IN = A_IN + B_IN + C_IN + D_IN

kernel_name = "hybrid_gated_natten_rwkv7_mla_gqa_block"


def split_cols(u, sizes):
    out, off = [], 0
    for s in sizes:
        out.append(u[..., off:off + s])
        off += s
    return out


def heads(t, n):
    return t.reshape(t.shape[:-1] + (n, t.shape[-1] // n))


def rmsnorm(t, g):
    t32 = t.astype(jnp.float32)
    return (t32 * lax.rsqrt(jnp.mean(t32 * t32, -1, keepdims=True) + EPS)).astype(t.dtype) * g


def axial_rope_tables(n_tok, d_rot):
    t = jnp.arange(n_tok)
    row = (t // GRID_W).astype(jnp.float32)
    col = (t % GRID_W).astype(jnp.float32)
    n_freq = d_rot // 4
    inv = ROPE_BASE ** (-jnp.arange(n_freq, dtype=jnp.float32) / n_freq)
    ang = jnp.concatenate([row[:, None] * inv, col[:, None] * inv], -1)
    return jnp.cos(ang), jnp.sin(ang)


def apply_rope(t, cos, sin):
    half = t.shape[-1] // 2
    t1, t2 = t[..., :half], t[..., half:]
    c, s = cos[:, None, :], sin[:, None, :]
    return jnp.concatenate([t1 * c - t2 * s, t1 * s + t2 * c], -1).astype(t.dtype)


def rope_tail(t, cos, sin, n):
    return jnp.concatenate([t[..., :-n], apply_rope(t[..., -n:], cos, sin)], -1)


def attend(q, k, v, scale):
    s = jnp.einsum('btgrd,bngd->bgrtn', q, k).astype(jnp.float32) * scale
    p = jax.nn.softmax(s, axis=-1).astype(v.dtype)
    o = jnp.einsum('bgrtn,bngd->btgrd', p, v)
    return o.reshape(o.shape[:2] + (-1,))


def attend_blocked(q, k, v, scale):
    b, t = q.shape[:2]
    qb = jnp.moveaxis(q.reshape((b, t // Q_BLOCK, Q_BLOCK) + q.shape[2:]), 1, 0)
    o = lax.map(lambda qi: attend(qi, k, v, scale), qb)
    return jnp.moveaxis(o, 0, 1).reshape(b, t, -1)


def neighbourhood_attention(q, k, v, k_ctx, v_ctx, rpb):
    b, n_tok, nh, d = q.shape
    rows = n_tok // GRID_W
    kr = min(NA_WIN_R, rows)
    kc = NA_WIN_C
    n_win = kr * kc
    qg = q.reshape(b, rows, GRID_W, nh, d)
    kg = k.reshape(b, rows, GRID_W, nh, d)
    vg = v.reshape(b, rows, GRID_W, nh, d)
    cols = np.arange(GRID_W)
    col_idx = np.clip(cols - kc // 2, 0, GRID_W - kc)[:, None] + np.arange(kc)[None, :]
    dc_idx = col_idx - cols[:, None] + (NA_WIN_C - 1)
    scale = d ** -0.5

    def one_row(r):
        rs = jnp.clip(r - kr // 2, 0, rows - kr)
        k_win = lax.dynamic_slice_in_dim(kg, rs, kr, axis=1)[:, :, col_idx]
        v_win = lax.dynamic_slice_in_dim(vg, rs, kr, axis=1)[:, :, col_idx]
        q_row = lax.dynamic_index_in_dim(qg, r, axis=1, keepdims=False)
        dr_idx = rs + jnp.arange(kr) - r + (NA_WIN_R - 1)
        bias = rpb[:, dr_idx[None, :, None], dc_idx[:, None, :]]
        s_win = jnp.einsum('bqhd,brqchd->bhqrc', q_row, k_win).astype(jnp.float32) * scale + bias
        s_ctx = jnp.einsum('bqhd,bnhd->bhqn', q_row, k_ctx).astype(jnp.float32) * scale
        s = jnp.concatenate([s_win.reshape(b, nh, GRID_W, n_win), s_ctx], -1)
        p = jax.nn.softmax(s, axis=-1).astype(v.dtype)
        p_win = p[..., :n_win].reshape(b, nh, GRID_W, kr, kc)
        return (jnp.einsum('bhqrc,brqchd->bqhd', p_win, v_win)
                + jnp.einsum('bhqn,bnhd->bqhd', p[..., n_win:], v_ctx))

    o = lax.map(one_row, jnp.arange(rows))
    return jnp.moveaxis(o, 0, 1).reshape(b, n_tok, nh * d)


def mixer_neigh(p, pc, q_g, k_g, rpb, need_ctx):
    q, k, v, g = split_cols(p, (BR,) * 4)
    qc, kc, vc, gc = split_cols(pc, (BR,) * 4)
    k_ctx = rmsnorm(heads(kc, NA_HEADS), k_g)
    v_ctx = heads(vc, NA_HEADS)
    y = neighbourhood_attention(rmsnorm(heads(q, NA_HEADS), q_g), rmsnorm(heads(k, NA_HEADS), k_g),
                                heads(v, NA_HEADS), k_ctx, v_ctx, rpb) * jax.nn.silu(g)
    y_c = None
    if need_ctx:
        qh = rmsnorm(heads(qc, NA_HEADS), q_g)[:, :, :, None, :]
        y_c = attend(qh, k_ctx, v_ctx, HD ** -0.5) * jax.nn.silu(gc)
    return y, y_c


def centred_shift(u):
    pad = jnp.pad(u, ((0, 0), (1, 1), (0, 0)))
    return 0.5 * (pad[:, :-2] + pad[:, 2:])


def rwkv_prep(p, mu, w0, w2, a0, a2, k_k, k_a):
    u, g = p[..., :B_SHIFT], p[..., B_SHIFT:]
    u = (u + mu * (centred_shift(u) - u)).astype(jnp.float32)
    r, k, v, wl, al = split_cols(u, (BR, BR, BR, 2 * RW_DECAY_LORA, 2 * RW_AAA_LORA))
    kk = heads(k * k_k, RW_HEADS)
    kk = (kk * lax.rsqrt(jnp.sum(kk * kk, -1, keepdims=True) + 1e-12)).reshape(k.shape)
    dirs = []
    for d in range(2):
        wl_d = wl[..., d * RW_DECAY_LORA:(d + 1) * RW_DECAY_LORA]
        al_d = al[..., d * RW_AAA_LORA:(d + 1) * RW_AAA_LORA]
        w_log = -jax.nn.softplus(-(w0[d] + jnp.tanh(wl_d) @ w2[d])) - 0.5
        a = jax.nn.sigmoid(a0[d] + al_d @ a2[d])
        dirs.append((jnp.exp(-jnp.exp(w_log)), k * (1.0 + (a - 1.0) * k_a), kk * a))
    return r, v, kk, dirs, g


def rwkv7_scan(r, w, k, v, a, b, s0, readout):
    def step(state, inp):
        w_t, k_t, v_t, a_t, b_t = inp[:5]
        sa = jnp.einsum('bhij,bhj->bhi', state, a_t)
        state = (state * w_t[:, :, None, :] + sa[..., None] * b_t[:, :, None, :]
                 + v_t[..., None] * k_t[:, :, None, :])
        y = jnp.einsum('bhij,bhj->bhi', state, inp[5]) if readout else None
        return state, y
    seqs = (w, k, v, a, b) + ((r,) if readout else ())
    s_fin, ys = lax.scan(step, s0, tuple(jnp.moveaxis(t, 1, 0) for t in seqs))
    return (jnp.moveaxis(ys, 0, 1) if readout else None), s_fin


def head_groupnorm(y, w, b):
    mean = jnp.mean(y, -1, keepdims=True)
    var = jnp.mean((y - mean) ** 2, -1, keepdims=True)
    yn = (y - mean) * lax.rsqrt(var + RW_GN_EPS)
    return yn.reshape(y.shape[:-2] + (-1,)) * w + b


def mixer_rwkv(p, pc, mu, w0, w2, a0, a2, k_k, k_a, r_k, gn_w, gn_b, need_ctx):
    lat = rwkv_prep(p, mu, w0, w2, a0, a2, k_k, k_a)
    cxt = rwkv_prep(pc, mu, w0, w2, a0, a2, k_k, k_a)

    def run(parts, d, s0, readout):
        r, v, kk, dirs, _ = parts
        decay, k_d, b_d = dirs[d]
        ts = [heads(t, RW_HEADS) for t in (r, decay, k_d, v, -kk, b_d)]
        if d == 1:
            ts = [jnp.flip(t, 1) for t in ts]
        y, s_fin = rwkv7_scan(*ts, s0, readout)
        if readout and d == 1:
            y = jnp.flip(y, 1)
        return y, s_fin

    def finish(parts, y_sum):
        r, v, kk, dirs, g = parts
        rh = heads(r, RW_HEADS)
        k_sum = heads(dirs[0][1] + dirs[1][1], RW_HEADS)
        bonus = jnp.sum(rh * k_sum * r_k, -1, keepdims=True) * heads(v, RW_HEADS)
        y = head_groupnorm(y_sum, gn_w, gn_b) + bonus.reshape(r.shape)
        return y.astype(g.dtype) * jax.nn.silu(g)

    s0 = jnp.zeros((p.shape[0], RW_HEADS, RW_HS, RW_HS), jnp.float32)
    y_lat, y_ctx = 0.0, 0.0
    for d in range(2):
        yc, s_c = run(cxt, d, s0, need_ctx)
        yl, _ = run(lat, d, s_c, True)
        y_lat = y_lat + yl
        if need_ctx:
            y_ctx = y_ctx + yc
    return finish(lat, y_lat), (finish(cxt, y_ctx) if need_ctx else None)


def mla_project(p, qa_g, kva_g, wuq, wukv, q_g, k_g, rope, want_q):
    cq, ckv, kr, g = split_cols(p, (MLA_Q_RANK, MLA_KV_RANK, MLA_ROPE, BR))
    kv = heads(rmsnorm(ckv, kva_g) @ wukv, MLA_HEADS)
    k_nope, v = kv[..., :MLA_NOPE], kv[..., MLA_NOPE:]
    k_pe = jnp.broadcast_to(kr[..., None, :], k_nope.shape[:-1] + (MLA_ROPE,))
    k = rmsnorm(jnp.concatenate([k_nope, k_pe], -1), k_g)
    q = rmsnorm(heads(rmsnorm(cq, qa_g) @ wuq, MLA_HEADS), q_g) if want_q else None
    if rope is not None:
        k = rope_tail(k, rope[0], rope[1], MLA_ROPE)
        q = rope_tail(q, rope[0], rope[1], MLA_ROPE) if want_q else None
    return q, k, v, g


def mixer_mla(p, pc, qa_g, kva_g, wuq, wukv, q_g, k_g, rope, need_ctx):
    q, k, v, g = mla_project(p, qa_g, kva_g, wuq, wukv, q_g, k_g, rope, True)
    qc, kc, vc, gc = mla_project(pc, qa_g, kva_g, wuq, wukv, q_g, k_g, None, need_ctx)
    scale = (MLA_NOPE + MLA_ROPE) ** -0.5
    k_all = jnp.concatenate([kc, k], 1)
    v_all = jnp.concatenate([vc, v], 1)
    y = attend_blocked(q[:, :, :, None], k_all, v_all, scale) * jax.nn.silu(g)
    y_c = attend(qc[:, :, :, None], kc, vc, scale) * jax.nn.silu(gc) if need_ctx else None
    return y, y_c


def gqa_project(p, q_g, k_g, rope, want_q):
    q, k, v, g = split_cols(p, (GQA_HEADS * HD, GQA_KV_HEADS * HD, GQA_KV_HEADS * HD, BR))
    k = rmsnorm(heads(k, GQA_KV_HEADS), k_g)
    v = heads(v, GQA_KV_HEADS)
    q = rmsnorm(heads(q, GQA_HEADS), q_g) if want_q else None
    if rope is not None:
        k = apply_rope(k, rope[0], rope[1])
        q = apply_rope(q, rope[0], rope[1]) if want_q else None
    if want_q:
        q = q.reshape(q.shape[:2] + (GQA_KV_HEADS, GQA_HEADS // GQA_KV_HEADS, HD))
    return q, k, v, g


def mixer_gqa(p, pc, q_g, k_g, rope, need_ctx):
    q, k, v, g = gqa_project(p, q_g, k_g, rope, True)
    qc, kc, vc, gc = gqa_project(pc, q_g, k_g, None, need_ctx)
    scale = HD ** -0.5
    y = attend_blocked(q, jnp.concatenate([kc, k], 1), jnp.concatenate([vc, v], 1), scale) * jax.nn.silu(g)
    y_c = attend(qc, kc, vc, scale) * jax.nn.silu(gc) if need_ctx else None
    return y, y_c


def merge_branches(h, ys, mg_w, mg_b, w_br, w_out):
    acc = None
    for i in range(N_BRANCH):
        term = jax.nn.sigmoid(h @ mg_w[i] + mg_b[i]) * (ys[i] @ w_br[i])
        acc = term if acc is None else acc + term
    return acc @ w_out


def setup_inputs(seed: int = 0) -> dict:
    key = jax.random.key(seed)
    ks = iter(jax.random.split(key, 48))
    L, D = DEPTH, D_MODEL

    def nrm(shape, s):
        return jax.random.normal(next(ks), shape, jnp.float32) * s

    def gain(shape):
        return 1.0 + nrm(shape, 0.02)

    return {
        "x": nrm((BATCH, SEQ, D), 1.0),
        "c": nrm((BATCH, D), 1.0),
        "ctx": nrm((BATCH, CTX_LEN, D), 1.0),
        "c_ctx": nrm((D,), 1.0),
        "norm_g": gain((L, D)),
        "mod_w": nrm((L, D, 3 * D), 0.5 * D ** -0.5),
        "mod_b": nrm((L, 3 * D), 0.02),
        "w_in": nrm((L, D, N_IN), D ** -0.5),
        "na_qg": gain((L, HD)),
        "na_kg": gain((L, HD)),
        "na_rpb": nrm((L, NA_HEADS, 2 * NA_WIN_R - 1, 2 * NA_WIN_C - 1), 0.1),
        "rw_mu": jax.random.uniform(next(ks), (L, B_SHIFT), jnp.float32, 0.0, 1.0),
        "rw_w0": jax.random.uniform(next(ks), (L, 2, BR), jnp.float32, -6.0, 1.0),
        "rw_w2": nrm((L, 2, RW_DECAY_LORA, BR), 0.1 * RW_DECAY_LORA ** -0.5),
        "rw_a0": nrm((L, 2, BR), 0.5),
        "rw_a2": nrm((L, 2, RW_AAA_LORA, BR), 0.1 * RW_AAA_LORA ** -0.5),
        "rw_kk": 0.85 + nrm((L, BR), 0.02),
        "rw_ka": gain((L, BR)),
        "rw_rk": nrm((L, RW_HEADS, RW_HS), 0.1),
        "rw_gn_w": gain((L, BR)),
        "rw_gn_b": nrm((L, BR), 0.02),
        "mla_qa_g": gain((L, MLA_Q_RANK)),
        "mla_kva_g": gain((L, MLA_KV_RANK)),
        "mla_wuq": nrm((L, MLA_Q_RANK, MLA_HEADS * (MLA_NOPE + MLA_ROPE)), MLA_Q_RANK ** -0.5),
        "mla_wukv": nrm((L, MLA_KV_RANK, MLA_HEADS * (MLA_NOPE + MLA_V)), MLA_KV_RANK ** -0.5),
        "mla_qg": gain((L, MLA_NOPE + MLA_ROPE)),
        "mla_kg": gain((L, MLA_NOPE + MLA_ROPE)),
        "gqa_qg": gain((L, HD)),
        "gqa_kg": gain((L, HD)),
        "mg_w": nrm((L, N_BRANCH, D, D), D ** -0.5),
        "mg_b": nrm((L, N_BRANCH, D), 0.02),
        "w_br": nrm((L, N_BRANCH, BR, D), BR ** -0.5),
        "w_out": nrm((L, D, D), D ** -0.5),
    }


def reference(x, c, ctx, c_ctx, norm_g, mod_w, mod_b, w_in,
              na_qg, na_kg, na_rpb,
              rw_mu, rw_w0, rw_w2, rw_a0, rw_a2, rw_kk, rw_ka, rw_rk, rw_gn_w, rw_gn_b,
              mla_qa_g, mla_kva_g, mla_wuq, mla_wukv, mla_qg, mla_kg,
              gqa_qg, gqa_kg,
              mg_w, mg_b, w_br, w_out):
    n_tok = x.shape[1]
    rope_hd = axial_rope_tables(n_tok, HD)
    rope_mla = axial_rope_tables(n_tok, MLA_ROPE)
    cx = ctx
    for l in range(DEPTH):
        need_ctx = l < DEPTH - 1
        sh, sc, gt = jnp.split(jax.nn.silu(c) @ mod_w[l] + mod_b[l], 3, axis=-1)
        sh_c, sc_c, gt_c = jnp.split(jax.nn.silu(c_ctx) @ mod_w[l] + mod_b[l], 3, axis=-1)
        h = rmsnorm(x, norm_g[l]) * (1.0 + sc[:, None]) + sh[:, None]
        hc = rmsnorm(cx, norm_g[l]) * (1.0 + sc_c) + sh_c
        pa, pb, pm, pd = split_cols(h @ w_in[l], (A_IN, B_IN, C_IN, D_IN))
        pa_c, pb_c, pm_c, pd_c = split_cols(hc @ w_in[l], (A_IN, B_IN, C_IN, D_IN))

        ya, ya_c = mixer_neigh(pa, pa_c, na_qg[l], na_kg[l], na_rpb[l], need_ctx)
        yb, yb_c = mixer_rwkv(pb, pb_c, rw_mu[l], rw_w0[l], rw_w2[l], rw_a0[l], rw_a2[l],
                              rw_kk[l], rw_ka[l], rw_rk[l], rw_gn_w[l], rw_gn_b[l], need_ctx)
        yc, yc_c = mixer_mla(pm, pm_c, mla_qa_g[l], mla_kva_g[l], mla_wuq[l], mla_wukv[l],
                             mla_qg[l], mla_kg[l], rope_mla, need_ctx)
        yd, yd_c = mixer_gqa(pd, pd_c, gqa_qg[l], gqa_kg[l], rope_hd, need_ctx)

        x = x + gt[:, None] * merge_branches(h, (ya, yb, yc, yd), mg_w[l], mg_b[l], w_br[l], w_out[l])
        if need_ctx:
            cx = cx + gt_c * merge_branches(hc, (ya_c, yb_c, yc_c, yd_c), mg_w[l], mg_b[l], w_br[l], w_out[l])
    return x
```

```cpp
#include <hip/hip_runtime.h>
#include <hip/hip_cooperative_groups.h>
#include <cstdio>
namespace cg = cooperative_groups;

#ifndef ONLY
#define ONLY (-1)
#endif
#define PH_ON(x) (ONLY < 0 || ONLY == (x))
#ifndef MULTI
#define MULTI 0
#endif

typedef unsigned short bf16_t;
typedef __attribute__((ext_vector_type(8))) short bf16x8;
typedef __attribute__((ext_vector_type(16))) float f32x16;
#define DI __device__ __forceinline__
#define MFMA32(a, b, c) __builtin_amdgcn_mfma_f32_32x32x16_bf16((a), (b), (c), 0, 0, 0)

#define DM 1024
#define SEQ 16384
#define CTXL 256
#define TR 16640
#define LDP 6688
#define NPAD 6784
#define A_Q 0
#define A_K 512
#define A_V 1024
#define A_G 1536
#define B_U 2048
#define B_G 3840
#define C_CQ 4352
#define C_CKV 4608
#define C_KR 4864
#define C_G 4896
#define D_Q 5408
#define D_K 5920
#define D_V 6048
#define D_G 6176
#define LOG2E 1.4426950408889634f
#define SC64 (0.125f * LOG2E)
#define SC96 (0.10206207261596575f * LOG2E)

constexpr size_t SZ_WINT = (size_t)2 * NPAD * 1024 * 2;
constexpr size_t SZ_MGT = (size_t)2 * 4 * 1024 * 1024 * 2;
constexpr size_t SZ_BRT = (size_t)2 * 4 * 1024 * 512 * 2;
constexpr size_t SZ_OUTT = (size_t)2 * 1024 * 1024 * 2;
constexpr size_t SZ_WUQT = (size_t)2 * 768 * 256 * 2;
constexpr size_t SZ_WUKVT = (size_t)2 * 1024 * 256 * 2;
constexpr size_t SZ_MODV = (size_t)2 * 3 * 3072 * 4;
constexpr size_t SZ_ROPE = (size_t)SEQ * 96 * 4;
constexpr size_t SZ_CX1 = (size_t)2 * 256 * 1024 * 4;
constexpr size_t SZ_CTR = 256;
constexpr size_t SZ_H = (size_t)TR * 1024 * 2;
constexpr size_t SZ_P = (size_t)TR * LDP * 2;
constexpr size_t SZ_VTA = (size_t)8 * 64 * TR * 2;
constexpr size_t SZ_VTD = (size_t)2 * 64 * TR * 2;
constexpr size_t SZ_QM = (size_t)TR * 768 * 2;
constexpr size_t SZ_KVRAW = (size_t)TR * 1024 * 2;
constexpr size_t SZ_KM = (size_t)TR * 768 * 2;
constexpr size_t SZ_VTM = (size_t)8 * 64 * TR * 2;
constexpr size_t SZ_Y = (size_t)TR * 512 * 2;
constexpr size_t SZ_CB = (size_t)2 * TR * 8 * 4;

constexpr size_t OFF_WINT = 0;
constexpr size_t OFF_MGT = OFF_WINT + SZ_WINT;
constexpr size_t OFF_BRT = OFF_MGT + SZ_MGT;
constexpr size_t OFF_OUTT = OFF_BRT + SZ_BRT;
constexpr size_t OFF_WUQT = OFF_OUTT + SZ_OUTT;
constexpr size_t OFF_WUKVT = OFF_WUQT + SZ_WUQT;
constexpr size_t OFF_MODV = OFF_WUKVT + SZ_WUKVT;
constexpr size_t OFF_ROPE = OFF_MODV + SZ_MODV;
constexpr size_t OFF_CX1 = OFF_ROPE + SZ_ROPE;
constexpr size_t OFF_CTR = OFF_CX1 + SZ_CX1;
constexpr size_t OFF_H = OFF_CTR + SZ_CTR;
constexpr size_t OFF_P = OFF_H + SZ_H;
constexpr size_t OFF_VTA = OFF_P + SZ_P;
constexpr size_t OFF_VTD = OFF_VTA + SZ_VTA;
constexpr size_t OFF_QM = OFF_VTD + SZ_VTD;
constexpr size_t OFF_KVRAW = OFF_QM + SZ_QM;
constexpr size_t OFF_KM = OFF_KVRAW + SZ_KVRAW;
constexpr size_t OFF_VTM = OFF_KM + SZ_KM;
constexpr size_t OFF_Y0 = OFF_VTM + SZ_VTM;
constexpr size_t OFF_Y1 = OFF_Y0 + SZ_Y;
constexpr size_t OFF_CB = OFF_Y1 + SZ_Y;
constexpr size_t OFF_END = OFF_CB + SZ_CB;
constexpr size_t OFF_ACC = OFF_QM;

struct Params {
  const float* in[33];
  float* out;
  char* ws;
};
enum { I_X = 0, I_C, I_CTX, I_CCTX, I_NORMG, I_MODW, I_MODB, I_WIN, I_NAQG, I_NAKG, I_NARPB, I_RWMU, I_RWW0, I_RWW2,
       I_RWA0, I_RWA2, I_RWKK, I_RWKA, I_RWRK, I_RWGNW, I_RWGNB, I_MLAQAG, I_MLAKVAG, I_MLAWUQ, I_MLAWUKV, I_MLAQG,
       I_MLAKG, I_GQAQG, I_GQAKG, I_MGW, I_MGB, I_WBR, I_WOUT };

DI int get_tid() { int t = threadIdx.x; asm volatile("" : "+v"(t)); return t; }
DI int get_bid() { int b = blockIdx.x; asm volatile("" : "+s"(b)); return b; }
DI bf16_t f2bf(float x) { unsigned u = __float_as_uint(x); u += 0x7fffu + ((u >> 16) & 1u); return (bf16_t)(u >> 16); }
DI float bf2f(bf16_t b) { return __uint_as_float(((unsigned)b) << 16); }
DI unsigned pack2(float a, float b) { return (unsigned)f2bf(a) | ((unsigned)f2bf(b) << 16); }
DI float lo2f(unsigned u) { return __uint_as_float(u << 16); }
DI float hi2f(unsigned u) { return __uint_as_float(u & 0xffff0000u); }
DI void unpack8(const uint4& v, float* x) {
  x[0] = lo2f(v.x); x[1] = hi2f(v.x); x[2] = lo2f(v.y); x[3] = hi2f(v.y);
  x[4] = lo2f(v.z); x[5] = hi2f(v.z); x[6] = lo2f(v.w); x[7] = hi2f(v.w);
}
DI uint4 pack8(const float* x) {
  uint4 v; v.x = pack2(x[0], x[1]); v.y = pack2(x[2], x[3]); v.z = pack2(x[4], x[5]); v.w = pack2(x[6], x[7]); return v;
}
DI void unpack4(const uint2& v, float* x) { x[0] = lo2f(v.x); x[1] = hi2f(v.x); x[2] = lo2f(v.y); x[3] = hi2f(v.y); }
DI uint2 pack4(const float* x) { uint2 v; v.x = pack2(x[0], x[1]); v.y = pack2(x[2], x[3]); return v; }
DI float red8(float v) { v += __shfl_xor(v, 1); v += __shfl_xor(v, 2); v += __shfl_xor(v, 4); return v; }
DI float red32(float v) { v = red8(v); v += __shfl_xor(v, 8); v += __shfl_xor(v, 16); return v; }
DI float red64(float v) { v = red32(v); v += __shfl_xor(v, 32); return v; }
DI float sigmoidf_(float x) { return 1.f / (1.f + __expf(-x)); }
DI float siluf_(float x) { return x / (1.f + __expf(-x)); }
DI int crow(int e, int h) { return (e & 3) + 8 * (e >> 2) + 4 * h; }
DI f32x16 zero16() { f32x16 z; for (int i = 0; i < 16; ++i) z[i] = 0.f; return z; }

template <int NJ>
DI void gemm_core(const bf16_t* __restrict__ A, int lda, const bf16_t* __restrict__ Bt, int ldb, int K,
                  f32x16 (&acc)[2][NJ], char* smem) {
  const int tid = get_tid(), lane = tid & 63, w = tid >> 6, r = lane & 31, h = lane >> 5;
  const int wm = w >> 1, wn = w & 1;
  bf16_t* As = (bf16_t*)smem;
  bf16_t* Bs = As + 2 * 256 * 72;
  uint4 ra[4], rb[NJ];
  const int nk = K >> 6;
  const bf16_t* Ag = A + (size_t)(tid >> 3) * lda + (tid & 7) * 8;
  const bf16_t* Bg = Bt + (size_t)(tid >> 3) * ldb + (tid & 7) * 8;
  bf16_t* Asw = As + (tid >> 3) * 72 + (tid & 7) * 8;
  bf16_t* Bsw = Bs + (tid >> 3) * 72 + (tid & 7) * 8;
  __syncthreads();
#pragma unroll
  for (int i = 0; i < 4; ++i) ra[i] = *(const uint4*)(Ag + (size_t)(64 * i) * lda);
#pragma unroll
  for (int i = 0; i < NJ; ++i) rb[i] = *(const uint4*)(Bg + (size_t)(64 * i) * ldb);
#pragma unroll
  for (int i = 0; i < 4; ++i) *(uint4*)(Asw + 64 * i * 72) = ra[i];
#pragma unroll
  for (int i = 0; i < NJ; ++i) *(uint4*)(Bsw + 64 * i * 72) = rb[i];
  __syncthreads();
  for (int kt = 0; kt < nk; ++kt) {
    const int buf = kt & 1;
    if (kt + 1 < nk) {
      const int ko = (kt + 1) * 64;
#pragma unroll
      for (int i = 0; i < 4; ++i) ra[i] = *(const uint4*)(Ag + (size_t)(64 * i) * lda + ko);
#pragma unroll
      for (int i = 0; i < NJ; ++i) rb[i] = *(const uint4*)(Bg + (size_t)(64 * i) * ldb + ko);
    }
    const bf16_t* Ab = As + (buf * 256 + 64 * wm + r) * 72 + h * 8;
    const bf16_t* Bb = Bs + (buf * 64 * NJ + 32 * NJ * wn + r) * 72 + h * 8;
#pragma unroll
    for (int ks = 0; ks < 4; ++ks) {
      bf16x8 a0 = *(const bf16x8*)(Ab + ks * 16);
      bf16x8 a1 = *(const bf16x8*)(Ab + 32 * 72 + ks * 16);
#pragma unroll
      for (int j = 0; j < NJ; ++j) {
        bf16x8 b0 = *(const bf16x8*)(Bb + j * 32 * 72 + ks * 16);
        acc[0][j] = MFMA32(a0, b0, acc[0][j]);
        acc[1][j] = MFMA32(a1, b0, acc[1][j]);
      }
    }
    if (kt + 1 < nk) {
      const int nb = buf ^ 1;
#pragma unroll
      for (int i = 0; i < 4; ++i) *(uint4*)(Asw + (nb * 256 + 64 * i) * 72) = ra[i];
#pragma unroll
      for (int i = 0; i < NJ; ++i) *(uint4*)(Bsw + (nb * 64 * NJ + 64 * i) * 72) = rb[i];
    }
    __syncthreads();
  }
}

template <int NJ>
DI void store_tile_bf16(const f32x16 (&acc)[2][NJ], bf16_t* dst, int ld, int ncols) {
  const int tid = get_tid(), lane = tid & 63, w = tid >> 6, r = lane & 31, h = lane >> 5;
  const int wm = w >> 1, wn = w & 1;
#pragma unroll
  for (int i = 0; i < 2; ++i)
#pragma unroll
    for (int j = 0; j < NJ; ++j) {
      const int col = 32 * NJ * wn + 32 * j + r;
      if (col < ncols) {
        bf16_t* d0 = dst + (size_t)(64 * wm + 32 * i + 4 * h) * ld + col;
#pragma unroll
        for (int e = 0; e < 16; ++e) d0[(size_t)((e & 3) + 8 * (e >> 2)) * ld] = f2bf(acc[i][j][e]);
      }
    }
}

DI void transpose_job(const float* __restrict__ src, int K, int N, bf16_t* __restrict__ dst, int Npad, char* smem) {
  float* tS = (float*)smem;
  const int tid = get_tid();
  const int ntk = K >> 6, ntn = Npad >> 6;
  for (int tile = get_bid(); tile < ntk * ntn; tile += gridDim.x) {
    const int kt = tile % ntk, nt = tile / ntk;
    __syncthreads();
    {
      const int kk = tid >> 3, c8 = (tid & 7) * 8;
      const int col = nt * 64 + c8;
      float v[8];
      if (col < N) {
        const float4 a = *(const float4*)(src + (size_t)(kt * 64 + kk) * N + col);
        const float4 b = *(const float4*)(src + (size_t)(kt * 64 + kk) * N + col + 4);
        v[0] = a.x; v[1] = a.y; v[2] = a.z; v[3] = a.w; v[4] = b.x; v[5] = b.y; v[6] = b.z; v[7] = b.w;
      } else {
#pragma unroll
        for (int e = 0; e < 8; ++e) v[e] = 0.f;
      }
#pragma unroll
      for (int e = 0; e < 8; ++e) tS[kk * 65 + c8 + e] = v[e];
    }
    __syncthreads();
    {
      const int n = tid >> 3, k8 = (tid & 7) * 8;
      float v[8];
#pragma unroll
      for (int e = 0; e < 8; ++e) v[e] = tS[(k8 + e) * 65 + n];
      *(uint4*)(dst + (size_t)(nt * 64 + n) * K + kt * 64 + k8) = pack8(v);
    }
  }
}

DI void phase_prep(const Params& p, char* smem) {
  const int tid = get_tid();
  char* ws = p.ws;
  if (get_bid() == 0 && tid < 64) ((int*)(ws + OFF_CTR))[tid] = 0;
  for (int l = 0; l < 2; ++l) {
    transpose_job(p.in[I_WIN] + (size_t)l * 1024 * LDP, 1024, LDP, (bf16_t*)(ws + OFF_WINT) + (size_t)l * NPAD * 1024, NPAD, smem);
    for (int i = 0; i < 4; ++i) {
      transpose_job(p.in[I_MGW] + (size_t)(l * 4 + i) * 1024 * 1024, 1024, 1024, (bf16_t*)(ws + OFF_MGT) + (size_t)(l * 4 + i) * 1024 * 1024, 1024, smem);
      transpose_job(p.in[I_WBR] + (size_t)(l * 4 + i) * 512 * 1024, 512, 1024, (bf16_t*)(ws + OFF_BRT) + (size_t)(l * 4 + i) * 1024 * 512, 1024, smem);
    }
    transpose_job(p.in[I_WOUT] + (size_t)l * 1024 * 1024, 1024, 1024, (bf16_t*)(ws + OFF_OUTT) + (size_t)l * 1024 * 1024, 1024, smem);
    transpose_job(p.in[I_MLAWUQ] + (size_t)l * 256 * 768, 256, 768, (bf16_t*)(ws + OFF_WUQT) + (size_t)l * 768 * 256, 768, smem);
    transpose_job(p.in[I_MLAWUKV] + (size_t)l * 256 * 1024, 256, 1024, (bf16_t*)(ws + OFF_WUKVT) + (size_t)l * 1024 * 256, 1024, smem);
  }
  {
    float* sv = (float*)smem;
    float* red = sv + 3 * 1024;
    float* modv = (float*)(ws + OFF_MODV);
    for (int job = get_bid(); job < 96; job += gridDim.x) {
      const int l = job / 48, cg0 = (job % 48) * 64;
      __syncthreads();
      for (int i = tid; i < 3072; i += 512) {
        const int rr = i >> 10, k = i & 1023;
        const float cv = (rr < 2) ? p.in[I_C][rr * 1024 + k] : p.in[I_CCTX][k];
        sv[i] = siluf_(cv);
      }
      __syncthreads();
      const int cl = tid & 63, ks = tid >> 6;
      float a0 = 0.f, a1 = 0.f, a2 = 0.f;
      const float* mw = p.in[I_MODW] + (size_t)l * 1024 * 3072 + cg0 + cl;
      for (int k = ks * 128; k < ks * 128 + 128; ++k) {
        const float wv = mw[(size_t)k * 3072];
        a0 += sv[k] * wv; a1 += sv[1024 + k] * wv; a2 += sv[2048 + k] * wv;
      }
      red[(ks * 3 + 0) * 64 + cl] = a0; red[(ks * 3 + 1) * 64 + cl] = a1; red[(ks * 3 + 2) * 64 + cl] = a2;
      __syncthreads();
      if (tid < 192) {
        const int rr = tid >> 6, c = tid & 63;
        float s = 0.f;
        for (int q = 0; q < 8; ++q) s += red[(q * 3 + rr) * 64 + c];
        modv[(l * 3 + rr) * 3072 + cg0 + c] = s + p.in[I_MODB][l * 3072 + cg0 + c];
      }
    }
  }
  {
    float* cosH = (float*)(ws + OFF_ROPE);
    float* sinH = cosH + SEQ * 32;
    float* cosM = sinH + SEQ * 32;
    float* sinM = cosM + SEQ * 16;
    for (int idx = get_bid() * 512 + tid; idx < SEQ * 48; idx += gridDim.x * 512) {
      if (idx < SEQ * 32) {
        const int t = idx >> 5, i = idx & 31, f = i & 15;
        const float pos = (i < 16) ? (float)(t >> 6) : (float)(t & 63);
        const float inv = exp2f(-(float)f * (13.287712379549449f / 16.f));
        const float ang = pos * inv;
        cosH[idx] = cosf(ang); sinH[idx] = sinf(ang);
      } else {
        const int j = idx - SEQ * 32;
        const int t = j >> 4, i = j & 15, f = i & 7;
        const float pos = (i < 8) ? (float)(t >> 6) : (float)(t & 63);
        const float inv = exp2f(-(float)f * (13.287712379549449f / 8.f));
        const float ang = pos * inv;
        cosM[j] = cosf(ang); sinM[j] = sinf(ang);
      }
    }
  }
}

DI void phase_h(const Params& p, int l, int b) {
  const int tid = get_tid(), lane = tid & 63, w = tid >> 6;
  const float* xin = (l == 0) ? p.in[I_X] : p.out;
  const float* cin = (l == 0) ? p.in[I_CTX] : (const float*)(p.ws + OFF_CX1);
  const float* ng = p.in[I_NORMG] + l * 1024;
  const float* modv = (const float*)(p.ws + OFF_MODV);
  bf16_t* H = (bf16_t*)(p.ws + OFF_H);
  for (int row = get_bid() * 8 + w; row < TR; row += gridDim.x * 8) {
    const float* src; const float* mv;
    if (row < 256) { src = cin + ((size_t)b * 256 + row) * 1024; mv = modv + (l * 3 + 2) * 3072; }
    else { src = xin + ((size_t)b * SEQ + (row - 256)) * 1024; mv = modv + (l * 3 + b) * 3072; }
    float4 v[4];
    float ss = 0.f;
#pragma unroll
    for (int i = 0; i < 4; ++i) {
      v[i] = *(const float4*)(src + i * 256 + lane * 4);
      ss += v[i].x * v[i].x + v[i].y * v[i].y + v[i].z * v[i].z + v[i].w * v[i].w;
    }
    ss = red64(ss);
    const float rs = rsqrtf(ss * (1.f / 1024.f) + 1e-6f);
#pragma unroll
    for (int i = 0; i < 4; ++i) {
      const int c = i * 256 + lane * 4;
      const float4 g = *(const float4*)(ng + c);
      const float4 sh = *(const float4*)(mv + c);
      const float4 sc = *(const float4*)(mv + 1024 + c);
      float o[4];
      o[0] = v[i].x * rs * g.x * (1.f + sc.x) + sh.x;
      o[1] = v[i].y * rs * g.y * (1.f + sc.y) + sh.y;
      o[2] = v[i].z * rs * g.z * (1.f + sc.z) + sh.z;
      o[3] = v[i].w * rs * g.w * (1.f + sc.w) + sh.w;
      *(uint2*)(H + (size_t)row * 1024 + c) = pack4(o);
    }
  }
}

DI void phase_g1(const Params& p, int l, char* smem) {
  const bf16_t* H = (const bf16_t*)(p.ws + OFF_H);
  const bf16_t* W = (const bf16_t*)(p.ws + OFF_WINT) + (size_t)l * NPAD * 1024;
  bf16_t* P = (bf16_t*)(p.ws + OFF_P);
  for (int tile = get_bid(); tile < 65 * 53; tile += gridDim.x) {
    const int mt = tile % 65, nt = tile / 65;
    f32x16 acc[2][2];
    acc[0][0] = zero16(); acc[0][1] = zero16(); acc[1][0] = zero16(); acc[1][1] = zero16();
    gemm_core<2>(H + (size_t)mt * 256 * 1024, 1024, W + (size_t)nt * 128 * 1024, 1024, 1024, acc, smem);
    store_tile_bf16<2>(acc, P + (size_t)mt * 256 * LDP + nt * 128, LDP, LDP - nt * 128);
  }
}

DI int swap23(int p) { return (p & 3) | ((p & 4) << 1) | ((p & 8) >> 1); }
DI void vt_tile(const bf16_t* __restrict__ src, int ld, bf16_t* __restrict__ dst, int tok0, char* smem) {
  bf16_t* tS = (bf16_t*)smem;
  const int tid = get_tid();
  __syncthreads();
  {
    const int tok = tid >> 3, c8 = (tid & 7) * 8;
    *(uint4*)(tS + tok * 72 + c8) = *(const uint4*)(src + (size_t)(tok0 + tok) * ld + c8);
  }
  __syncthreads();
  {
    const int dv = tid >> 3, pc = tid & 7;
    unsigned short v[8];
#pragma unroll
    for (int j = 0; j < 8; ++j) {
      const int pos = 8 * pc + j;
      const int tokoff = (pos & ~15) | swap23(pos & 15);
      v[j] = tS[tokoff * 72 + dv];
    }
    uint4 o;
    o.x = v[0] | ((unsigned)v[1] << 16); o.y = v[2] | ((unsigned)v[3] << 16);
    o.z = v[4] | ((unsigned)v[5] << 16); o.w = v[6] | ((unsigned)v[7] << 16);
    *(uint4*)(dst + (size_t)dv * TR + tok0 + 8 * pc) = o;
  }
}

DI void phase_post(const Params& p, int l, char* smem) {
  const int tid = get_tid(), lane = tid & 63, w = tid >> 6;
  bf16_t* P = (bf16_t*)(p.ws + OFF_P);
  const float* cosH = (const float*)(p.ws + OFF_ROPE);
  const float* sinH = cosH + SEQ * 32;
  const int m = lane & 7;
  for (int row = get_bid() * 8 + w; row < TR; row += gridDim.x * 8) {
    bf16_t* Pr = P + (size_t)row * LDP;
    float x[8];
    {
      uint4 v = *(const uint4*)(Pr + A_Q + lane * 8); unpack8(v, x);
      float ss = 0.f;
#pragma unroll
      for (int e = 0; e < 8; ++e) ss += x[e] * x[e];
      ss = red8(ss);
      const float rs = rsqrtf(ss * (1.f / 64.f) + 1e-6f) * SC64;
#pragma unroll
      for (int e = 0; e < 8; ++e) x[e] = x[e] * rs * p.in[I_NAQG][l * 64 + m * 8 + e];
      *(uint4*)(Pr + A_Q + lane * 8) = pack8(x);
    }
    {
      uint4 v = *(const uint4*)(Pr + A_K + lane * 8); unpack8(v, x);
      float ss = 0.f;
#pragma unroll
      for (int e = 0; e < 8; ++e) ss += x[e] * x[e];
      ss = red8(ss);
      const float rs = rsqrtf(ss * (1.f / 64.f) + 1e-6f);
#pragma unroll
      for (int e = 0; e < 8; ++e) x[e] = x[e] * rs * p.in[I_NAKG][l * 64 + m * 8 + e];
      *(uint4*)(Pr + A_K + lane * 8) = pack8(x);
    }
#pragma unroll
    for (int which = 0; which < 2; ++which) {
      const int lc = which ? (lane & 15) : lane;
      bf16_t* ptr = Pr + (which ? D_K : D_Q) + lc * 8;
      const float* gg = (which ? p.in[I_GQAKG] : p.in[I_GQAQG]) + l * 64 + m * 8;
      uint4 v = *(const uint4*)ptr; unpack8(v, x);
      float ss = 0.f;
#pragma unroll
      for (int e = 0; e < 8; ++e) ss += x[e] * x[e];
      ss = red8(ss);
      const float rs = rsqrtf(ss * (1.f / 64.f) + 1e-6f);
#pragma unroll
      for (int e = 0; e < 8; ++e) x[e] = x[e] * rs * gg[e];
      if (row >= 256) {
        const int t = row - 256;
        const float sgn = (m < 4) ? -1.f : 1.f;
#pragma unroll
        for (int e = 0; e < 8; ++e) {
          const float pr = __shfl_xor(x[e], 4);
          const int i = 8 * (m & 3) + e;
          const float c = cosH[t * 32 + i], s = sinH[t * 32 + i];
          x[e] = x[e] * c + sgn * pr * s;
        }
      }
      if (!which) {
#pragma unroll
        for (int e = 0; e < 8; ++e) x[e] *= SC64;
      }
      if (!which || lane < 16) *(uint4*)ptr = pack8(x);
    }
    {
      const int hh = lane >> 5, li = lane & 31;
      bf16_t* ptr = Pr + C_CQ + 256 * hh + li * 8;
      const float* gg = (hh ? p.in[I_MLAKVAG] : p.in[I_MLAQAG]) + l * 256 + li * 8;
      uint4 v = *(const uint4*)ptr; unpack8(v, x);
      float ss = 0.f;
#pragma unroll
      for (int e = 0; e < 8; ++e) ss += x[e] * x[e];
      ss = red32(ss);
      const float rs = rsqrtf(ss * (1.f / 256.f) + 1e-6f);
#pragma unroll
      for (int e = 0; e < 8; ++e) x[e] = x[e] * rs * gg[e];
      *(uint4*)ptr = pack8(x);
    }
  }
  for (int tile = get_bid(); tile < 260 * 10; tile += gridDim.x) {
    const int tt = tile % 260, hd = tile / 260;
    if (hd < 8) vt_tile(P + A_V + hd * 64, LDP, (bf16_t*)(p.ws + OFF_VTA) + (size_t)hd * 64 * TR, tt * 64, smem);
    else vt_tile(P + D_V + (hd - 8) * 64, LDP, (bf16_t*)(p.ws + OFF_VTD) + (size_t)(hd - 8) * 64 * TR, tt * 64, smem);
  }
}

DI void phase_mlaproj(const Params& p, int l, char* smem) {
  const bf16_t* P = (const bf16_t*)(p.ws + OFF_P);
  for (int tile = get_bid(); tile < 65 * 14; tile += gridDim.x) {
    const int mt = tile % 65, nt = tile / 65;
    f32x16 acc[2][2];
    acc[0][0] = zero16(); acc[0][1] = zero16(); acc[1][0] = zero16(); acc[1][1] = zero16();
    if (nt < 6) {
      gemm_core<2>(P + (size_t)mt * 256 * LDP + C_CQ, LDP, (const bf16_t*)(p.ws + OFF_WUQT) + (size_t)l * 768 * 256 + (size_t)nt * 128 * 256, 256, 256, acc, smem);
      store_tile_bf16<2>(acc, (bf16_t*)(p.ws + OFF_QM) + (size_t)mt * 256 * 768 + nt * 128, 768, 128);
    } else {
      const int n2 = nt - 6;
      gemm_core<2>(P + (size_t)mt * 256 * LDP + C_CKV, LDP, (const bf16_t*)(p.ws + OFF_WUKVT) + (size_t)l * 1024 * 256 + (size_t)n2 * 128 * 256, 256, 256, acc, smem);
      store_tile_bf16<2>(acc, (bf16_t*)(p.ws + OFF_KVRAW) + (size_t)mt * 256 * 1024 + n2 * 128, 1024, 128);
    }
  }
}

DI void phase_mlapost(const Params& p, int l, char* smem) {
  const int tid = get_tid(), lane = tid & 63, w = tid >> 6;
  const bf16_t* P = (const bf16_t*)(p.ws + OFF_P);
  bf16_t* Qm = (bf16_t*)(p.ws + OFF_QM);
  const bf16_t* KV = (const bf16_t*)(p.ws + OFF_KVRAW);
  bf16_t* Km = (bf16_t*)(p.ws + OFF_KM);
  const float* cosM = (const float*)(p.ws + OFF_ROPE) + SEQ * 64;
  const float* sinM = cosM + SEQ * 16;
  const int hh = lane >> 3, m = lane & 7;
  for (int row = get_bid() * 8 + w; row < TR; row += gridDim.x * 8) {
#pragma unroll
    for (int which = 0; which < 2; ++which) {
      float x[12];
      const bf16_t* pn = which ? (KV + (size_t)row * 1024 + hh * 128 + 8 * m) : (Qm + (size_t)row * 768 + hh * 96 + 8 * m);
      const bf16_t* pt = which ? (P + (size_t)row * LDP + C_KR + 4 * m) : (Qm + (size_t)row * 768 + hh * 96 + 64 + 4 * m);
      const float* gg = (which ? p.in[I_MLAKG] : p.in[I_MLAQG]) + l * 96;
      uint4 vn = *(const uint4*)pn; uint2 vt = *(const uint2*)pt;
      unpack8(vn, x); unpack4(vt, x + 8);
      float ss = 0.f;
#pragma unroll
      for (int e = 0; e < 12; ++e) ss += x[e] * x[e];
      ss = red8(ss);
      const float rs = rsqrtf(ss * (1.f / 96.f) + 1e-6f);
#pragma unroll
      for (int e = 0; e < 8; ++e) x[e] = x[e] * rs * gg[8 * m + e];
#pragma unroll
      for (int e = 0; e < 4; ++e) x[8 + e] = x[8 + e] * rs * gg[64 + 4 * m + e];
      if (row >= 256) {
        const int t = row - 256;
        const float sgn = (m < 4) ? -1.f : 1.f;
#pragma unroll
        for (int e = 0; e < 4; ++e) {
          const float pr = __shfl_xor(x[8 + e], 4);
          const int i = 4 * (m & 3) + e;
          const float c = cosM[t * 16 + i], s = sinM[t * 16 + i];
          x[8 + e] = x[8 + e] * c + sgn * pr * s;
        }
      }
      if (!which) {
#pragma unroll
        for (int e = 0; e < 12; ++e) x[e] *= SC96;
      }
      bf16_t* dn = which ? (Km + (size_t)row * 768 + hh * 96 + 8 * m) : (Qm + (size_t)row * 768 + hh * 96 + 8 * m);
      bf16_t* dt = which ? (Km + (size_t)row * 768 + hh * 96 + 64 + 4 * m) : (Qm + (size_t)row * 768 + hh * 96 + 64 + 4 * m);
      *(uint4*)dn = pack8(x);
      *(uint2*)dt = pack4(x + 8);
    }
  }
  for (int tile = get_bid(); tile < 260 * 8; tile += gridDim.x) {
    const int tt = tile % 260, hd = tile / 260;
    vt_tile(KV + hd * 128 + 64, 1024, (bf16_t*)(p.ws + OFF_VTM) + (size_t)hd * 64 * TR, tt * 64, smem);
  }
}

template <int DK>
DI void attn_item(const bf16_t* __restrict__ Qp, int ldq, const bf16_t* __restrict__ Kp, int ldk,
                  const bf16_t* __restrict__ Vt, bf16_t* __restrict__ Gp, int ldg, int q0,
                  int r0a, int n0, int r1a, int n1, int na_mode, const float* __restrict__ rpb, char* smem) {
  constexpr int KS = DK / 16, LK = DK + 8, CPR = DK / 8;
  const int tid = get_tid(), lane = tid & 63, w = tid >> 6, r = lane & 31, h = lane >> 5;
  bf16_t* Ks = (bf16_t*)smem;
  bf16_t* Vs = Ks + 2 * 64 * LK;
  float* rpbS = (float*)(Vs + 2 * 64 * 72);
  __syncthreads();
  if (na_mode) for (int i = tid; i < 465; i += 512) rpbS[i] = rpb[i] * LOG2E;
  const int qrow = q0 + 32 * w + r;
  bf16x8 qf[KS];
#pragma unroll
  for (int ks = 0; ks < KS; ++ks) qf[ks] = *(const bf16x8*)(Qp + (size_t)qrow * ldq + ks * 16 + h * 8);
  f32x16 o[2]; o[0] = zero16(); o[1] = zero16();
  float mrun = -1e30f, lsum = 0.f;
  const int ntiles = n0 + n1;
  const int tq = qrow - 256;
  const int qr = tq >> 6, qc = tq & 63;
  const int rs = min(max(qr - 4, 0), 248), cs = min(max(qc - 8, 0), 48);
  uint4 rk0, rk1, rv;
  rk1 = make_uint4(0, 0, 0, 0);
  auto gload = [&](int ti) {
    const int rowstart = (ti < n0) ? (r0a + 64 * ti) : (r1a + 64 * (ti - n0));
    { const int c = tid; rk0 = *(const uint4*)(Kp + (size_t)(rowstart + c / CPR) * ldk + (c % CPR) * 8); }
    if (CPR == 12 && tid < 256) { const int c = tid + 512; rk1 = *(const uint4*)(Kp + (size_t)(rowstart + c / CPR) * ldk + (c % CPR) * 8); }
    rv = *(const uint4*)(Vt + (size_t)(tid >> 3) * TR + rowstart + (tid & 7) * 8);
  };
  auto sstore = [&](int buf) {
    { const int c = tid; *(uint4*)(Ks + (buf * 64 + c / CPR) * LK + (c % CPR) * 8) = rk0; }
    if (CPR == 12 && tid < 256) { const int c = tid + 512; *(uint4*)(Ks + (buf * 64 + c / CPR) * LK + (c % CPR) * 8) = rk1; }
    *(uint4*)(Vs + (buf * 64 + (tid >> 3)) * 72 + (tid & 7) * 8) = rv;
  };
  gload(0); sstore(0);
  __syncthreads();
  for (int ti = 0; ti < ntiles; ++ti) {
    const int buf = ti & 1;
    if (ti + 1 < ntiles) gload(ti + 1);
    f32x16 s[2]; s[0] = zero16(); s[1] = zero16();
#pragma unroll
    for (int kt2 = 0; kt2 < 2; ++kt2) {
      const bf16_t* kb = Ks + (buf * 64 + 32 * kt2 + r) * LK + h * 8;
#pragma unroll
      for (int ks = 0; ks < KS; ++ks) {
        bf16x8 a = *(const bf16x8*)(kb + ks * 16);
        s[kt2] = MFMA32(a, qf[ks], s[kt2]);
      }
    }
    if (na_mode && ti >= n0) {
      const int kr = ((r1a - 256) >> 6) + (ti - n0);
      const bool rowok = (kr >= rs) && (kr <= rs + 7);
      const int dr = kr - qr + 7;
#pragma unroll
      for (int kt2 = 0; kt2 < 2; ++kt2)
#pragma unroll
        for (int e = 0; e < 16; ++e) {
          const int kc = 32 * kt2 + crow(e, h);
          const bool ok = rowok && (kc >= cs) && (kc <= cs + 15);
          const int idx = ok ? (dr * 31 + (kc - qc + 15)) : 0;
          const float bv = rpbS[idx];
          s[kt2][e] = ok ? (s[kt2][e] + bv) : -1e30f;
        }
    }
    float mx = -1e30f;
#pragma unroll
    for (int e = 0; e < 16; ++e) mx = fmaxf(mx, fmaxf(s[0][e], s[1][e]));
    mx = fmaxf(mx, __shfl_xor(mx, 32));
    const float mnew = fmaxf(mrun, mx);
    const float alpha = __builtin_amdgcn_exp2f(mrun - mnew);
    mrun = mnew;
    float ps = 0.f;
#pragma unroll
    for (int kt2 = 0; kt2 < 2; ++kt2)
#pragma unroll
      for (int e = 0; e < 16; ++e) { const float pv = __builtin_amdgcn_exp2f(s[kt2][e] - mnew); s[kt2][e] = pv; ps += pv; }
    lsum = lsum * alpha + ps;
#pragma unroll
    for (int e = 0; e < 16; ++e) { o[0][e] *= alpha; o[1][e] *= alpha; }
#pragma unroll
    for (int kt2 = 0; kt2 < 2; ++kt2)
#pragma unroll
      for (int sx = 0; sx < 2; ++sx) {
        uint4 pk;
        pk.x = pack2(s[kt2][8 * sx + 0], s[kt2][8 * sx + 1]);
        pk.y = pack2(s[kt2][8 * sx + 2], s[kt2][8 * sx + 3]);
        pk.z = pack2(s[kt2][8 * sx + 4], s[kt2][8 * sx + 5]);
        pk.w = pack2(s[kt2][8 * sx + 6], s[kt2][8 * sx + 7]);
        const bf16x8 pf = __builtin_bit_cast(bf16x8, pk);
#pragma unroll
        for (int d2 = 0; d2 < 2; ++d2) {
          bf16x8 a = *(const bf16x8*)(Vs + (buf * 64 + 32 * d2 + r) * 72 + 32 * kt2 + 16 * sx + 8 * h);
          o[d2] = MFMA32(a, pf, o[d2]);
        }
      }
    if (ti + 1 < ntiles) sstore(buf ^ 1);
    __syncthreads();
  }
  const float lt = lsum + __shfl_xor(lsum, 32);
  const float inv = 1.f / lt;
#pragma unroll
  for (int d2 = 0; d2 < 2; ++d2)
#pragma unroll
    for (int gq = 0; gq < 4; ++gq) {
      const int dv0 = 32 * d2 + 8 * gq + 4 * h;
      bf16_t* ptr = Gp + (size_t)qrow * ldg + dv0;
      uint2 gv = *(const uint2*)ptr;
      float g[4]; unpack4(gv, g);
      float y[4];
#pragma unroll
      for (int e = 0; e < 4; ++e) y[e] = o[d2][4 * gq + e] * inv * siluf_(g[e]);
      *(uint2*)ptr = pack4(y);
    }
}

DI float dpp_red8(float v) {
  v += __builtin_bit_cast(float, __builtin_amdgcn_update_dpp(0, __builtin_bit_cast(int, v), 0xB1, 0xF, 0xF, true));
  v += __builtin_bit_cast(float, __builtin_amdgcn_update_dpp(0, __builtin_bit_cast(int, v), 0x4E, 0xF, 0xF, true));
  v += __builtin_bit_cast(float, __builtin_amdgcn_update_dpp(0, __builtin_bit_cast(int, v), 0x141, 0xF, 0xF, true));
  return v;
}

DI void scan_item(const Params& p, int l, int hd, int d, int rp, char* smem) {
  const int tid = get_tid(), lane = tid & 63, w = tid >> 6;
  float* CH = (float*)smem;
  float* YC = CH + 2 * 6 * 2048;
  bf16_t* W2T = (bf16_t*)(YC + 2048);
  bf16_t* XW = W2T + 2 * 64 * 72;
  float* LO = (float*)(XW + 4 * 2 * 8 * 72);
  const bf16_t* P = (const bf16_t*)(p.ws + OFF_P);
  bf16_t* Yd = (bf16_t*)(p.ws + (d ? OFF_Y1 : OFF_Y0));
  float* Cb = (float*)(p.ws + OFF_CB) + (size_t)d * TR * 8;
  __syncthreads();
  {
    const float* w2 = p.in[I_RWW2] + (size_t)(l * 2 + d) * 64 * 512 + hd * 64;
    const float* a2 = p.in[I_RWA2] + (size_t)(l * 2 + d) * 64 * 512 + hd * 64;
    for (int i = tid; i < 4096; i += 512) {
      const int j = i >> 6, c = i & 63;
      W2T[c * 72 + j] = f2bf(w2[(size_t)j * 512 + c]);
      W2T[64 * 72 + c * 72 + j] = f2bf(a2[(size_t)j * 512 + c]);
    }
  }
  __syncthreads();
  const int NCH = 520;
  float S[8];
#pragma unroll
  for (int e = 0; e < 8; ++e) S[e] = 0.f;
  const float* mu = p.in[I_RWMU] + l * 1792;
  for (int ci = 0; ci <= NCH + 1; ++ci) {
    if (w >= 4) {
      const int pw = w - 4;
      if (ci < NCH) {
        const int buf = ci & 1;
        int segbase, seglen, cs;
        if (ci < 8) { segbase = 0; seglen = 256; cs = d ? (7 - ci) : ci; }
        else { segbase = 256; seglen = SEQ; cs = d ? (511 - (ci - 8)) : (ci - 8); }
        const int tl = lane >> 3, m = lane & 7;
        const int tc = 8 * pw + tl;
        const int t = 32 * cs + tc;
        const size_t row = (size_t)(segbase + t);
        const bool hm = t > 0, hp = t < seglen - 1;
        float xr[8], xk[8], xv[8], xw[8], xa[8];
        const int cols[5] = {B_U + hd * 64 + 8 * m, B_U + 512 + hd * 64 + 8 * m, B_U + 1024 + hd * 64 + 8 * m,
                             B_U + 1536 + d * 64 + 8 * m, B_U + 1664 + d * 64 + 8 * m};
#pragma unroll
        for (int vv = 0; vv < 5; ++vv) {
          float* dst = (vv == 0) ? xr : (vv == 1) ? xk : (vv == 2) ? xv : (vv == 3) ? xw : xa;
          const bf16_t* pc = P + row * LDP + cols[vv];
          float u0[8], um[8], up[8];
          unpack8(*(const uint4*)pc, u0);
          if (hm) unpack8(*(const uint4*)(pc - LDP), um); else {
#pragma unroll
            for (int e = 0; e < 8; ++e) um[e] = 0.f;
          }
          if (hp) unpack8(*(const uint4*)(pc + LDP), up); else {
#pragma unroll
            for (int e = 0; e < 8; ++e) up[e] = 0.f;
          }
          const float* mp = mu + (cols[vv] - B_U);
#pragma unroll
          for (int e = 0; e < 8; ++e) dst[e] = u0[e] + mp[e] * (0.5f * (um[e] + up[e]) - u0[e]);
        }
        float kk[8];
        {
          float ss = 0.f;
#pragma unroll
          for (int e = 0; e < 8; ++e) { kk[e] = xk[e] * p.in[I_RWKK][l * 512 + hd * 64 + 8 * m + e]; ss += kk[e] * kk[e]; }
          ss = red8(ss);
          const float rn = rsqrtf(ss + 1e-12f);
#pragma unroll
          for (int e = 0; e < 8; ++e) kk[e] *= rn;
        }
        bf16_t* xwp = XW + pw * (2 * 8 * 72);
        {
          float tw[8];
#pragma unroll
          for (int e = 0; e < 8; ++e) tw[e] = tanhf(xw[e]);
          *(uint4*)(xwp + tl * 72 + 8 * m) = pack8(tw);
          *(uint4*)(xwp + 8 * 72 + tl * 72 + 8 * m) = pack8(xa);
        }
        __builtin_amdgcn_fence(__ATOMIC_RELEASE, "wavefront");
        __builtin_amdgcn_wave_barrier();
        __builtin_amdgcn_fence(__ATOMIC_ACQUIRE, "wavefront");
        {
          const int r = lane & 31, h = lane >> 5;
          float* lop = LO + pw * (2 * 8 * 64);
#pragma unroll
          for (int mat = 0; mat < 2; ++mat) {
            f32x16 acc[2]; acc[0] = zero16(); acc[1] = zero16();
#pragma unroll
            for (int ks = 0; ks < 4; ++ks) {
              bf16x8 a;
              if (r < 8) a = *(const bf16x8*)(xwp + mat * 8 * 72 + r * 72 + ks * 16 + h * 8);
              else {
#pragma unroll
                for (int e = 0; e < 8; ++e) a[e] = 0;
              }
#pragma unroll
              for (int nt = 0; nt < 2; ++nt) {
                bf16x8 bb = *(const bf16x8*)(W2T + mat * 64 * 72 + (32 * nt + r) * 72 + ks * 16 + h * 8);
                acc[nt] = MFMA32(a, bb, acc[nt]);
              }
            }
#pragma unroll
            for (int nt = 0; nt < 2; ++nt)
#pragma unroll
              for (int e = 0; e < 4; ++e) lop[mat * 8 * 64 + (4 * h + e) * 64 + 32 * nt + r] = acc[nt][e];
          }
        }
        __builtin_amdgcn_fence(__ATOMIC_RELEASE, "wavefront");
        __builtin_amdgcn_wave_barrier();
        __builtin_amdgcn_fence(__ATOMIC_ACQUIRE, "wavefront");
        {
          const float* lop = LO + pw * (2 * 8 * 64);
          const int c0 = hd * 64 + 8 * m;
          float* chb = CH + buf * (6 * 2048) + tc * 64 + 8 * m;
          float bon = 0.f;
          float ow[8], okd[8], obd[8], onk[8];
#pragma unroll
          for (int e = 0; e < 8; ++e) {
            const float xwl = p.in[I_RWW0][(l * 2 + d) * 512 + c0 + e] + lop[tl * 64 + 8 * m + e];
            const float xal = p.in[I_RWA0][(l * 2 + d) * 512 + c0 + e] + lop[8 * 64 + tl * 64 + 8 * m + e];
            const float dec = __expf(-0.6065306597126334f * sigmoidf_(xwl));
            const float a = sigmoidf_(xal);
            const float kd = xk[e] * (1.f + (a - 1.f) * p.in[I_RWKA][l * 512 + c0 + e]);
            ow[e] = dec; okd[e] = kd; obd[e] = kk[e] * a; onk[e] = -kk[e];
            bon += xr[e] * kd * p.in[I_RWRK][l * 512 + c0 + e];
          }
          bon = red8(bon);
          if (m == 0 && rp == 0) Cb[row * 8 + hd] = bon;
          *(float4*)(chb + 0 * 2048) = make_float4(ow[0], ow[1], ow[2], ow[3]);
          *(float4*)(chb + 0 * 2048 + 4) = make_float4(ow[4], ow[5], ow[6], ow[7]);
          *(float4*)(chb + 1 * 2048) = make_float4(okd[0], okd[1], okd[2], okd[3]);
          *(float4*)(chb + 1 * 2048 + 4) = make_float4(okd[4], okd[5], okd[6], okd[7]);
          *(float4*)(chb + 2 * 2048) = make_float4(obd[0], obd[1], obd[2], obd[3]);
          *(float4*)(chb + 2 * 2048 + 4) = make_float4(obd[4], obd[5], obd[6], obd[7]);
          *(float4*)(chb + 3 * 2048) = make_float4(onk[0], onk[1], onk[2], onk[3]);
          *(float4*)(chb + 3 * 2048 + 4) = make_float4(onk[4], onk[5], onk[6], onk[7]);
          *(float4*)(chb + 4 * 2048) = make_float4(xr[0], xr[1], xr[2], xr[3]);
          *(float4*)(chb + 4 * 2048 + 4) = make_float4(xr[4], xr[5], xr[6], xr[7]);
          *(float4*)(chb + 5 * 2048) = make_float4(xv[0], xv[1], xv[2], xv[3]);
          *(float4*)(chb + 5 * 2048 + 4) = make_float4(xv[4], xv[5], xv[6], xv[7]);
        }
      }
      if (ci >= 2) {
        const int cj = ci - 2;
        int segbase, cs;
        if (cj < 8) { segbase = 0; cs = d ? (7 - cj) : cj; }
        else { segbase = 256; cs = d ? (511 - (cj - 8)) : (cj - 8); }
        const int ptid = tid - 256;
        const int tf = ptid >> 3, i4 = (ptid & 7) * 4;
        const float* yc = YC + (cj & 1) * 1024 + tf * 32 + i4;
        float y[4] = {yc[0], yc[1], yc[2], yc[3]};
        const size_t row = (size_t)(segbase + 32 * cs + tf);
        *(uint2*)(Yd + row * 512 + hd * 64 + 32 * rp + i4) = pack4(y);
      }
    } else {
      if (ci >= 1 && ci <= NCH) {
        const int cj = ci - 1;
        const int il = tid >> 3, js = tid & 7;
        const float* chb = CH + (cj & 1) * (6 * 2048) + 8 * js;
        float* yc = YC + (cj & 1) * 1024;
        for (int sidx = 0; sidx < 32; ++sidx) {
          const int tt = d ? (31 - sidx) : sidx;
          const float* cb = chb + tt * 64;
          const float4 w0 = *(const float4*)(cb), w1 = *(const float4*)(cb + 4);
          const float4 k0 = *(const float4*)(cb + 2048), k1 = *(const float4*)(cb + 2048 + 4);
          const float4 b0 = *(const float4*)(cb + 2 * 2048), b1 = *(const float4*)(cb + 2 * 2048 + 4);
          const float4 n0 = *(const float4*)(cb + 3 * 2048), n1 = *(const float4*)(cb + 3 * 2048 + 4);
          const float4 r0 = *(const float4*)(cb + 4 * 2048), r1 = *(const float4*)(cb + 4 * 2048 + 4);
          const float vi = CH[(cj & 1) * (6 * 2048) + 5 * 2048 + tt * 64 + 32 * rp + il];
          const float wv[8] = {w0.x, w0.y, w0.z, w0.w, w1.x, w1.y, w1.z, w1.w};
          const float kv[8] = {k0.x, k0.y, k0.z, k0.w, k1.x, k1.y, k1.z, k1.w};
          const float bv[8] = {b0.x, b0.y, b0.z, b0.w, b1.x, b1.y, b1.z, b1.w};
          const float nv[8] = {n0.x, n0.y, n0.z, n0.w, n1.x, n1.y, n1.z, n1.w};
          const float rv[8] = {r0.x, r0.y, r0.z, r0.w, r1.x, r1.y, r1.z, r1.w};
          float sa = 0.f;
#pragma unroll
          for (int e = 0; e < 8; ++e) sa += S[e] * nv[e];
          sa = dpp_red8(sa);
          float y = 0.f;
#pragma unroll
          for (int e = 0; e < 8; ++e) {
            S[e] = S[e] * wv[e] + (sa * bv[e] + vi * kv[e]);
            y += S[e] * rv[e];
          }
          y = dpp_red8(y);
          if (js == 0) yc[tt * 32 + il] = y;
        }
      }
    }
    __syncthreads();
  }
}

DI void phase_mix(const Params& p, int l, int lb, char* smem, int* s_item) {
  const int tid = get_tid();
  int* ctr = (int*)(p.ws + OFF_CTR) + lb;
  const bf16_t* P = (const bf16_t*)(p.ws + OFF_P);
  bf16_t* Pw = (bf16_t*)(p.ws + OFF_P);
  const int nctx = (l == 0) ? 24 : 0;
  const int total = 32 + 1024 + 512 + nctx;
  while (true) {
    __syncthreads();
    if (tid == 0) *s_item = atomicAdd(ctr, 1);
    __syncthreads();
    const int item = *s_item;
    if (item >= total) break;
    if (item < 32) {
      scan_item(p, l, item >> 2, (item >> 1) & 1, item & 1, smem);
    } else {
      int ty, hd, q0, n0 = 4, r1a = 0, n1 = 0, na = 0;
      if (item < 32 + 512) { const int it = item - 32; ty = 0; hd = it >> 6; q0 = 256 + 256 * (it & 63); n0 = 260; }
      else if (item < 32 + 1024) { const int it = item - 32 - 512; ty = 1; hd = it >> 6; q0 = 256 + 256 * (it & 63); n0 = 260; }
      else if (item < 32 + 1024 + 512) {
        const int it = item - 32 - 1024; ty = 2; hd = it >> 6; const int qt = it & 63; q0 = 256 + 256 * qt;
        const int rsmin = min(max(4 * qt - 4, 0), 248);
        const int rsend = min(max(4 * qt + 3 - 4, 0), 248) + 7;
        r1a = 256 + 64 * rsmin; n1 = rsend - rsmin + 1; na = 1;
      } else { const int it = item - 32 - 1024 - 512; ty = it >> 3; hd = it & 7; q0 = 0; }
      if (ty == 0) {
        attn_item<96>((const bf16_t*)(p.ws + OFF_QM) + hd * 96, 768, (const bf16_t*)(p.ws + OFF_KM) + hd * 96, 768,
                      (const bf16_t*)(p.ws + OFF_VTM) + (size_t)hd * 64 * TR, Pw + C_G + hd * 64, LDP, q0,
                      0, n0, 0, 0, 0, nullptr, smem);
      } else {
        const bf16_t* Qp = (ty == 1) ? (P + D_Q + hd * 64) : (P + A_Q + hd * 64);
        const bf16_t* Kp = (ty == 1) ? (P + D_K + (hd >> 2) * 64) : (P + A_K + hd * 64);
        const bf16_t* Vt = (ty == 1) ? ((const bf16_t*)(p.ws + OFF_VTD) + (size_t)(hd >> 2) * 64 * TR)
                                     : ((const bf16_t*)(p.ws + OFF_VTA) + (size_t)hd * 64 * TR);
        bf16_t* Gp = (ty == 1) ? (Pw + D_G + hd * 64) : (Pw + A_G + hd * 64);
        attn_item<64>(Qp, LDP, Kp, LDP, Vt, Gp, LDP, q0, 0, n0, r1a, n1, na,
                      p.in[I_NARPB] + (size_t)(l * 8 + hd) * 465, smem);
      }
    }
  }
}

DI void phase_fin(const Params& p, int l) {
  const int tid = get_tid(), lane = tid & 63, w = tid >> 6;
  bf16_t* P = (bf16_t*)(p.ws + OFF_P);
  const bf16_t* Y0 = (const bf16_t*)(p.ws + OFF_Y0);
  const bf16_t* Y1 = (const bf16_t*)(p.ws + OFF_Y1);
  const float* Cb = (const float*)(p.ws + OFF_CB);
  const float* mu = p.in[I_RWMU] + l * 1792 + 1024;
  const int hh = lane >> 3, c = lane * 8;
  for (int row = get_bid() * 8 + w; row < TR; row += gridDim.x * 8) {
    float a[8], b2[8], ys[8];
    unpack8(*(const uint4*)(Y0 + (size_t)row * 512 + c), a);
    unpack8(*(const uint4*)(Y1 + (size_t)row * 512 + c), b2);
    float sm = 0.f;
#pragma unroll
    for (int e = 0; e < 8; ++e) { ys[e] = a[e] + b2[e]; sm += ys[e]; }
    const float mean = red8(sm) * (1.f / 64.f);
    float vs = 0.f;
#pragma unroll
    for (int e = 0; e < 8; ++e) { const float dd = ys[e] - mean; vs += dd * dd; }
    const float var = red8(vs) * (1.f / 64.f);
    const float rstd = rsqrtf(var + 64e-5f);
    const int segb = (row < 256) ? 0 : 256, sege = (row < 256) ? 256 : TR;
    bf16_t* Pr = P + (size_t)row * LDP;
    float u0[8], um[8], up[8];
    unpack8(*(const uint4*)(Pr + B_U + 1024 + c), u0);
    if (row > segb) unpack8(*(const uint4*)(Pr - LDP + B_U + 1024 + c), um); else {
#pragma unroll
      for (int e = 0; e < 8; ++e) um[e] = 0.f;
    }
    if (row < sege - 1) unpack8(*(const uint4*)(Pr + LDP + B_U + 1024 + c), up); else {
#pragma unroll
      for (int e = 0; e < 8; ++e) up[e] = 0.f;
    }
    const float bon = Cb[(size_t)row * 8 + hh] + Cb[(size_t)TR * 8 + (size_t)row * 8 + hh];
    float g[8], o[8];
    unpack8(*(const uint4*)(Pr + B_G + c), g);
#pragma unroll
    for (int e = 0; e < 8; ++e) {
      const float v = u0[e] + mu[c + e] * (0.5f * (um[e] + up[e]) - u0[e]);
      const float yn = (ys[e] - mean) * rstd * p.in[I_RWGNW][l * 512 + c + e] + p.in[I_RWGNB][l * 512 + c + e];
      o[e] = (yn + bon * v) * siluf_(g[e]);
    }
    *(uint4*)(Pr + B_G + c) = pack8(o);
  }
}

DI void phase_merge1(const Params& p, int l, char* smem) {
  const int tid = get_tid(), lane = tid & 63, w = tid >> 6, r = lane & 31;
  const int wn = w & 1;
  const bf16_t* H = (const bf16_t*)(p.ws + OFF_H);
  const bf16_t* P = (const bf16_t*)(p.ws + OFF_P);
  bf16_t* ACC = (bf16_t*)(p.ws + OFF_ACC);
  const int mt0 = (l == 0) ? 0 : 1;
  const int nmt = 65 - mt0;
  for (int tile = get_bid(); tile < nmt * 16; tile += gridDim.x) {
    const int mt = mt0 + tile % nmt, nt = tile / nmt;
    f32x16 accS[2][1];
    accS[0][0] = zero16(); accS[1][0] = zero16();
#pragma unroll 1
    for (int i = 0; i < 4; ++i) {
      const int ycol = (i == 0) ? A_G : (i == 1) ? B_G : (i == 2) ? C_G : D_G;
      unsigned gp[2][8];
      {
        f32x16 g[2][1];
        g[0][0] = zero16(); g[1][0] = zero16();
        gemm_core<1>(H + (size_t)mt * 256 * 1024, 1024, (const bf16_t*)(p.ws + OFF_MGT) + (size_t)(l * 4 + i) * 1024 * 1024 + (size_t)nt * 64 * 1024,
                     1024, 1024, g, smem);
        const float bias = p.in[I_MGB][(l * 4 + i) * 1024 + nt * 64 + 32 * wn + r];
#pragma unroll
        for (int ii = 0; ii < 2; ++ii)
#pragma unroll
          for (int e = 0; e < 8; ++e)
            gp[ii][e] = pack2(sigmoidf_(g[ii][0][2 * e] + bias), sigmoidf_(g[ii][0][2 * e + 1] + bias));
      }
      f32x16 z[2][1];
      z[0][0] = zero16(); z[1][0] = zero16();
      gemm_core<1>(P + (size_t)mt * 256 * LDP + ycol, LDP, (const bf16_t*)(p.ws + OFF_BRT) + (size_t)(l * 4 + i) * 1024 * 512 + (size_t)nt * 64 * 512,
                   512, 512, z, smem);
#pragma unroll
      for (int ii = 0; ii < 2; ++ii)
#pragma unroll
        for (int e = 0; e < 8; ++e) {
          accS[ii][0][2 * e] += lo2f(gp[ii][e]) * z[ii][0][2 * e];
          accS[ii][0][2 * e + 1] += hi2f(gp[ii][e]) * z[ii][0][2 * e + 1];
        }
    }
    store_tile_bf16<1>(accS, ACC + (size_t)mt * 256 * 1024 + nt * 64, 1024, 64);
  }
}

DI void phase_merge2(const Params& p, int l, int b, char* smem) {
  const int tid = get_tid(), lane = tid & 63, w = tid >> 6, r = lane & 31, h = lane >> 5;
  const int wm = w >> 1, wn = w & 1;
  const bf16_t* ACC = (const bf16_t*)(p.ws + OFF_ACC);
  const float* modv = (const float*)(p.ws + OFF_MODV);
  const int mt0 = (l == 0) ? 0 : 1;
  const int nmt = 65 - mt0;
  for (int tile = get_bid(); tile < nmt * 8; tile += gridDim.x) {
    const int mt = mt0 + tile % nmt, nt = tile / nmt;
    f32x16 acc[2][2];
    acc[0][0] = zero16(); acc[0][1] = zero16(); acc[1][0] = zero16(); acc[1][1] = zero16();
    gemm_core<2>(ACC + (size_t)mt * 256 * 1024, 1024, (const bf16_t*)(p.ws + OFF_OUTT) + (size_t)l * 1024 * 1024 + (size_t)nt * 128 * 1024,
              1024, 1024, acc, smem);
    const float* src; float* dst; const float* gt;
    if (mt == 0) {
      src = p.in[I_CTX] + (size_t)b * 256 * 1024; dst = (float*)(p.ws + OFF_CX1) + (size_t)b * 256 * 1024;
      gt = modv + (l * 3 + 2) * 3072 + 2048;
    } else {
      src = ((l == 0) ? p.in[I_X] : p.out) + ((size_t)b * SEQ + (size_t)(mt * 256 - 256)) * 1024;
      dst = p.out + ((size_t)b * SEQ + (size_t)(mt * 256 - 256)) * 1024;
      gt = modv + (l * 3 + b) * 3072 + 2048;
    }
#pragma unroll
    for (int i = 0; i < 2; ++i)
#pragma unroll
      for (int j = 0; j < 2; ++j) {
        const int col = nt * 128 + 64 * wn + 32 * j + r;
        const float gv = gt[col];
#pragma unroll
        for (int e = 0; e < 16; ++e) {
          const int row = 64 * wm + 32 * i + crow(e, h);
          const size_t idx = (size_t)row * 1024 + col;
          dst[idx] = src[idx] + gv * acc[i][j][e];
        }
      }
  }
}

__global__ void __launch_bounds__(512) mk_forward(Params p, int ph_lo, int ph_hi) {
  __shared__ __attribute__((aligned(16))) char smem[151552];
  __shared__ int s_item;
  cg::grid_group grid = cg::this_grid();
  for (int ph = ph_lo; ph < ph_hi; ++ph) {
    if (ph == 0) {
      if (PH_ON(9)) phase_prep(p, smem);
    } else {
      const int q = ph - 1;
      const int lb = q / 9, k = q % 9;
      const int l = lb >> 1, b = lb & 1;
      if (k == 0) { if (PH_ON(0)) phase_h(p, l, b); }
      else if (k == 1) { if (PH_ON(1)) phase_g1(p, l, smem); }
      else if (k == 2) { if (PH_ON(2)) phase_post(p, l, smem); }
      else if (k == 3) { if (PH_ON(3)) phase_mlaproj(p, l, smem); }
      else if (k == 4) { if (PH_ON(4)) phase_mlapost(p, l, smem); }
      else if (k == 5) { if (PH_ON(5)) phase_mix(p, l, lb, smem, &s_item); }
      else if (k == 6) { if (PH_ON(6)) phase_fin(p, l); }
      else if (k == 7) { if (PH_ON(7)) phase_merge1(p, l, smem); }
      else { if (PH_ON(8)) phase_merge2(p, l, b, smem); }
    }
    if (ph + 1 < ph_hi) grid.sync();
  }
}

extern "C" void kernel_launch(void* const* d_in, const int* in_sizes, int n_in, void* d_out, int out_size, void* d_ws,
                              size_t ws_size, hipStream_t stream) {
  Params p{};
  for (int i = 0; i < 33; ++i) p.in[i] = (const float*)d_in[i];
  p.out = (float*)d_out;
  p.ws = (char*)d_ws;
  const int NPH = 1 + 4 * 9;
#if MULTI
  for (int ph = 0; ph < NPH; ++ph) {
    hipLaunchKernelGGL(mk_forward, dim3(256), dim3(512), 0, stream, p, ph, ph + 1);
  }
#else
  static int grid_blocks = 0;
  if (!grid_blocks) {
    int dev = 0, cus = 0, per_cu = 0;
    hipGetDevice(&dev);
    hipDeviceGetAttribute(&cus, hipDeviceAttributeMultiprocessorCount, dev);
    hipOccupancyMaxActiveBlocksPerMultiprocessor(&per_cu, mk_forward, 512, 0);
    if (per_cu < 1) per_cu = 1;
    grid_blocks = cus * per_cu;
  }
  int lo = 0, hi = NPH;
  void* args[] = {&p, &lo, &hi};
  hipError_t e = hipLaunchCooperativeKernel((void*)mk_forward, dim3(grid_blocks), dim3(512), args, 0, stream);
  if (e != hipSuccess) fprintf(stderr, "cooperative launch failed: %s (grid %d)\n", hipGetErrorString(e), grid_blocks);
#endif
}
```

```cpp
#include <hip/hip_runtime.h>
#include <hip/hip_cooperative_groups.h>
#include <cstdio>
namespace cg = cooperative_groups;

#ifndef ONLY
#define ONLY (-1)
#endif
#define PH_ON(x) (ONLY < 0 || ONLY == (x))
#ifndef MULTI
#define MULTI 0
#endif

typedef unsigned short bf16_t;
typedef __attribute__((ext_vector_type(8))) short bf16x8;
typedef __attribute__((ext_vector_type(16))) float f32x16;
#define DI __device__ __forceinline__
#define MFMA32(a, b, c) __builtin_amdgcn_mfma_f32_32x32x16_bf16((a), (b), (c), 0, 0, 0)

#define DM 1024
#define SEQ 16384
#define CTXL 256
#define TR 16640
#define LDP 6688
#define NPAD 6784
#define A_Q 0
#define A_K 512
#define A_V 1024
#define A_G 1536
#define B_U 2048
#define B_G 3840
#define C_CQ 4352
#define C_CKV 4608
#define C_KR 4864
#define C_G 4896
#define D_Q 5408
#define D_K 5920
#define D_V 6048
#define D_G 6176
#define LOG2E 1.4426950408889634f
#define SC64 (0.125f * LOG2E)
#define SC96 (0.10206207261596575f * LOG2E)

constexpr size_t SZ_WINT = (size_t)2 * NPAD * 1024 * 2;
constexpr size_t SZ_MGT = (size_t)2 * 4 * 1024 * 1024 * 2;
constexpr size_t SZ_BRT = (size_t)2 * 4 * 1024 * 512 * 2;
constexpr size_t SZ_OUTT = (size_t)2 * 1024 * 1024 * 2;
constexpr size_t SZ_WUQT = (size_t)2 * 768 * 256 * 2;
constexpr size_t SZ_WUKVT = (size_t)2 * 1024 * 256 * 2;
constexpr size_t SZ_MODV = (size_t)2 * 3 * 3072 * 4;
constexpr size_t SZ_ROPE = (size_t)SEQ * 96 * 4;
constexpr size_t SZ_CX1 = (size_t)2 * 256 * 1024 * 4;
constexpr size_t SZ_CTR = 256;
constexpr size_t SZ_H = (size_t)TR * 1024 * 2;
constexpr size_t SZ_P = (size_t)TR * LDP * 2;
constexpr size_t SZ_VTA = (size_t)8 * 64 * TR * 2;
constexpr size_t SZ_VTD = (size_t)2 * 64 * TR * 2;
constexpr size_t SZ_QM = (size_t)TR * 768 * 2;
constexpr size_t SZ_KVRAW = (size_t)TR * 1024 * 2;
constexpr size_t SZ_KM = (size_t)TR * 768 * 2;
constexpr size_t SZ_VTM = (size_t)8 * 64 * TR * 2;
constexpr size_t SZ_Y = (size_t)TR * 512 * 2;
constexpr size_t SZ_CB = (size_t)2 * TR * 8 * 4;

constexpr size_t OFF_WINT = 0;
constexpr size_t OFF_MGT = OFF_WINT + SZ_WINT;
constexpr size_t OFF_BRT = OFF_MGT + SZ_MGT;
constexpr size_t OFF_OUTT = OFF_BRT + SZ_BRT;
constexpr size_t OFF_WUQT = OFF_OUTT + SZ_OUTT;
constexpr size_t OFF_WUKVT = OFF_WUQT + SZ_WUQT;
constexpr size_t OFF_MODV = OFF_WUKVT + SZ_WUKVT;
constexpr size_t OFF_ROPE = OFF_MODV + SZ_MODV;
constexpr size_t OFF_CX1 = OFF_ROPE + SZ_ROPE;
constexpr size_t OFF_CTR = OFF_CX1 + SZ_CX1;
constexpr size_t OFF_H = OFF_CTR + SZ_CTR;
constexpr size_t OFF_P = OFF_H + SZ_H;
constexpr size_t OFF_VTA = OFF_P + SZ_P;
constexpr size_t OFF_VTD = OFF_VTA + SZ_VTA;
constexpr size_t OFF_QM = OFF_VTD + SZ_VTD;
constexpr size_t OFF_KVRAW = OFF_QM + SZ_QM;
constexpr size_t OFF_KM = OFF_KVRAW + SZ_KVRAW;
constexpr size_t OFF_VTM = OFF_KM + SZ_KM;
constexpr size_t OFF_Y0 = OFF_VTM + SZ_VTM;
constexpr size_t OFF_Y1 = OFF_Y0 + SZ_Y;
constexpr size_t OFF_CB = OFF_Y1 + SZ_Y;
constexpr size_t OFF_END = OFF_CB + SZ_CB;
constexpr size_t OFF_ACC = OFF_QM;

struct Params {
  const float* in[33];
  float* out;
  char* ws;
};
enum { I_X = 0, I_C, I_CTX, I_CCTX, I_NORMG, I_MODW, I_MODB, I_WIN, I_NAQG, I_NAKG, I_NARPB, I_RWMU, I_RWW0, I_RWW2,
       I_RWA0, I_RWA2, I_RWKK, I_RWKA, I_RWRK, I_RWGNW, I_RWGNB, I_MLAQAG, I_MLAKVAG, I_MLAWUQ, I_MLAWUKV, I_MLAQG,
       I_MLAKG, I_GQAQG, I_GQAKG, I_MGW, I_MGB, I_WBR, I_WOUT };

DI int get_tid() { int t = threadIdx.x; asm volatile("" : "+v"(t)); return t; }
DI int get_bid() { int b = blockIdx.x; asm volatile("" : "+s"(b)); return b; }
DI bf16_t f2bf(float x) { unsigned u = __float_as_uint(x); u += 0x7fffu + ((u >> 16) & 1u); return (bf16_t)(u >> 16); }
DI float bf2f(bf16_t b) { return __uint_as_float(((unsigned)b) << 16); }
DI unsigned pack2(float a, float b) { return (unsigned)f2bf(a) | ((unsigned)f2bf(b) << 16); }
DI float lo2f(unsigned u) { return __uint_as_float(u << 16); }
DI float hi2f(unsigned u) { return __uint_as_float(u & 0xffff0000u); }
DI void unpack8(const uint4& v, float* x) {
  x[0] = lo2f(v.x); x[1] = hi2f(v.x); x[2] = lo2f(v.y); x[3] = hi2f(v.y);
  x[4] = lo2f(v.z); x[5] = hi2f(v.z); x[6] = lo2f(v.w); x[7] = hi2f(v.w);
}
DI uint4 pack8(const float* x) {
  uint4 v; v.x = pack2(x[0], x[1]); v.y = pack2(x[2], x[3]); v.z = pack2(x[4], x[5]); v.w = pack2(x[6], x[7]); return v;
}
DI void unpack4(const uint2& v, float* x) { x[0] = lo2f(v.x); x[1] = hi2f(v.x); x[2] = lo2f(v.y); x[3] = hi2f(v.y); }
DI uint2 pack4(const float* x) { uint2 v; v.x = pack2(x[0], x[1]); v.y = pack2(x[2], x[3]); return v; }
DI float red8(float v) { v += __shfl_xor(v, 1); v += __shfl_xor(v, 2); v += __shfl_xor(v, 4); return v; }
DI float red32(float v) { v = red8(v); v += __shfl_xor(v, 8); v += __shfl_xor(v, 16); return v; }
DI float red64(float v) { v = red32(v); v += __shfl_xor(v, 32); return v; }
DI float sigmoidf_(float x) { return 1.f / (1.f + __expf(-x)); }
DI float siluf_(float x) { return x / (1.f + __expf(-x)); }
DI int crow(int e, int h) { return (e & 3) + 8 * (e >> 2) + 4 * h; }
DI f32x16 zero16() { f32x16 z; for (int i = 0; i < 16; ++i) z[i] = 0.f; return z; }

template <int NJ>
DI void gemm_core(const bf16_t* __restrict__ A, int lda, const bf16_t* __restrict__ Bt, int ldb, int K,
                  f32x16 (&acc)[2][NJ], char* smem) {
  const int tid = get_tid(), lane = tid & 63, w = tid >> 6, r = lane & 31, h = lane >> 5;
  const int wm = w >> 1, wn = w & 1;
  bf16_t* As = (bf16_t*)smem;
  bf16_t* Bs = As + 2 * 256 * 72;
  uint4 ra[4], rb[NJ];
  const int nk = K >> 6;
  const bf16_t* Ag = A + (size_t)(tid >> 3) * lda + (tid & 7) * 8;
  const bf16_t* Bg = Bt + (size_t)(tid >> 3) * ldb + (tid & 7) * 8;
  bf16_t* Asw = As + (tid >> 3) * 72 + (tid & 7) * 8;
  bf16_t* Bsw = Bs + (tid >> 3) * 72 + (tid & 7) * 8;
  __syncthreads();
#pragma unroll
  for (int i = 0; i < 4; ++i) ra[i] = *(const uint4*)(Ag + (size_t)(64 * i) * lda);
#pragma unroll
  for (int i = 0; i < NJ; ++i) rb[i] = *(const uint4*)(Bg + (size_t)(64 * i) * ldb);
#pragma unroll
  for (int i = 0; i < 4; ++i) *(uint4*)(Asw + 64 * i * 72) = ra[i];
#pragma unroll
  for (int i = 0; i < NJ; ++i) *(uint4*)(Bsw + 64 * i * 72) = rb[i];
  __syncthreads();
  for (int kt = 0; kt < nk; ++kt) {
    const int buf = kt & 1;
    if (kt + 1 < nk) {
      const int ko = (kt + 1) * 64;
#pragma unroll
      for (int i = 0; i < 4; ++i) ra[i] = *(const uint4*)(Ag + (size_t)(64 * i) * lda + ko);
#pragma unroll
      for (int i = 0; i < NJ; ++i) rb[i] = *(const uint4*)(Bg + (size_t)(64 * i) * ldb + ko);
    }
    const bf16_t* Ab = As + (buf * 256 + 64 * wm + r) * 72 + h * 8;
    const bf16_t* Bb = Bs + (buf * 64 * NJ + 32 * NJ * wn + r) * 72 + h * 8;
#pragma unroll
    for (int ks = 0; ks < 4; ++ks) {
      bf16x8 a0 = *(const bf16x8*)(Ab + ks * 16);
      bf16x8 a1 = *(const bf16x8*)(Ab + 32 * 72 + ks * 16);
#pragma unroll
      for (int j = 0; j < NJ; ++j) {
        bf16x8 b0 = *(const bf16x8*)(Bb + j * 32 * 72 + ks * 16);
        acc[0][j] = MFMA32(a0, b0, acc[0][j]);
        acc[1][j] = MFMA32(a1, b0, acc[1][j]);
      }
    }
    if (kt + 1 < nk) {
      const int nb = buf ^ 1;
#pragma unroll
      for (int i = 0; i < 4; ++i) *(uint4*)(Asw + (nb * 256 + 64 * i) * 72) = ra[i];
#pragma unroll
      for (int i = 0; i < NJ; ++i) *(uint4*)(Bsw + (nb * 64 * NJ + 64 * i) * 72) = rb[i];
    }
    __syncthreads();
  }
}

template <int NJ>
DI void store_tile_bf16(const f32x16 (&acc)[2][NJ], bf16_t* dst, int ld, int ncols) {
  const int tid = get_tid(), lane = tid & 63, w = tid >> 6, r = lane & 31, h = lane >> 5;
  const int wm = w >> 1, wn = w & 1;
#pragma unroll
  for (int i = 0; i < 2; ++i)
#pragma unroll
    for (int j = 0; j < NJ; ++j) {
      const int col = 32 * NJ * wn + 32 * j + r;
      if (col < ncols) {
        bf16_t* d0 = dst + (size_t)(64 * wm + 32 * i + 4 * h) * ld + col;
#pragma unroll
        for (int e = 0; e < 16; ++e) d0[(size_t)((e & 3) + 8 * (e >> 2)) * ld] = f2bf(acc[i][j][e]);
      }
    }
}

DI void transpose_job(const float* __restrict__ src, int K, int N, bf16_t* __restrict__ dst, int Npad, char* smem) {
  float* tS = (float*)smem;
  const int tid = get_tid();
  const int ntk = K >> 6, ntn = Npad >> 6;
  for (int tile = get_bid(); tile < ntk * ntn; tile += gridDim.x) {
    const int kt = tile % ntk, nt = tile / ntk;
    __syncthreads();
    {
      const int kk = tid >> 3, c8 = (tid & 7) * 8;
      const int col = nt * 64 + c8;
      float v[8];
      if (col < N) {
        const float4 a = *(const float4*)(src + (size_t)(kt * 64 + kk) * N + col);
        const float4 b = *(const float4*)(src + (size_t)(kt * 64 + kk) * N + col + 4);
        v[0] = a.x; v[1] = a.y; v[2] = a.z; v[3] = a.w; v[4] = b.x; v[5] = b.y; v[6] = b.z; v[7] = b.w;
      } else {
#pragma unroll
        for (int e = 0; e < 8; ++e) v[e] = 0.f;
      }
#pragma unroll
      for (int e = 0; e < 8; ++e) tS[kk * 65 + c8 + e] = v[e];
    }
    __syncthreads();
    {
      const int n = tid >> 3, k8 = (tid & 7) * 8;
      float v[8];
#pragma unroll
      for (int e = 0; e < 8; ++e) v[e] = tS[(k8 + e) * 65 + n];
      *(uint4*)(dst + (size_t)(nt * 64 + n) * K + kt * 64 + k8) = pack8(v);
    }
  }
}

DI void phase_prep(const Params& p, char* smem) {
  const int tid = get_tid();
  char* ws = p.ws;
  if (get_bid() == 0 && tid < 64) ((int*)(ws + OFF_CTR))[tid] = 0;
  for (int l = 0; l < 2; ++l) {
    transpose_job(p.in[I_WIN] + (size_t)l * 1024 * LDP, 1024, LDP, (bf16_t*)(ws + OFF_WINT) + (size_t)l * NPAD * 1024, NPAD, smem);
    for (int i = 0; i < 4; ++i) {
      transpose_job(p.in[I_MGW] + (size_t)(l * 4 + i) * 1024 * 1024, 1024, 1024, (bf16_t*)(ws + OFF_MGT) + (size_t)(l * 4 + i) * 1024 * 1024, 1024, smem);
      transpose_job(p.in[I_WBR] + (size_t)(l * 4 + i) * 512 * 1024, 512, 1024, (bf16_t*)(ws + OFF_BRT) + (size_t)(l * 4 + i) * 1024 * 512, 1024, smem);
    }
    transpose_job(p.in[I_WOUT] + (size_t)l * 1024 * 1024, 1024, 1024, (bf16_t*)(ws + OFF_OUTT) + (size_t)l * 1024 * 1024, 1024, smem);
    transpose_job(p.in[I_MLAWUQ] + (size_t)l * 256 * 768, 256, 768, (bf16_t*)(ws + OFF_WUQT) + (size_t)l * 768 * 256, 768, smem);
    transpose_job(p.in[I_MLAWUKV] + (size_t)l * 256 * 1024, 256, 1024, (bf16_t*)(ws + OFF_WUKVT) + (size_t)l * 1024 * 256, 1024, smem);
  }
  {
    float* sv = (float*)smem;
    float* red = sv + 3 * 1024;
    float* modv = (float*)(ws + OFF_MODV);
    for (int job = get_bid(); job < 96; job += gridDim.x) {
      const int l = job / 48, cg0 = (job % 48) * 64;
      __syncthreads();
      for (int i = tid; i < 3072; i += 512) {
        const int rr = i >> 10, k = i & 1023;
        const float cv = (rr < 2) ? p.in[I_C][rr * 1024 + k] : p.in[I_CCTX][k];
        sv[i] = siluf_(cv);
      }
      __syncthreads();
      const int cl = tid & 63, ks = tid >> 6;
      float a0 = 0.f, a1 = 0.f, a2 = 0.f;
      const float* mw = p.in[I_MODW] + (size_t)l * 1024 * 3072 + cg0 + cl;
      for (int k = ks * 128; k < ks * 128 + 128; ++k) {
        const float wv = mw[(size_t)k * 3072];
        a0 += sv[k] * wv; a1 += sv[1024 + k] * wv; a2 += sv[2048 + k] * wv;
      }
      red[(ks * 3 + 0) * 64 + cl] = a0; red[(ks * 3 + 1) * 64 + cl] = a1; red[(ks * 3 + 2) * 64 + cl] = a2;
      __syncthreads();
      if (tid < 192) {
        const int rr = tid >> 6, c = tid & 63;
        float s = 0.f;
        for (int q = 0; q < 8; ++q) s += red[(q * 3 + rr) * 64 + c];
        modv[(l * 3 + rr) * 3072 + cg0 + c] = s + p.in[I_MODB][l * 3072 + cg0 + c];
      }
    }
  }
  {
    float* cosH = (float*)(ws + OFF_ROPE);
    float* sinH = cosH + SEQ * 32;
    float* cosM = sinH + SEQ * 32;
    float* sinM = cosM + SEQ * 16;
    for (int idx = get_bid() * 512 + tid; idx < SEQ * 48; idx += gridDim.x * 512) {
      if (idx < SEQ * 32) {
        const int t = idx >> 5, i = idx & 31, f = i & 15;
        const float pos = (i < 16) ? (float)(t >> 6) : (float)(t & 63);
        const float inv = exp2f(-(float)f * (13.287712379549449f / 16.f));
        const float ang = pos * inv;
        cosH[idx] = cosf(ang); sinH[idx] = sinf(ang);
      } else {
        const int j = idx - SEQ * 32;
        const int t = j >> 4, i = j & 15, f = i & 7;
        const float pos = (i < 8) ? (float)(t >> 6) : (float)(t & 63);
        const float inv = exp2f(-(float)f * (13.287712379549449f / 8.f));
        const float ang = pos * inv;
        cosM[j] = cosf(ang); sinM[j] = sinf(ang);
      }
    }
  }
}

DI void phase_h(const Params& p, int l, int b) {
  const int tid = get_tid(), lane = tid & 63, w = tid >> 6;
  const float* xin = (l == 0) ? p.in[I_X] : p.out;
  const float* cin = (l == 0) ? p.in[I_CTX] : (const float*)(p.ws + OFF_CX1);
  const float* ng = p.in[I_NORMG] + l * 1024;
  const float* modv = (const float*)(p.ws + OFF_MODV);
  bf16_t* H = (bf16_t*)(p.ws + OFF_H);
  for (int row = get_bid() * 8 + w; row < TR; row += gridDim.x * 8) {
    const float* src; const float* mv;
    if (row < 256) { src = cin + ((size_t)b * 256 + row) * 1024; mv = modv + (l * 3 + 2) * 3072; }
    else { src = xin + ((size_t)b * SEQ + (row - 256)) * 1024; mv = modv + (l * 3 + b) * 3072; }
    float4 v[4];
    float ss = 0.f;
#pragma unroll
    for (int i = 0; i < 4; ++i) {
      v[i] = *(const float4*)(src + i * 256 + lane * 4);
      ss += v[i].x * v[i].x + v[i].y * v[i].y + v[i].z * v[i].z + v[i].w * v[i].w;
    }
    ss = red64(ss);
    const float rs = rsqrtf(ss * (1.f / 1024.f) + 1e-6f);
#pragma unroll
    for (int i = 0; i < 4; ++i) {
      const int c = i * 256 + lane * 4;
      const float4 g = *(const float4*)(ng + c);
      const float4 sh = *(const float4*)(mv + c);
      const float4 sc = *(const float4*)(mv + 1024 + c);
      float o[4];
      o[0] = v[i].x * rs * g.x * (1.f + sc.x) + sh.x;
      o[1] = v[i].y * rs * g.y * (1.f + sc.y) + sh.y;
      o[2] = v[i].z * rs * g.z * (1.f + sc.z) + sh.z;
      o[3] = v[i].w * rs * g.w * (1.f + sc.w) + sh.w;
      *(uint2*)(H + (size_t)row * 1024 + c) = pack4(o);
    }
  }
}

DI void phase_g1(const Params& p, int l, char* smem) {
  const bf16_t* H = (const bf16_t*)(p.ws + OFF_H);
  const bf16_t* W = (const bf16_t*)(p.ws + OFF_WINT) + (size_t)l * NPAD * 1024;
  bf16_t* P = (bf16_t*)(p.ws + OFF_P);
  for (int tile = get_bid(); tile < 65 * 53; tile += gridDim.x) {
    const int mt = tile % 65, nt = tile / 65;
    f32x16 acc[2][2];
    acc[0][0] = zero16(); acc[0][1] = zero16(); acc[1][0] = zero16(); acc[1][1] = zero16();
    gemm_core<2>(H + (size_t)mt * 256 * 1024, 1024, W + (size_t)nt * 128 * 1024, 1024, 1024, acc, smem);
    store_tile_bf16<2>(acc, P + (size_t)mt * 256 * LDP + nt * 128, LDP, LDP - nt * 128);
  }
}

DI int swap23(int p) { return (p & 3) | ((p & 4) << 1) | ((p & 8) >> 1); }
DI void vt_tile(const bf16_t* __restrict__ src, int ld, bf16_t* __restrict__ dst, int tok0, char* smem) {
  bf16_t* tS = (bf16_t*)smem;
  const int tid = get_tid();
  __syncthreads();
  {
    const int tok = tid >> 3, c8 = (tid & 7) * 8;
    *(uint4*)(tS + tok * 72 + c8) = *(const uint4*)(src + (size_t)(tok0 + tok) * ld + c8);
  }
  __syncthreads();
  {
    const int dv = tid >> 3, pc = tid & 7;
    unsigned short v[8];
#pragma unroll
    for (int j = 0; j < 8; ++j) {
      const int pos = 8 * pc + j;
      const int tokoff = (pos & ~15) | swap23(pos & 15);
      v[j] = tS[tokoff * 72 + dv];
    }
    uint4 o;
    o.x = v[0] | ((unsigned)v[1] << 16); o.y = v[2] | ((unsigned)v[3] << 16);
    o.z = v[4] | ((unsigned)v[5] << 16); o.w = v[6] | ((unsigned)v[7] << 16);
    *(uint4*)(dst + (size_t)dv * TR + tok0 + 8 * pc) = o;
  }
}

DI void phase_post(const Params& p, int l, char* smem) {
  const int tid = get_tid(), lane = tid & 63, w = tid >> 6;
  bf16_t* P = (bf16_t*)(p.ws + OFF_P);
  const float* cosH = (const float*)(p.ws + OFF_ROPE);
  const float* sinH = cosH + SEQ * 32;
  const int m = lane & 7;
  for (int row = get_bid() * 8 + w; row < TR; row += gridDim.x * 8) {
    bf16_t* Pr = P + (size_t)row * LDP;
    float x[8];
    {
      uint4 v = *(const uint4*)(Pr + A_Q + lane * 8); unpack8(v, x);
      float ss = 0.f;
#pragma unroll
      for (int e = 0; e < 8; ++e) ss += x[e] * x[e];
      ss = red8(ss);
      const float rs = rsqrtf(ss * (1.f / 64.f) + 1e-6f) * SC64;
#pragma unroll
      for (int e = 0; e < 8; ++e) x[e] = x[e] * rs * p.in[I_NAQG][l * 64 + m * 8 + e];
      *(uint4*)(Pr + A_Q + lane * 8) = pack8(x);
    }
    {
      uint4 v = *(const uint4*)(Pr + A_K + lane * 8); unpack8(v, x);
      float ss = 0.f;
#pragma unroll
      for (int e = 0; e < 8; ++e) ss += x[e] * x[e];
      ss = red8(ss);
      const float rs = rsqrtf(ss * (1.f / 64.f) + 1e-6f);
#pragma unroll
      for (int e = 0; e < 8; ++e) x[e] = x[e] * rs * p.in[I_NAKG][l * 64 + m * 8 + e];
      *(uint4*)(Pr + A_K + lane * 8) = pack8(x);
    }
#pragma unroll
    for (int which = 0; which < 2; ++which) {
      const int lc = which ? (lane & 15) : lane;
      bf16_t* ptr = Pr + (which ? D_K : D_Q) + lc * 8;
      const float* gg = (which ? p.in[I_GQAKG] : p.in[I_GQAQG]) + l * 64 + m * 8;
      uint4 v = *(const uint4*)ptr; unpack8(v, x);
      float ss = 0.f;
#pragma unroll
      for (int e = 0; e < 8; ++e) ss += x[e] * x[e];
      ss = red8(ss);
      const float rs = rsqrtf(ss * (1.f / 64.f) + 1e-6f);
#pragma unroll
      for (int e = 0; e < 8; ++e) x[e] = x[e] * rs * gg[e];
      if (row >= 256) {
        const int t = row - 256;
        const float sgn = (m < 4) ? -1.f : 1.f;
#pragma unroll
        for (int e = 0; e < 8; ++e) {
          const float pr = __shfl_xor(x[e], 4);
          const int i = 8 * (m & 3) + e;
          const float c = cosH[t * 32 + i], s = sinH[t * 32 + i];
          x[e] = x[e] * c + sgn * pr * s;
        }
      }
      if (!which) {
#pragma unroll
        for (int e = 0; e < 8; ++e) x[e] *= SC64;
      }
      if (!which || lane < 16) *(uint4*)ptr = pack8(x);
    }
    {
      const int hh = lane >> 5, li = lane & 31;
      bf16_t* ptr = Pr + C_CQ + 256 * hh + li * 8;
      const float* gg = (hh ? p.in[I_MLAKVAG] : p.in[I_MLAQAG]) + l * 256 + li * 8;
      uint4 v = *(const uint4*)ptr; unpack8(v, x);
      float ss = 0.f;
#pragma unroll
      for (int e = 0; e < 8; ++e) ss += x[e] * x[e];
      ss = red32(ss);
      const float rs = rsqrtf(ss * (1.f / 256.f) + 1e-6f);
#pragma unroll
      for (int e = 0; e < 8; ++e) x[e] = x[e] * rs * gg[e];
      *(uint4*)ptr = pack8(x);
    }
  }
  for (int tile = get_bid(); tile < 260 * 10; tile += gridDim.x) {
    const int tt = tile % 260, hd = tile / 260;
    if (hd < 8) vt_tile(P + A_V + hd * 64, LDP, (bf16_t*)(p.ws + OFF_VTA) + (size_t)hd * 64 * TR, tt * 64, smem);
    else vt_tile(P + D_V + (hd - 8) * 64, LDP, (bf16_t*)(p.ws + OFF_VTD) + (size_t)(hd - 8) * 64 * TR, tt * 64, smem);
  }
}

DI void phase_mlaproj(const Params& p, int l, char* smem) {
  const bf16_t* P = (const bf16_t*)(p.ws + OFF_P);
  for (int tile = get_bid(); tile < 65 * 14; tile += gridDim.x) {
    const int mt = tile % 65, nt = tile / 65;
    f32x16 acc[2][2];
    acc[0][0] = zero16(); acc[0][1] = zero16(); acc[1][0] = zero16(); acc[1][1] = zero16();
    if (nt < 6) {
      gemm_core<2>(P + (size_t)mt * 256 * LDP + C_CQ, LDP, (const bf16_t*)(p.ws + OFF_WUQT) + (size_t)l * 768 * 256 + (size_t)nt * 128 * 256, 256, 256, acc, smem);
      store_tile_bf16<2>(acc, (bf16_t*)(p.ws + OFF_QM) + (size_t)mt * 256 * 768 + nt * 128, 768, 128);
    } else {
      const int n2 = nt - 6;
      gemm_core<2>(P + (size_t)mt * 256 * LDP + C_CKV, LDP, (const bf16_t*)(p.ws + OFF_WUKVT) + (size_t)l * 1024 * 256 + (size_t)n2 * 128 * 256, 256, 256, acc, smem);
      store_tile_bf16<2>(acc, (bf16_t*)(p.ws + OFF_KVRAW) + (size_t)mt * 256 * 1024 + n2 * 128, 1024, 128);
    }
  }
}

DI void phase_mlapost(const Params& p, int l, char* smem) {
  const int tid = get_tid(), lane = tid & 63, w = tid >> 6;
  const bf16_t* P = (const bf16_t*)(p.ws + OFF_P);
  bf16_t* Qm = (bf16_t*)(p.ws + OFF_QM);
  const bf16_t* KV = (const bf16_t*)(p.ws + OFF_KVRAW);
  bf16_t* Km = (bf16_t*)(p.ws + OFF_KM);
  const float* cosM = (const float*)(p.ws + OFF_ROPE) + SEQ * 64;
  const float* sinM = cosM + SEQ * 16;
  const int hh = lane >> 3, m = lane & 7;
  for (int row = get_bid() * 8 + w; row < TR; row += gridDim.x * 8) {
#pragma unroll
    for (int which = 0; which < 2; ++which) {
      float x[12];
      const bf16_t* pn = which ? (KV + (size_t)row * 1024 + hh * 128 + 8 * m) : (Qm + (size_t)row * 768 + hh * 96 + 8 * m);
      const bf16_t* pt = which ? (P + (size_t)row * LDP + C_KR + 4 * m) : (Qm + (size_t)row * 768 + hh * 96 + 64 + 4 * m);
      const float* gg = (which ? p.in[I_MLAKG] : p.in[I_MLAQG]) + l * 96;
      uint4 vn = *(const uint4*)pn; uint2 vt = *(const uint2*)pt;
      unpack8(vn, x); unpack4(vt, x + 8);
      float ss = 0.f;
#pragma unroll
      for (int e = 0; e < 12; ++e) ss += x[e] * x[e];
      ss = red8(ss);
      const float rs = rsqrtf(ss * (1.f / 96.f) + 1e-6f);
#pragma unroll
      for (int e = 0; e < 8; ++e) x[e] = x[e] * rs * gg[8 * m + e];
#pragma unroll
      for (int e = 0; e < 4; ++e) x[8 + e] = x[8 + e] * rs * gg[64 + 4 * m + e];
      if (row >= 256) {
        const int t = row - 256;
        const float sgn = (m < 4) ? -1.f : 1.f;
#pragma unroll
        for (int e = 0; e < 4; ++e) {
          const float pr = __shfl_xor(x[8 + e], 4);
          const int i = 4 * (m & 3) + e;
          const float c = cosM[t * 16 + i], s = sinM[t * 16 + i];
          x[8 + e] = x[8 + e] * c + sgn * pr * s;
        }
      }
      if (!which) {
#pragma unroll
        for (int e = 0; e < 12; ++e) x[e] *= SC96;
      }
      bf16_t* dn = which ? (Km + (size_t)row * 768 + hh * 96 + 8 * m) : (Qm + (size_t)row * 768 + hh * 96 + 8 * m);
      bf16_t* dt = which ? (Km + (size_t)row * 768 + hh * 96 + 64 + 4 * m) : (Qm + (size_t)row * 768 + hh * 96 + 64 + 4 * m);
      *(uint4*)dn = pack8(x);
      *(uint2*)dt = pack4(x + 8);
    }
  }
  for (int tile = get_bid(); tile < 260 * 8; tile += gridDim.x) {
    const int tt = tile % 260, hd = tile / 260;
    vt_tile(KV + hd * 128 + 64, 1024, (bf16_t*)(p.ws + OFF_VTM) + (size_t)hd * 64 * TR, tt * 64, smem);
  }
}

template <int DK>
DI void attn_item(const bf16_t* __restrict__ Qp, int ldq, const bf16_t* __restrict__ Kp, int ldk,
                  const bf16_t* __restrict__ Vt, bf16_t* __restrict__ Gp, int ldg, int q0,
                  int r0a, int n0, int r1a, int n1, int na_mode, const float* __restrict__ rpb, char* smem) {
  constexpr int KS = DK / 16, LK = DK + 8, CPR = DK / 8;
  const int tid = get_tid(), lane = tid & 63, w = tid >> 6, r = lane & 31, h = lane >> 5;
  bf16_t* Ks = (bf16_t*)smem;
  bf16_t* Vs = Ks + 2 * 64 * LK;
  float* rpbS = (float*)(Vs + 2 * 64 * 72);
  __syncthreads();
  if (na_mode) for (int i = tid; i < 465; i += 512) rpbS[i] = rpb[i] * LOG2E;
  const int qrow = q0 + 32 * w + r;
  bf16x8 qf[KS];
#pragma unroll
  for (int ks = 0; ks < KS; ++ks) qf[ks] = *(const bf16x8*)(Qp + (size_t)qrow * ldq + ks * 16 + h * 8);
  f32x16 o[2]; o[0] = zero16(); o[1] = zero16();
  float mrun = -1e30f, lsum = 0.f;
  const int ntiles = n0 + n1;
  const int tq = qrow - 256;
  const int qr = tq >> 6, qc = tq & 63;
  const int rs = min(max(qr - 4, 0), 248), cs = min(max(qc - 8, 0), 48);
  uint4 rk0, rk1, rv;
  rk1 = make_uint4(0, 0, 0, 0);
  auto gload = [&](int ti) {
    const int rowstart = (ti < n0) ? (r0a + 64 * ti) : (r1a + 64 * (ti - n0));
    { const int c = tid; rk0 = *(const uint4*)(Kp + (size_t)(rowstart + c / CPR) * ldk + (c % CPR) * 8); }
    if (CPR == 12 && tid < 256) { const int c = tid + 512; rk1 = *(const uint4*)(Kp + (size_t)(rowstart + c / CPR) * ldk + (c % CPR) * 8); }
    rv = *(const uint4*)(Vt + (size_t)(tid >> 3) * TR + rowstart + (tid & 7) * 8);
  };
  auto sstore = [&](int buf) {
    { const int c = tid; *(uint4*)(Ks + (buf * 64 + c / CPR) * LK + (c % CPR) * 8) = rk0; }
    if (CPR == 12 && tid < 256) { const int c = tid + 512; *(uint4*)(Ks + (buf * 64 + c / CPR) * LK + (c % CPR) * 8) = rk1; }
    *(uint4*)(Vs + (buf * 64 + (tid >> 3)) * 72 + (tid & 7) * 8) = rv;
  };
  gload(0); sstore(0);
  __syncthreads();
  for (int ti = 0; ti < ntiles; ++ti) {
    const int buf = ti & 1;
    if (ti + 1 < ntiles) gload(ti + 1);
    f32x16 s[2]; s[0] = zero16(); s[1] = zero16();
#pragma unroll
    for (int kt2 = 0; kt2 < 2; ++kt2) {
      const bf16_t* kb = Ks + (buf * 64 + 32 * kt2 + r) * LK + h * 8;
#pragma unroll
      for (int ks = 0; ks < KS; ++ks) {
        bf16x8 a = *(const bf16x8*)(kb + ks * 16);
        s[kt2] = MFMA32(a, qf[ks], s[kt2]);
      }
    }
    if (na_mode && ti >= n0) {
      const int kr = ((r1a - 256) >> 6) + (ti - n0);
      const bool rowok = (kr >= rs) && (kr <= rs + 7);
      const int dr = kr - qr + 7;
#pragma unroll
      for (int kt2 = 0; kt2 < 2; ++kt2)
#pragma unroll
        for (int e = 0; e < 16; ++e) {
          const int kc = 32 * kt2 + crow(e, h);
          const bool ok = rowok && (kc >= cs) && (kc <= cs + 15);
          const int idx = ok ? (dr * 31 + (kc - qc + 15)) : 0;
          const float bv = rpbS[idx];
          s[kt2][e] = ok ? (s[kt2][e] + bv) : -1e30f;
        }
    }
    float mx = -1e30f;
#pragma unroll
    for (int e = 0; e < 16; ++e) mx = fmaxf(mx, fmaxf(s[0][e], s[1][e]));
    mx = fmaxf(mx, __shfl_xor(mx, 32));
    const float mnew = fmaxf(mrun, mx);
    const float alpha = __builtin_amdgcn_exp2f(mrun - mnew);
    mrun = mnew;
    float ps = 0.f;
#pragma unroll
    for (int kt2 = 0; kt2 < 2; ++kt2)
#pragma unroll
      for (int e = 0; e < 16; ++e) { const float pv = __builtin_amdgcn_exp2f(s[kt2][e] - mnew); s[kt2][e] = pv; ps += pv; }
    lsum = lsum * alpha + ps;
#pragma unroll
    for (int e = 0; e < 16; ++e) { o[0][e] *= alpha; o[1][e] *= alpha; }
#pragma unroll
    for (int kt2 = 0; kt2 < 2; ++kt2)
#pragma unroll
      for (int sx = 0; sx < 2; ++sx) {
        uint4 pk;
        pk.x = pack2(s[kt2][8 * sx + 0], s[kt2][8 * sx + 1]);
        pk.y = pack2(s[kt2][8 * sx + 2], s[kt2][8 * sx + 3]);
        pk.z = pack2(s[kt2][8 * sx + 4], s[kt2][8 * sx + 5]);
        pk.w = pack2(s[kt2][8 * sx + 6], s[kt2][8 * sx + 7]);
        const bf16x8 pf = __builtin_bit_cast(bf16x8, pk);
#pragma unroll
        for (int d2 = 0; d2 < 2; ++d2) {
          bf16x8 a = *(const bf16x8*)(Vs + (buf * 64 + 32 * d2 + r) * 72 + 32 * kt2 + 16 * sx + 8 * h);
          o[d2] = MFMA32(a, pf, o[d2]);
        }
      }
    if (ti + 1 < ntiles) sstore(buf ^ 1);
    __syncthreads();
  }
  const float lt = lsum + __shfl_xor(lsum, 32);
  const float inv = 1.f / lt;
#pragma unroll
  for (int d2 = 0; d2 < 2; ++d2)
#pragma unroll
    for (int gq = 0; gq < 4; ++gq) {
      const int dv0 = 32 * d2 + 8 * gq + 4 * h;
      bf16_t* ptr = Gp + (size_t)qrow * ldg + dv0;
      uint2 gv = *(const uint2*)ptr;
      float g[4]; unpack4(gv, g);
      float y[4];
#pragma unroll
      for (int e = 0; e < 4; ++e) y[e] = o[d2][4 * gq + e] * inv * siluf_(g[e]);
      *(uint2*)ptr = pack4(y);
    }
}

typedef __attribute__((ext_vector_type(2))) float v2f;
DI float dpp_x1(float v) { return __builtin_bit_cast(float, __builtin_amdgcn_update_dpp(0, __builtin_bit_cast(int, v), 0xB1, 0xF, 0xF, true)); }
DI float dpp_x2(float v) { return __builtin_bit_cast(float, __builtin_amdgcn_update_dpp(0, __builtin_bit_cast(int, v), 0x4E, 0xF, 0xF, true)); }
DI float dpp_hm(float v) { return __builtin_bit_cast(float, __builtin_amdgcn_update_dpp(0, __builtin_bit_cast(int, v), 0x141, 0xF, 0xF, true)); }
DI float dpp_rm(float v) { return __builtin_bit_cast(float, __builtin_amdgcn_update_dpp(0, __builtin_bit_cast(int, v), 0x140, 0xF, 0xF, true)); }
DI float dpp_red8(float v) { v += dpp_x1(v); v += dpp_x2(v); v += dpp_hm(v); return v; }
DI float dpp_red16(float v) { v += dpp_x1(v); v += dpp_x2(v); v += dpp_hm(v); v += dpp_rm(v); return v; }
DI float fast_tanh(float x) { return 1.f - 2.f * __builtin_amdgcn_rcpf(1.f + __expf(2.f * x)); }
DI float fast_sigmoid(float x) { return __builtin_amdgcn_rcpf(1.f + __expf(-x)); }

struct ScanVec { float4 w, k, b, n, r; float v; };
DI void scan_load(ScanVec& sv, const float* cb, const float* vb) {
  sv.w = *(const float4*)(cb);
  sv.k = *(const float4*)(cb + 2048);
  sv.b = *(const float4*)(cb + 2 * 2048);
  sv.n = *(const float4*)(cb + 3 * 2048);
  sv.r = *(const float4*)(cb + 4 * 2048);
  sv.v = *vb;
}

DI void scan_item(const Params& p, int l, int hd, int d, int rp, char* smem) {
  const int tid = get_tid(), lane = tid & 63, w = tid >> 6;
  float* CH = (float*)smem;
  float* YC = CH + 2 * 6 * 2048;
  bf16_t* W2T = (bf16_t*)(YC + 1024);
  bf16_t* XW = W2T + 2 * 64 * 72;
  float* LO = (float*)(XW + 4 * 2 * 8 * 72);
  const bf16_t* P = (const bf16_t*)(p.ws + OFF_P);
  bf16_t* Yd = (bf16_t*)(p.ws + (d ? OFF_Y1 : OFF_Y0));
  float* Cb = (float*)(p.ws + OFF_CB) + (size_t)d * TR * 8;
  __syncthreads();
  {
    const float* w2 = p.in[I_RWW2] + (size_t)(l * 2 + d) * 64 * 512 + hd * 64;
    const float* a2 = p.in[I_RWA2] + (size_t)(l * 2 + d) * 64 * 512 + hd * 64;
    for (int i = tid; i < 4096; i += 512) {
      const int j = i >> 6, c = i & 63;
      W2T[c * 72 + j] = f2bf(w2[(size_t)j * 512 + c]);
      W2T[64 * 72 + c * 72 + j] = f2bf(a2[(size_t)j * 512 + c]);
    }
  }
  __syncthreads();
  const int NCH = 520;
  v2f S01 = {0.f, 0.f}, S23 = {0.f, 0.f};
  const float* mu = p.in[I_RWMU] + l * 1792;
  for (int ci = 0; ci <= NCH + 1; ++ci) {
    if (w >= 4) {
      const int pw = w - 4;
      if (ci < NCH) {
        const int buf = ci & 1;
        int segbase, seglen, cs;
        if (ci < 8) { segbase = 0; seglen = 256; cs = d ? (7 - ci) : ci; }
        else { segbase = 256; seglen = SEQ; cs = d ? (511 - (ci - 8)) : (ci - 8); }
        const int tl = lane >> 3, m = lane & 7;
        const int tc = 8 * pw + tl;
        const int t = 32 * cs + tc;
        const size_t row = (size_t)(segbase + t);
        const bool hm = t > 0, hp = t < seglen - 1;
        float xr[8], xk[8], xv[8], xw[8], xa[8];
        const int cols[5] = {B_U + hd * 64 + 8 * m, B_U + 512 + hd * 64 + 8 * m, B_U + 1024 + hd * 64 + 8 * m,
                             B_U + 1536 + d * 64 + 8 * m, B_U + 1664 + d * 64 + 8 * m};
        uint4 r0[5], rm[5], rq[5];
#pragma unroll
        for (int vv = 0; vv < 5; ++vv) {
          const bf16_t* pc = P + row * LDP + cols[vv];
          r0[vv] = *(const uint4*)pc;
          rm[vv] = hm ? *(const uint4*)(pc - LDP) : make_uint4(0, 0, 0, 0);
          rq[vv] = hp ? *(const uint4*)(pc + LDP) : make_uint4(0, 0, 0, 0);
        }
#pragma unroll
        for (int vv = 0; vv < 5; ++vv) {
          float* dst = (vv == 0) ? xr : (vv == 1) ? xk : (vv == 2) ? xv : (vv == 3) ? xw : xa;
          float u0[8], um[8], up[8];
          unpack8(r0[vv], u0); unpack8(rm[vv], um); unpack8(rq[vv], up);
          const float* mp = mu + (cols[vv] - B_U);
          const float4 m0 = *(const float4*)mp, m1 = *(const float4*)(mp + 4);
          const float mm[8] = {m0.x, m0.y, m0.z, m0.w, m1.x, m1.y, m1.z, m1.w};
#pragma unroll
          for (int e = 0; e < 8; ++e) dst[e] = u0[e] + mm[e] * (0.5f * (um[e] + up[e]) - u0[e]);
        }
        const int c0 = hd * 64 + 8 * m;
        float kk[8];
        {
          const float4 q0 = *(const float4*)(p.in[I_RWKK] + l * 512 + c0), q1 = *(const float4*)(p.in[I_RWKK] + l * 512 + c0 + 4);
          const float qq[8] = {q0.x, q0.y, q0.z, q0.w, q1.x, q1.y, q1.z, q1.w};
          float ss = 0.f;
#pragma unroll
          for (int e = 0; e < 8; ++e) { kk[e] = xk[e] * qq[e]; ss += kk[e] * kk[e]; }
          ss = dpp_red8(ss);
          const float rn = rsqrtf(ss + 1e-12f);
#pragma unroll
          for (int e = 0; e < 8; ++e) kk[e] *= rn;
        }
        bf16_t* xwp = XW + pw * (2 * 8 * 72);
        {
          float tw[8];
#pragma unroll
          for (int e = 0; e < 8; ++e) tw[e] = fast_tanh(xw[e]);
          *(uint4*)(xwp + tl * 72 + 8 * m) = pack8(tw);
          *(uint4*)(xwp + 8 * 72 + tl * 72 + 8 * m) = pack8(xa);
        }
        __builtin_amdgcn_fence(__ATOMIC_RELEASE, "wavefront");
        __builtin_amdgcn_wave_barrier();
        __builtin_amdgcn_fence(__ATOMIC_ACQUIRE, "wavefront");
        {
          const int r = lane & 31, h = lane >> 5;
          float* lop = LO + pw * (2 * 8 * 64);
#pragma unroll
          for (int mat = 0; mat < 2; ++mat) {
            f32x16 acc[2]; acc[0] = zero16(); acc[1] = zero16();
#pragma unroll
            for (int ks = 0; ks < 4; ++ks) {
              bf16x8 a;
              if (r < 8) a = *(const bf16x8*)(xwp + mat * 8 * 72 + r * 72 + ks * 16 + h * 8);
              else {
#pragma unroll
                for (int e = 0; e < 8; ++e) a[e] = 0;
              }
#pragma unroll
              for (int nt = 0; nt < 2; ++nt) {
                bf16x8 bb = *(const bf16x8*)(W2T + mat * 64 * 72 + (32 * nt + r) * 72 + ks * 16 + h * 8);
                acc[nt] = MFMA32(a, bb, acc[nt]);
              }
            }
#pragma unroll
            for (int nt = 0; nt < 2; ++nt)
#pragma unroll
              for (int e = 0; e < 4; ++e) lop[mat * 8 * 64 + (4 * h + e) * 64 + 32 * nt + r] = acc[nt][e];
          }
        }
        __builtin_amdgcn_fence(__ATOMIC_RELEASE, "wavefront");
        __builtin_amdgcn_wave_barrier();
        __builtin_amdgcn_fence(__ATOMIC_ACQUIRE, "wavefront");
        {
          const float* lop = LO + pw * (2 * 8 * 64);
          float* chb = CH + buf * (6 * 2048) + tc * 64 + 8 * m;
          const float4 lw0 = *(const float4*)(lop + tl * 64 + 8 * m), lw1 = *(const float4*)(lop + tl * 64 + 8 * m + 4);
          const float4 la0 = *(const float4*)(lop + 512 + tl * 64 + 8 * m), la1 = *(const float4*)(lop + 512 + tl * 64 + 8 * m + 4);
          const float lw[8] = {lw0.x, lw0.y, lw0.z, lw0.w, lw1.x, lw1.y, lw1.z, lw1.w};
          const float la[8] = {la0.x, la0.y, la0.z, la0.w, la1.x, la1.y, la1.z, la1.w};
          const float* pw0 = p.in[I_RWW0] + (l * 2 + d) * 512 + c0;
          const float* pa0 = p.in[I_RWA0] + (l * 2 + d) * 512 + c0;
          const float* pka = p.in[I_RWKA] + l * 512 + c0;
          const float* prk = p.in[I_RWRK] + l * 512 + c0;
          float bon = 0.f;
          float ow[8], okd[8], obd[8], onk[8];
#pragma unroll
          for (int e = 0; e < 8; ++e) {
            const float xwl = pw0[e] + lw[e];
            const float xal = pa0[e] + la[e];
            const float dec = __expf(-0.6065306597126334f * fast_sigmoid(xwl));
            const float a = fast_sigmoid(xal);
            const float kd = xk[e] * (1.f + (a - 1.f) * pka[e]);
            ow[e] = dec; okd[e] = kd; obd[e] = kk[e] * a; onk[e] = -kk[e];
            bon += xr[e] * kd * prk[e];
          }
          bon = dpp_red8(bon);
          if (m == 0 && rp == 0) Cb[row * 8 + hd] = bon;
          *(float4*)(chb + 0 * 2048) = make_float4(ow[0], ow[1], ow[2], ow[3]);
          *(float4*)(chb + 0 * 2048 + 4) = make_float4(ow[4], ow[5], ow[6], ow[7]);
          *(float4*)(chb + 1 * 2048) = make_float4(okd[0], okd[1], okd[2], okd[3]);
          *(float4*)(chb + 1 * 2048 + 4) = make_float4(okd[4], okd[5], okd[6], okd[7]);
          *(float4*)(chb + 2 * 2048) = make_float4(obd[0], obd[1], obd[2], obd[3]);
          *(float4*)(chb + 2 * 2048 + 4) = make_float4(obd[4], obd[5], obd[6], obd[7]);
          *(float4*)(chb + 3 * 2048) = make_float4(onk[0], onk[1], onk[2], onk[3]);
          *(float4*)(chb + 3 * 2048 + 4) = make_float4(onk[4], onk[5], onk[6], onk[7]);
          *(float4*)(chb + 4 * 2048) = make_float4(xr[0], xr[1], xr[2], xr[3]);
          *(float4*)(chb + 4 * 2048 + 4) = make_float4(xr[4], xr[5], xr[6], xr[7]);
          *(float4*)(chb + 5 * 2048) = make_float4(xv[0], xv[1], xv[2], xv[3]);
          *(float4*)(chb + 5 * 2048 + 4) = make_float4(xv[4], xv[5], xv[6], xv[7]);
        }
      }
      if (ci >= 2) {
        const int cj = ci - 2;
        int segbase, cs;
        if (cj < 8) { segbase = 0; cs = d ? (7 - cj) : cj; }
        else { segbase = 256; cs = d ? (511 - (cj - 8)) : (cj - 8); }
        const int ptid = tid - 256;
        const int tf = ptid >> 3, i2 = (ptid & 7) * 2;
        const float* yc = YC + (cj & 1) * 512 + tf * 16 + i2;
        const size_t row = (size_t)(segbase + 32 * cs + tf);
        *(unsigned*)(Yd + row * 512 + hd * 64 + 16 * rp + i2) = pack2(yc[0], yc[1]);
      }
    } else {
      if (ci >= 1 && ci <= NCH) {
        __builtin_amdgcn_s_setprio(3);
        const int cj = ci - 1;
        const int il = tid >> 4, js = tid & 15;
        const float* chb = CH + (cj & 1) * (6 * 2048) + 4 * js;
        const float* vb = CH + (cj & 1) * (6 * 2048) + 5 * 2048 + 16 * rp + il;
        float* yc = YC + (cj & 1) * 512 + il;
        const int tstep = d ? -64 : 64;
        const int t0 = d ? 31 * 64 : 0;
        ScanVec cur, nxt;
        scan_load(cur, chb + t0, vb + t0);
        int toff = t0;
#pragma unroll 4
        for (int sidx = 0; sidx < 32; ++sidx) {
          const int tn = (sidx < 31) ? (toff + tstep) : toff;
          scan_load(nxt, chb + tn, vb + tn);
          const v2f n01 = {cur.n.x, cur.n.y}, n23 = {cur.n.z, cur.n.w};
          v2f pa = S01 * n01;
          pa = S23 * n23 + pa;
          float sa = dpp_red16(pa.x + pa.y);
          const v2f k01 = {cur.k.x, cur.k.y}, k23 = {cur.k.z, cur.k.w};
          const v2f b01 = {cur.b.x, cur.b.y}, b23 = {cur.b.z, cur.b.w};
          const v2f w01 = {cur.w.x, cur.w.y}, w23 = {cur.w.z, cur.w.w};
          const v2f vv2 = {cur.v, cur.v}, sa2 = {sa, sa};
          v2f t01 = vv2 * k01, t23 = vv2 * k23;
          t01 = sa2 * b01 + t01; t23 = sa2 * b23 + t23;
          S01 = S01 * w01 + t01; S23 = S23 * w23 + t23;
          const v2f r01 = {cur.r.x, cur.r.y}, r23 = {cur.r.z, cur.r.w};
          v2f qa = S01 * r01;
          qa = S23 * r23 + qa;
          const float y = dpp_red16(qa.x + qa.y);
          if (js == 0) yc[(toff >> 6) * 16] = y;
          cur = nxt;
          toff = tn;
        }
        __builtin_amdgcn_s_setprio(0);
      }
    }
    __syncthreads();
  }
}

DI void phase_mix(const Params& p, int l, int lb, char* smem, int* s_item) {
  const int tid = get_tid();
  int* ctr = (int*)(p.ws + OFF_CTR) + lb;
  const bf16_t* P = (const bf16_t*)(p.ws + OFF_P);
  bf16_t* Pw = (bf16_t*)(p.ws + OFF_P);
  const int nctx = (l == 0) ? 24 : 0;
  const int total = 64 + 1024 + 512 + nctx;
  while (true) {
    __syncthreads();
    if (tid == 0) *s_item = atomicAdd(ctr, 1);
    __syncthreads();
    const int item = *s_item;
    if (item >= total) break;
    if (item < 64) {
      scan_item(p, l, item >> 3, (item >> 2) & 1, item & 3, smem);
    } else {
      int ty, hd, q0, n0 = 4, r1a = 0, n1 = 0, na = 0;
      if (item < 64 + 512) { const int it = item - 64; ty = 0; hd = it >> 6; q0 = 256 + 256 * (it & 63); n0 = 260; }
      else if (item < 64 + 1024) { const int it = item - 64 - 512; ty = 1; hd = it >> 6; q0 = 256 + 256 * (it & 63); n0 = 260; }
      else if (item < 64 + 1024 + 512) {
        const int it = item - 64 - 1024; ty = 2; hd = it >> 6; const int qt = it & 63; q0 = 256 + 256 * qt;
        const int rsmin = min(max(4 * qt - 4, 0), 248);
        const int rsend = min(max(4 * qt + 3 - 4, 0), 248) + 7;
        r1a = 256 + 64 * rsmin; n1 = rsend - rsmin + 1; na = 1;
      } else { const int it = item - 64 - 1024 - 512; ty = it >> 3; hd = it & 7; q0 = 0; }
      if (ty == 0) {
        attn_item<96>((const bf16_t*)(p.ws + OFF_QM) + hd * 96, 768, (const bf16_t*)(p.ws + OFF_KM) + hd * 96, 768,
                      (const bf16_t*)(p.ws + OFF_VTM) + (size_t)hd * 64 * TR, Pw + C_G + hd * 64, LDP, q0,
                      0, n0, 0, 0, 0, nullptr, smem);
      } else {
        const bf16_t* Qp = (ty == 1) ? (P + D_Q + hd * 64) : (P + A_Q + hd * 64);
        const bf16_t* Kp = (ty == 1) ? (P + D_K + (hd >> 2) * 64) : (P + A_K + hd * 64);
        const bf16_t* Vt = (ty == 1) ? ((const bf16_t*)(p.ws + OFF_VTD) + (size_t)(hd >> 2) * 64 * TR)
                                     : ((const bf16_t*)(p.ws + OFF_VTA) + (size_t)hd * 64 * TR);
        bf16_t* Gp = (ty == 1) ? (Pw + D_G + hd * 64) : (Pw + A_G + hd * 64);
        attn_item<64>(Qp, LDP, Kp, LDP, Vt, Gp, LDP, q0, 0, n0, r1a, n1, na,
                      p.in[I_NARPB] + (size_t)(l * 8 + hd) * 465, smem);
      }
    }
  }
}

DI void phase_fin(const Params& p, int l) {
  const int tid = get_tid(), lane = tid & 63, w = tid >> 6;
  bf16_t* P = (bf16_t*)(p.ws + OFF_P);
  const bf16_t* Y0 = (const bf16_t*)(p.ws + OFF_Y0);
  const bf16_t* Y1 = (const bf16_t*)(p.ws + OFF_Y1);
  const float* Cb = (const float*)(p.ws + OFF_CB);
  const float* mu = p.in[I_RWMU] + l * 1792 + 1024;
  const int hh = lane >> 3, c = lane * 8;
  for (int row = get_bid() * 8 + w; row < TR; row += gridDim.x * 8) {
    float a[8], b2[8], ys[8];
    unpack8(*(const uint4*)(Y0 + (size_t)row * 512 + c), a);
    unpack8(*(const uint4*)(Y1 + (size_t)row * 512 + c), b2);
    float sm = 0.f;
#pragma unroll
    for (int e = 0; e < 8; ++e) { ys[e] = a[e] + b2[e]; sm += ys[e]; }
    const float mean = red8(sm) * (1.f / 64.f);
    float vs = 0.f;
#pragma unroll
    for (int e = 0; e < 8; ++e) { const float dd = ys[e] - mean; vs += dd * dd; }
    const float var = red8(vs) * (1.f / 64.f);
    const float rstd = rsqrtf(var + 64e-5f);
    const int segb = (row < 256) ? 0 : 256, sege = (row < 256) ? 256 : TR;
    bf16_t* Pr = P + (size_t)row * LDP;
    float u0[8], um[8], up[8];
    unpack8(*(const uint4*)(Pr + B_U + 1024 + c), u0);
    if (row > segb) unpack8(*(const uint4*)(Pr - LDP + B_U + 1024 + c), um); else {
#pragma unroll
      for (int e = 0; e < 8; ++e) um[e] = 0.f;
    }
    if (row < sege - 1) unpack8(*(const uint4*)(Pr + LDP + B_U + 1024 + c), up); else {
#pragma unroll
      for (int e = 0; e < 8; ++e) up[e] = 0.f;
    }
    const float bon = Cb[(size_t)row * 8 + hh] + Cb[(size_t)TR * 8 + (size_t)row * 8 + hh];
    float g[8], o[8];
    unpack8(*(const uint4*)(Pr + B_G + c), g);
#pragma unroll
    for (int e = 0; e < 8; ++e) {
      const float v = u0[e] + mu[c + e] * (0.5f * (um[e] + up[e]) - u0[e]);
      const float yn = (ys[e] - mean) * rstd * p.in[I_RWGNW][l * 512 + c + e] + p.in[I_RWGNB][l * 512 + c + e];
      o[e] = (yn + bon * v) * siluf_(g[e]);
    }
    *(uint4*)(Pr + B_G + c) = pack8(o);
  }
}

DI void phase_merge1(const Params& p, int l, char* smem) {
  const int tid = get_tid(), lane = tid & 63, w = tid >> 6, r = lane & 31;
  const int wn = w & 1;
  const bf16_t* H = (const bf16_t*)(p.ws + OFF_H);
  const bf16_t* P = (const bf16_t*)(p.ws + OFF_P);
  bf16_t* ACC = (bf16_t*)(p.ws + OFF_ACC);
  const int mt0 = (l == 0) ? 0 : 1;
  const int nmt = 65 - mt0;
  for (int tile = get_bid(); tile < nmt * 16; tile += gridDim.x) {
    const int mt = mt0 + tile % nmt, nt = tile / nmt;
    f32x16 accS[2][1];
    accS[0][0] = zero16(); accS[1][0] = zero16();
#pragma unroll 1
    for (int i = 0; i < 4; ++i) {
      const int ycol = (i == 0) ? A_G : (i == 1) ? B_G : (i == 2) ? C_G : D_G;
      unsigned gp[2][8];
      {
        f32x16 g[2][1];
        g[0][0] = zero16(); g[1][0] = zero16();
        gemm_core<1>(H + (size_t)mt * 256 * 1024, 1024, (const bf16_t*)(p.ws + OFF_MGT) + (size_t)(l * 4 + i) * 1024 * 1024 + (size_t)nt * 64 * 1024,
                     1024, 1024, g, smem);
        const float bias = p.in[I_MGB][(l * 4 + i) * 1024 + nt * 64 + 32 * wn + r];
#pragma unroll
        for (int ii = 0; ii < 2; ++ii)
#pragma unroll
          for (int e = 0; e < 8; ++e)
            gp[ii][e] = pack2(sigmoidf_(g[ii][0][2 * e] + bias), sigmoidf_(g[ii][0][2 * e + 1] + bias));
      }
      f32x16 z[2][1];
      z[0][0] = zero16(); z[1][0] = zero16();
      gemm_core<1>(P + (size_t)mt * 256 * LDP + ycol, LDP, (const bf16_t*)(p.ws + OFF_BRT) + (size_t)(l * 4 + i) * 1024 * 512 + (size_t)nt * 64 * 512,
                   512, 512, z, smem);
#pragma unroll
      for (int ii = 0; ii < 2; ++ii)
#pragma unroll
        for (int e = 0; e < 8; ++e) {
          accS[ii][0][2 * e] += lo2f(gp[ii][e]) * z[ii][0][2 * e];
          accS[ii][0][2 * e + 1] += hi2f(gp[ii][e]) * z[ii][0][2 * e + 1];
        }
    }
    store_tile_bf16<1>(accS, ACC + (size_t)mt * 256 * 1024 + nt * 64, 1024, 64);
  }
}

DI void phase_merge2(const Params& p, int l, int b, char* smem) {
  const int tid = get_tid(), lane = tid & 63, w = tid >> 6, r = lane & 31, h = lane >> 5;
  const int wm = w >> 1, wn = w & 1;
  const bf16_t* ACC = (const bf16_t*)(p.ws + OFF_ACC);
  const float* modv = (const float*)(p.ws + OFF_MODV);
  const int mt0 = (l == 0) ? 0 : 1;
  const int nmt = 65 - mt0;
  for (int tile = get_bid(); tile < nmt * 8; tile += gridDim.x) {
    const int mt = mt0 + tile % nmt, nt = tile / nmt;
    f32x16 acc[2][2];
    acc[0][0] = zero16(); acc[0][1] = zero16(); acc[1][0] = zero16(); acc[1][1] = zero16();
    gemm_core<2>(ACC + (size_t)mt * 256 * 1024, 1024, (const bf16_t*)(p.ws + OFF_OUTT) + (size_t)l * 1024 * 1024 + (size_t)nt * 128 * 1024,
              1024, 1024, acc, smem);
    const float* src; float* dst; const float* gt;
    if (mt == 0) {
      src = p.in[I_CTX] + (size_t)b * 256 * 1024; dst = (float*)(p.ws + OFF_CX1) + (size_t)b * 256 * 1024;
      gt = modv + (l * 3 + 2) * 3072 + 2048;
    } else {
      src = ((l == 0) ? p.in[I_X] : p.out) + ((size_t)b * SEQ + (size_t)(mt * 256 - 256)) * 1024;
      dst = p.out + ((size_t)b * SEQ + (size_t)(mt * 256 - 256)) * 1024;
      gt = modv + (l * 3 + b) * 3072 + 2048;
    }
#pragma unroll
    for (int i = 0; i < 2; ++i)
#pragma unroll
      for (int j = 0; j < 2; ++j) {
        const int col = nt * 128 + 64 * wn + 32 * j + r;
        const float gv = gt[col];
#pragma unroll
        for (int e = 0; e < 16; ++e) {
          const int row = 64 * wm + 32 * i + crow(e, h);
          const size_t idx = (size_t)row * 1024 + col;
          dst[idx] = src[idx] + gv * acc[i][j][e];
        }
      }
  }
}

__global__ void __launch_bounds__(512) mk_forward(Params p, int ph_lo, int ph_hi) {
  __shared__ __attribute__((aligned(16))) char smem[151552];
  __shared__ int s_item;
  cg::grid_group grid = cg::this_grid();
  for (int ph = ph_lo; ph < ph_hi; ++ph) {
    if (ph == 0) {
      if (PH_ON(9)) phase_prep(p, smem);
    } else {
      const int q = ph - 1;
      const int lb = q / 9, k = q % 9;
      const int l = lb >> 1, b = lb & 1;
      if (k == 0) { if (PH_ON(0)) phase_h(p, l, b); }
      else if (k == 1) { if (PH_ON(1)) phase_g1(p, l, smem); }
      else if (k == 2) { if (PH_ON(2)) phase_post(p, l, smem); }
      else if (k == 3) { if (PH_ON(3)) phase_mlaproj(p, l, smem); }
      else if (k == 4) { if (PH_ON(4)) phase_mlapost(p, l, smem); }
      else if (k == 5) { if (PH_ON(5)) phase_mix(p, l, lb, smem, &s_item); }
      else if (k == 6) { if (PH_ON(6)) phase_fin(p, l); }
      else if (k == 7) { if (PH_ON(7)) phase_merge1(p, l, smem); }
      else { if (PH_ON(8)) phase_merge2(p, l, b, smem); }
    }
    if (ph + 1 < ph_hi) grid.sync();
  }
}

extern "C" void kernel_launch(void* const* d_in, const int* in_sizes, int n_in, void* d_out, int out_size, void* d_ws,
                              size_t ws_size, hipStream_t stream) {
  Params p{};
  for (int i = 0; i < 33; ++i) p.in[i] = (const float*)d_in[i];
  p.out = (float*)d_out;
  p.ws = (char*)d_ws;
  const int NPH = 1 + 4 * 9;
#if MULTI
  for (int ph = 0; ph < NPH; ++ph) {
    hipLaunchKernelGGL(mk_forward, dim3(256), dim3(512), 0, stream, p, ph, ph + 1);
  }
#else
  static int grid_blocks = 0;
  if (!grid_blocks) {
    int dev = 0, cus = 0, per_cu = 0;
    hipGetDevice(&dev);
    hipDeviceGetAttribute(&cus, hipDeviceAttributeMultiprocessorCount, dev);
    hipOccupancyMaxActiveBlocksPerMultiprocessor(&per_cu, mk_forward, 512, 0);
    if (per_cu < 1) per_cu = 1;
    grid_blocks = cus * per_cu;
  }
  int lo = 0, hi = NPH;
  void* args[] = {&p, &lo, &hi};
  hipError_t e = hipLaunchCooperativeKernel((void*)mk_forward, dim3(grid_blocks), dim3(512), args, 0, stream);
  if (e != hipSuccess) fprintf(stderr, "cooperative launch failed: %s (grid %d)\n", hipGetErrorString(e), grid_blocks);
#endif
}
```

```cpp
#include <hip/hip_runtime.h>
#include <hip/hip_cooperative_groups.h>
#include <cstdio>
namespace cg = cooperative_groups;

#ifndef ONLY
#define ONLY (-1)
#endif
#define PH_ON(x) (ONLY < 0 || ONLY == (x))
#ifndef MULTI
#define MULTI 0
#endif

typedef unsigned short bf16_t;
typedef __attribute__((ext_vector_type(8))) short bf16x8;
typedef __attribute__((ext_vector_type(16))) float f32x16;
#define DI __device__ __forceinline__
#define MFMA32(a, b, c) __builtin_amdgcn_mfma_f32_32x32x16_bf16((a), (b), (c), 0, 0, 0)

#define DM 1024
#define SEQ 16384
#define CTXL 256
#define TR 16640
#define LDP 6912
#define NIN 6688
#define NPAD 6912
#define A_Q 0
#define A_K 512
#define A_V 1024
#define A_G 1536
#define B_U 2048
#define B_G 3840
#define C_CQ 4352
#define C_CKV 4608
#define C_KR 4864
#define C_G 4896
#define D_Q 5408
#define D_K 5920
#define D_V 6048
#define D_G 6176
#define LOG2E 1.4426950408889634f
#define SC64 (0.125f * LOG2E)
#define SC96 (0.10206207261596575f * LOG2E)

constexpr size_t SZ_WINT = (size_t)2 * NPAD * 1024 * 2;
constexpr size_t SZ_MGT = (size_t)2 * 4 * 1024 * 1024 * 2;
constexpr size_t SZ_BRT = (size_t)2 * 4 * 1024 * 512 * 2;
constexpr size_t SZ_OUTT = (size_t)2 * 1024 * 1024 * 2;
constexpr size_t SZ_WUQT = (size_t)2 * 768 * 256 * 2;
constexpr size_t SZ_WUKVT = (size_t)2 * 1024 * 256 * 2;
constexpr size_t SZ_MODV = (size_t)2 * 3 * 3072 * 4;
constexpr size_t SZ_ROPE = (size_t)SEQ * 96 * 4;
constexpr size_t SZ_CX1 = (size_t)2 * 256 * 1024 * 4;
constexpr size_t SZ_CTR = 256;
constexpr size_t SZ_H = (size_t)TR * 1024 * 2;
constexpr size_t SZ_P = (size_t)TR * LDP * 2;
constexpr size_t SZ_VTA = (size_t)8 * 64 * TR * 2;
constexpr size_t SZ_VTD = (size_t)2 * 64 * TR * 2;
constexpr size_t SZ_QM = (size_t)TR * 768 * 2;
constexpr size_t SZ_KVRAW = (size_t)TR * 1024 * 2;
constexpr size_t SZ_KM = (size_t)TR * 768 * 2;
constexpr size_t SZ_VTM = (size_t)8 * 64 * TR * 2;
constexpr size_t SZ_Y = (size_t)TR * 512 * 2;
constexpr size_t SZ_CB = (size_t)2 * TR * 8 * 4;

constexpr size_t SZ_SG = (size_t)TR * 4096 * 2;
constexpr size_t OFF_WINT = 0;
constexpr size_t OFF_MGT = OFF_WINT + SZ_WINT;
constexpr size_t OFF_BRT = OFF_MGT + SZ_MGT;
constexpr size_t OFF_OUTT = OFF_BRT + SZ_BRT;
constexpr size_t OFF_WUQT = OFF_OUTT + SZ_OUTT;
constexpr size_t OFF_WUKVT = OFF_WUQT + SZ_WUQT;
constexpr size_t OFF_MODV = OFF_WUKVT + SZ_WUKVT;
constexpr size_t OFF_ROPE = OFF_MODV + SZ_MODV;
constexpr size_t OFF_CX1 = OFF_ROPE + SZ_ROPE;
constexpr size_t OFF_CTR = OFF_CX1 + SZ_CX1;
constexpr size_t OFF_H = OFF_CTR + SZ_CTR;
constexpr size_t OFF_P = OFF_H + SZ_H;
constexpr size_t OFF_Y0 = OFF_P + SZ_P;
constexpr size_t OFF_Y1 = OFF_Y0 + SZ_Y;
constexpr size_t OFF_CB = OFF_Y1 + SZ_Y;
constexpr size_t OFF_VTA = OFF_CB + SZ_CB;
constexpr size_t OFF_VTD = OFF_VTA + SZ_VTA;
constexpr size_t OFF_QM = OFF_VTD + SZ_VTD;
constexpr size_t OFF_KVRAW = OFF_QM + SZ_QM;
constexpr size_t OFF_KM = OFF_KVRAW + SZ_KVRAW;
constexpr size_t OFF_VTM = OFF_KM + SZ_KM;
constexpr size_t OFF_END = OFF_VTM + SZ_VTM;
constexpr size_t OFF_XWA = OFF_END;
constexpr size_t SZ_XWA = (size_t)2 * TR * 128 * 2;
constexpr size_t OFF_SG = OFF_VTA;
constexpr size_t OFF_ACC = OFF_Y0;
static_assert(OFF_SG + SZ_SG <= (size_t)536870912, "workspace overflow");
static_assert(OFF_XWA + SZ_XWA <= (size_t)536870912, "workspace overflow");

struct Params {
  const float* in[33];
  float* out;
  char* ws;
};
enum { I_X = 0, I_C, I_CTX, I_CCTX, I_NORMG, I_MODW, I_MODB, I_WIN, I_NAQG, I_NAKG, I_NARPB, I_RWMU, I_RWW0, I_RWW2,
       I_RWA0, I_RWA2, I_RWKK, I_RWKA, I_RWRK, I_RWGNW, I_RWGNB, I_MLAQAG, I_MLAKVAG, I_MLAWUQ, I_MLAWUKV, I_MLAQG,
       I_MLAKG, I_GQAQG, I_GQAKG, I_MGW, I_MGB, I_WBR, I_WOUT };

DI int get_tid() { int t = threadIdx.x; asm volatile("" : "+v"(t)); return t; }
DI int get_bid() { int b = blockIdx.x; asm volatile("" : "+s"(b)); return b; }
typedef __attribute__((ext_vector_type(2))) float v2f;
typedef __attribute__((ext_vector_type(2))) __bf16 v2bf_t;
DI unsigned pack2(float a, float b) { v2f f = {a, b}; v2bf_t hv = __builtin_convertvector(f, v2bf_t); return __builtin_bit_cast(unsigned, hv); }
DI bf16_t f2bf(float x) { return (bf16_t)(pack2(x, 0.f) & 0xffffu); }
DI float bf2f(bf16_t b) { return __uint_as_float(((unsigned)b) << 16); }
DI float lo2f(unsigned u) { return __uint_as_float(u << 16); }
DI float hi2f(unsigned u) { return __uint_as_float(u & 0xffff0000u); }
DI void unpack8(const uint4& v, float* x) {
  x[0] = lo2f(v.x); x[1] = hi2f(v.x); x[2] = lo2f(v.y); x[3] = hi2f(v.y);
  x[4] = lo2f(v.z); x[5] = hi2f(v.z); x[6] = lo2f(v.w); x[7] = hi2f(v.w);
}
DI uint4 pack8(const float* x) {
  uint4 v; v.x = pack2(x[0], x[1]); v.y = pack2(x[2], x[3]); v.z = pack2(x[4], x[5]); v.w = pack2(x[6], x[7]); return v;
}
DI void unpack4(const uint2& v, float* x) { x[0] = lo2f(v.x); x[1] = hi2f(v.x); x[2] = lo2f(v.y); x[3] = hi2f(v.y); }
DI uint2 pack4(const float* x) { uint2 v; v.x = pack2(x[0], x[1]); v.y = pack2(x[2], x[3]); return v; }
DI float red8(float v) { v += __shfl_xor(v, 1); v += __shfl_xor(v, 2); v += __shfl_xor(v, 4); return v; }
DI float red32(float v) { v = red8(v); v += __shfl_xor(v, 8); v += __shfl_xor(v, 16); return v; }
DI float red64(float v) { v = red32(v); v += __shfl_xor(v, 32); return v; }
DI float sigmoidf_(float x) { return 1.f / (1.f + __expf(-x)); }
DI float siluf_(float x) { return x / (1.f + __expf(-x)); }
DI float fast_tanh(float x) { return 1.f - 2.f * __builtin_amdgcn_rcpf(1.f + __builtin_amdgcn_exp2f(2.8853900817779268f * x)); }
DI float fast_sigmoid(float x) { return __builtin_amdgcn_rcpf(1.f + __builtin_amdgcn_exp2f(-1.4426950408889634f * x)); }
DI int crow(int e, int h) { return (e & 3) + 8 * (e >> 2) + 4 * h; }
DI f32x16 zero16() { f32x16 z; for (int i = 0; i < 16; ++i) z[i] = 0.f; return z; }

template <int NJ>
DI void gemm_core(const bf16_t* __restrict__ A, int lda, const bf16_t* __restrict__ Bt, int ldb, int K,
                  f32x16 (&acc)[2][NJ], char* smem) {
  const int tid = get_tid(), lane = tid & 63, w = tid >> 6, r = lane & 31, h = lane >> 5;
  const int wm = w >> 1, wn = w & 1;
  bf16_t* As = (bf16_t*)smem;
  bf16_t* Bs = As + 2 * 256 * 72;
  uint4 ra[4], rb[NJ];
  const int nk = K >> 6;
  const bf16_t* Ag = A + (size_t)(tid >> 3) * lda + (tid & 7) * 8;
  const bf16_t* Bg = Bt + (size_t)(tid >> 3) * ldb + (tid & 7) * 8;
  bf16_t* Asw = As + (tid >> 3) * 72 + (tid & 7) * 8;
  bf16_t* Bsw = Bs + (tid >> 3) * 72 + (tid & 7) * 8;
  __syncthreads();
#pragma unroll
  for (int i = 0; i < 4; ++i) ra[i] = *(const uint4*)(Ag + (size_t)(64 * i) * lda);
#pragma unroll
  for (int i = 0; i < NJ; ++i) rb[i] = *(const uint4*)(Bg + (size_t)(64 * i) * ldb);
#pragma unroll
  for (int i = 0; i < 4; ++i) *(uint4*)(Asw + 64 * i * 72) = ra[i];
#pragma unroll
  for (int i = 0; i < NJ; ++i) *(uint4*)(Bsw + 64 * i * 72) = rb[i];
  __syncthreads();
  for (int kt = 0; kt < nk; ++kt) {
    const int buf = kt & 1;
    if (kt + 1 < nk) {
      const int ko = (kt + 1) * 64;
#pragma unroll
      for (int i = 0; i < 4; ++i) ra[i] = *(const uint4*)(Ag + (size_t)(64 * i) * lda + ko);
#pragma unroll
      for (int i = 0; i < NJ; ++i) rb[i] = *(const uint4*)(Bg + (size_t)(64 * i) * ldb + ko);
    }
    const bf16_t* Ab = As + (buf * 256 + 64 * wm + r) * 72 + h * 8;
    const bf16_t* Bb = Bs + (buf * 64 * NJ + 32 * NJ * wn + r) * 72 + h * 8;
#pragma unroll
    for (int ks = 0; ks < 4; ++ks) {
      bf16x8 a0 = *(const bf16x8*)(Ab + ks * 16);
      bf16x8 a1 = *(const bf16x8*)(Ab + 32 * 72 + ks * 16);
#pragma unroll
      for (int j = 0; j < NJ; ++j) {
        bf16x8 b0 = *(const bf16x8*)(Bb + j * 32 * 72 + ks * 16);
        acc[0][j] = MFMA32(a0, b0, acc[0][j]);
        acc[1][j] = MFMA32(a1, b0, acc[1][j]);
      }
    }
    if (kt + 1 < nk) {
      const int nb = buf ^ 1;
#pragma unroll
      for (int i = 0; i < 4; ++i) *(uint4*)(Asw + (nb * 256 + 64 * i) * 72) = ra[i];
#pragma unroll
      for (int i = 0; i < NJ; ++i) *(uint4*)(Bsw + (nb * 64 * NJ + 64 * i) * 72) = rb[i];
    }
    __syncthreads();
  }
}

template <int NJ>
DI void store_tile_bf16(const f32x16 (&acc)[2][NJ], bf16_t* dst, int ld, int ncols) {
  const int tid = get_tid(), lane = tid & 63, w = tid >> 6, r = lane & 31, h = lane >> 5;
  const int wm = w >> 1, wn = w & 1;
#pragma unroll
  for (int i = 0; i < 2; ++i)
#pragma unroll
    for (int j = 0; j < NJ; ++j) {
      const int col = 32 * NJ * wn + 32 * j + r;
      if (col < ncols) {
        bf16_t* d0 = dst + (size_t)(64 * wm + 32 * i + 4 * h) * ld + col;
#pragma unroll
        for (int e = 0; e < 16; ++e) d0[(size_t)((e & 3) + 8 * (e >> 2)) * ld] = f2bf(acc[i][j][e]);
      }
    }
}

namespace pg8 {
#define PG8_LAS __attribute__((address_space(3)))
typedef unsigned short bf16_t;
typedef short bf16x8 __attribute__((ext_vector_type(8)));
typedef float f32x4 __attribute__((ext_vector_type(4)));
typedef unsigned u32x4 __attribute__((ext_vector_type(4)));
constexpr int BM = 256, BK = 64, HALF = 128, HTB = HALF * BK * 2  , STAGE_BYTES = 8 * HTB, NXCD = 8, WGM = 8;

__host__ __device__ __forceinline__ int lds_byte(int r, int c) { const int st = (r >> 4) * 2 + (c >> 5), rr = r & 15, cc = c & 31, ob = rr * 64 + cc * 2; return st * 1024 + (ob ^ (((ob >> 9) & 1) << 5)); }
__host__ __device__ __forceinline__ void stage_rc(int b, int& R, int& C) { const int st = b / 1024, sb = b % 1024, swz = sb ^ (((sb >> 9) & 1) << 5); R = (st >> 1) * 16 + swz / 64; C = (st & 1) * 32 + (swz % 64) / 2; }
__host__ __device__ __forceinline__ int perm32(int rho) { const int n = rho >> 4, i = rho & 15; return 8 * (i >> 2) + 4 * n + (i & 3); }

struct Unit { int pm, pn; };
struct Gemm { const bf16_t* A; const bf16_t* Bt; int M, N, K, lda; };

struct StaticOrder {
    int nM, nN, nwg, G, c;
    __host__ __device__ void init(int M, int N, int G_, int c_) { nM = M / BM; nN = N / BM; nwg = nM * nN; G = G_; c = c_; }
    __host__ __device__ bool next(int i, Unit& u) const {
        const long L = (long)i * G + c; if (L >= nwg) return false;
        int wgid = (int)L; { const int q = nwg / NXCD, r = nwg % NXCD, xcd = wgid % NXCD, off = wgid / NXCD; wgid = (xcd < r ? xcd * (q + 1) : r * (q + 1) + (xcd - r) * q) + off; }
        const int nig = WGM * nN, gid = wgid / nig, fm = gid * WGM, gsz = (nM - fm) < WGM ? (nM - fm) : WGM;
        u.pm = fm + ((wgid % nig) % gsz); u.pn = (wgid % nig) / gsz; return true;
    }
    __device__ __forceinline__ void a_ready(const Unit&) const {}
    __device__ __forceinline__ void done(const Unit&) const {}
    __device__ __forceinline__ size_t a_off(const Unit&) const { return 0; }
};
template <class Epi, class Sched, bool STAMP = false>
__device__ __forceinline__ void gemm_phase(PG8_LAS unsigned char* lds, const Gemm g, const Sched& S, const Epi& E, unsigned long long* stamps) {
    const int tid = get_tid(), wid = __builtin_amdgcn_readfirstlane(tid >> 6), lane = tid & 63, wr = wid >> 2, wc = wid & 3, fr = lane & 15, fq = lane >> 4;
    const int K = g.K, nt = K / BK;
    int ts_lo = 0, ts_hi = 0, nts = 0; const unsigned long long rt_entry = STAMP ? (unsigned long long)wall_clock64() : 0ull;
#define PG8_STAMP() do { if (STAMP && wid == 0 && nts < 64) { const unsigned long long _c = (unsigned long long)clock64(); \
        ts_lo = (lane == nts) ? (int)(unsigned)_c : ts_lo; ts_hi = (lane == nts) ? (int)(unsigned)(_c >> 32) : ts_hi; ++nts; } } while (0)
    PG8_STAMP();
    unsigned voffA[2], voffB[2];
#pragma unroll
    for (int i = 0; i < 2; ++i) { int R, C; stage_rc(tid * 16 + i * 8192, R, C); const int Rb = Epi::PERM ? ((R & ~31) + perm32(R & 31)) : R;
        voffA[i] = (unsigned)(R * g.lda + C) * 2u; voffB[i] = (unsigned)(Rb * K + C) * 2u; }
    const size_t kstep = (size_t)(BK * 2);
    const size_t hstep = (size_t)HALF * K * 2; const size_t hstepA = (size_t)HALF * g.lda * 2; const size_t tstepA = 2 * hstepA;
    const size_t tstep = 2 * hstep;
    const unsigned ldsw = (unsigned)wid * 1024u;
    const int aoff = lds_byte(wr * 64 + fr, fq * 8), boff = lds_byte(wc * 32 + fr, fq * 8);
#define PG8_SA(b, h) (((b) * 2 + (h)) * HTB)
#define PG8_SB(b, h) ((4 + (b) * 2 + (h)) * HTB)
#define PG8_STAGE(bufoff, gbase, voff) do { _Pragma("unroll") for (int _i = 0; _i < 2; ++_i) \
        __builtin_amdgcn_global_load_lds((const unsigned*)((const char*)(gbase) + (voff)[_i]), (PG8_LAS unsigned*)(lds + (bufoff) + ldsw + _i * 8192), 16, 0, 0); } while (0)
#define PG8_LDA(dst, b, h) do { _Pragma("unroll") for (int m = 0; m < 4; ++m) _Pragma("unroll") for (int k = 0; k < 2; ++k) dst[m][k] = *(const PG8_LAS bf16x8*)(lds + PG8_SA(b, h) + aoff + m * 2048 + k * 1024); } while (0)
#define PG8_LDB(dst, b, h) do { _Pragma("unroll") for (int n = 0; n < 2; ++n) _Pragma("unroll") for (int k = 0; k < 2; ++k) dst[n][k] = *(const PG8_LAS bf16x8*)(lds + PG8_SB(b, h) + boff + n * 2048 + k * 1024); } while (0)
#define PG8_MMA(ai, bj, At, Bt) do { __builtin_amdgcn_s_setprio(1); _Pragma("unroll") for (int m = 0; m < 4; ++m) _Pragma("unroll") for (int n = 0; n < 2; ++n) _Pragma("unroll") for (int k = 0; k < 2; ++k) \
        acc[ai][bj][m][n] = __builtin_amdgcn_mfma_f32_16x16x32_bf16(Bt[n][k], At[m][k], acc[ai][bj][m][n], 0, 0, 0); __builtin_amdgcn_s_setprio(0); } while (0)
#define PG8_WAIT_V(n) asm volatile("s_waitcnt vmcnt(" #n ")" ::: "memory")
#define PG8_WAIT_L(n) asm volatile("s_waitcnt lgkmcnt(" #n ")" ::: "memory")
#define PG8_BAR __builtin_amdgcn_s_barrier()
#define PG8_SCHED __builtin_amdgcn_sched_barrier(0)
    Unit cur, nxt; int ui = 0;
    if (!S.next(0, cur)) return;
    f32x4 acc[2][2][4][2];
#pragma unroll
    for (int a = 0; a < 2; ++a)
#pragma unroll
        for (int b = 0; b < 2; ++b)
#pragma unroll
            for (int m = 0; m < 4; ++m)
#pragma unroll
                for (int n = 0; n < 2; ++n) acc[a][b][m][n] = (f32x4){0.f, 0.f, 0.f, 0.f};
    bf16x8 At[4][2], B0[2][2], B1[2][2];
    const char* cA = (const char*)g.A + (size_t)cur.pm * tstepA + S.a_off(cur); const char* cB = (const char*)g.Bt + (size_t)cur.pn * tstep;
    S.a_ready(cur);
    PG8_STAGE(PG8_SB(0, 0), cB, voffB); PG8_STAGE(PG8_SA(0, 0), cA, voffA); PG8_STAGE(PG8_SB(0, 1), cB + hstep, voffB); PG8_STAGE(PG8_SA(0, 1), cA + hstepA, voffA);
    if (wr == 1) PG8_BAR;
    PG8_WAIT_V(4); PG8_BAR;
    PG8_STAGE(PG8_SB(1, 0), cB + kstep, voffB); PG8_STAGE(PG8_SA(1, 0), cA + kstep, voffA); PG8_STAGE(PG8_SB(1, 1), cB + hstep + kstep, voffB);
    PG8_WAIT_V(6); PG8_BAR;
    PG8_STAMP();
    for (;;) {
        const bool has_next = S.next(ui + 1, nxt);
        const char* nA = has_next ? (const char*)g.A + (size_t)nxt.pm * tstepA + S.a_off(nxt) : cA; const char* nB = has_next ? (const char*)g.Bt + (size_t)nxt.pn * tstep : cB;
        for (int t = 0; t < nt; t += 2) {
            const bool last = (t == nt - 2);
            const char* a1 = cA + (size_t)(t + 1) * kstep;
            const char* a2 = last ? nA : cA + (size_t)(t + 2) * kstep; const char* b2 = last ? nB : cB + (size_t)(t + 2) * kstep;
            const char* a3 = a2 + kstep; const char* b3 = b2 + kstep;
            if (last && has_next) S.a_ready(nxt);
            PG8_LDB(B0, 0, 0); PG8_SCHED; PG8_LDA(At, 0, 0); PG8_STAGE(PG8_SA(1, 1), a1 + hstepA, voffA);
            PG8_WAIT_L(8); PG8_BAR; PG8_WAIT_L(0); PG8_MMA(0, 0, At, B0); PG8_BAR; PG8_SCHED;
            PG8_LDB(B1, 0, 1); PG8_STAGE(PG8_SB(0, 0), b2, voffB);
            PG8_BAR; PG8_WAIT_L(0); PG8_MMA(0, 1, At, B1); PG8_BAR;
            PG8_LDA(At, 0, 1); PG8_STAGE(PG8_SA(0, 0), a2, voffA);
            PG8_BAR; PG8_WAIT_L(0); PG8_MMA(1, 0, At, B0); PG8_BAR; PG8_SCHED;
            PG8_STAGE(PG8_SB(0, 1), b2 + hstep, voffB);
            PG8_WAIT_V(6); PG8_BAR; PG8_MMA(1, 1, At, B1); PG8_BAR;
            PG8_LDB(B0, 1, 0); PG8_SCHED; PG8_LDA(At, 1, 0); PG8_STAGE(PG8_SA(0, 1), a2 + hstepA, voffA);
            PG8_WAIT_L(8); PG8_BAR; PG8_WAIT_L(0); PG8_MMA(0, 0, At, B0); PG8_BAR; PG8_SCHED;
            PG8_LDB(B1, 1, 1); PG8_STAGE(PG8_SB(1, 0), b3, voffB);
            PG8_BAR; PG8_WAIT_L(0); PG8_MMA(0, 1, At, B1); PG8_BAR;
            PG8_LDA(At, 1, 1); PG8_STAGE(PG8_SA(1, 0), a3, voffA);
            PG8_BAR; PG8_WAIT_L(0); PG8_MMA(1, 0, At, B0); PG8_BAR; PG8_SCHED;
            PG8_STAGE(PG8_SB(1, 1), b3 + hstep, voffB);
            PG8_WAIT_V(6); PG8_BAR; PG8_MMA(1, 1, At, B1); PG8_BAR;
        }
        PG8_STAMP();
        if constexpr (!Epi::AFTER_DRAIN) { E(acc, cur, wr, wc, fr, fq); S.done(cur); }
        PG8_STAMP();
        if (!has_next) break;
#pragma unroll
        for (int a = 0; a < 2; ++a)
#pragma unroll
            for (int b = 0; b < 2; ++b)
#pragma unroll
                for (int m = 0; m < 4; ++m)
#pragma unroll
                    for (int n = 0; n < 2; ++n) acc[a][b][m][n] = (f32x4){0.f, 0.f, 0.f, 0.f};
        cur = nxt; cA = nA; cB = nB; ++ui;
    }
    PG8_WAIT_V(0);
    if (wr == 0) PG8_BAR;
    PG8_BAR;
    if constexpr (Epi::AFTER_DRAIN) { E.fused(acc, cur, wr, wc, fr, fq, lds, wid, lane); S.done(cur); }
    PG8_STAMP();
    if (STAMP && wid == 0) { stamps[lane] = lane < nts ? (((unsigned long long)(unsigned)ts_hi << 32) | (unsigned)ts_lo) : 0ull;
        if (lane == 62) stamps[62] = rt_entry; if (lane == 63) stamps[63] = (unsigned long long)wall_clock64(); }
#undef PG8_STAMP
#undef PG8_SA
#undef PG8_SB
#undef PG8_STAGE
#undef PG8_LDA
#undef PG8_LDB
#undef PG8_MMA
#undef PG8_WAIT_V
#undef PG8_WAIT_L
#undef PG8_BAR
#undef PG8_SCHED
}
}

struct EpiStoreBf16 {
  static constexpr bool PERM = true, AFTER_DRAIN = false;
  bf16_t* O; int ldc;
  DI void operator()(const pg8::f32x4 (&acc)[2][2][4][2], const pg8::Unit& u, int wr, int wc, int fr, int fq) const {
    const int row0 = u.pm * 256 + wr * 64 + fr, col0 = u.pn * 256 + wc * 32 + 8 * fq;
#pragma unroll
    for (int ai = 0; ai < 2; ++ai)
#pragma unroll
      for (int m = 0; m < 4; ++m) {
        bf16_t* rowp = O + (size_t)(row0 + ai * 128 + m * 16) * ldc + col0;
#pragma unroll
        for (int bj = 0; bj < 2; ++bj) {
          const pg8::f32x4 v0 = acc[ai][bj][m][0], v1 = acc[ai][bj][m][1];
          uint4 o; o.x = pack2(v0[0], v0[1]); o.y = pack2(v0[2], v0[3]); o.z = pack2(v1[0], v1[1]); o.w = pack2(v1[2], v1[3]);
          *(uint4*)(rowp + bj * 128) = o;
        }
      }
  }
};
struct EpiGate {
  static constexpr bool PERM = true, AFTER_DRAIN = false;
  bf16_t* O; int ldc; const float* bias;
  DI void operator()(const pg8::f32x4 (&acc)[2][2][4][2], const pg8::Unit& u, int wr, int wc, int fr, int fq) const {
    const int row0 = u.pm * 256 + wr * 64 + fr, col0 = u.pn * 256 + wc * 32 + 8 * fq;
#pragma unroll
    for (int bj = 0; bj < 2; ++bj) {
      const float4 b0 = *(const float4*)(bias + col0 + bj * 128), b1 = *(const float4*)(bias + col0 + bj * 128 + 4);
#pragma unroll
      for (int ai = 0; ai < 2; ++ai)
#pragma unroll
        for (int m = 0; m < 4; ++m) {
          bf16_t* rowp = O + (size_t)(row0 + ai * 128 + m * 16) * ldc + col0 + bj * 128;
          const pg8::f32x4 v0 = acc[ai][bj][m][0], v1 = acc[ai][bj][m][1];
          uint4 o;
          o.x = pack2(fast_sigmoid(v0[0] + b0.x), fast_sigmoid(v0[1] + b0.y));
          o.y = pack2(fast_sigmoid(v0[2] + b0.z), fast_sigmoid(v0[3] + b0.w));
          o.z = pack2(fast_sigmoid(v1[0] + b1.x), fast_sigmoid(v1[1] + b1.y));
          o.w = pack2(fast_sigmoid(v1[2] + b1.z), fast_sigmoid(v1[3] + b1.w));
          *(uint4*)rowp = o;
        }
    }
  }
};
template <int FIRST>
struct EpiZ {
  static constexpr bool PERM = true, AFTER_DRAIN = false;
  bf16_t* ACC; const bf16_t* SG;
  DI void operator()(const pg8::f32x4 (&acc)[2][2][4][2], const pg8::Unit& u, int wr, int wc, int fr, int fq) const {
    const int row0 = u.pm * 256 + wr * 64 + fr, col0 = u.pn * 256 + wc * 32 + 8 * fq;
#pragma unroll
    for (int ai = 0; ai < 2; ++ai)
#pragma unroll
      for (int m = 0; m < 4; ++m) {
        const size_t row = (size_t)(row0 + ai * 128 + m * 16);
#pragma unroll
        for (int bj = 0; bj < 2; ++bj) {
          const int col = col0 + bj * 128;
          float g[8], a[8];
          unpack8(*(const uint4*)(SG + row * 4096 + col), g);
          const pg8::f32x4 v0 = acc[ai][bj][m][0], v1 = acc[ai][bj][m][1];
          const float z[8] = {v0[0], v0[1], v0[2], v0[3], v1[0], v1[1], v1[2], v1[3]};
          if (FIRST) {
#pragma unroll
            for (int e = 0; e < 8; ++e) a[e] = g[e] * z[e];
          } else {
            {
              const unsigned long long* ap = (const unsigned long long*)(ACC + row * 1024 + col);
              const unsigned long long q0 = __hip_atomic_load(ap, __ATOMIC_RELAXED, __HIP_MEMORY_SCOPE_AGENT);
              const unsigned long long q1 = __hip_atomic_load(ap + 1, __ATOMIC_RELAXED, __HIP_MEMORY_SCOPE_AGENT);
              uint4 av; av.x = (unsigned)q0; av.y = (unsigned)(q0 >> 32); av.z = (unsigned)q1; av.w = (unsigned)(q1 >> 32);
              unpack8(av, a);
            }
#pragma unroll
            for (int e = 0; e < 8; ++e) a[e] += g[e] * z[e];
          }
          *(uint4*)(ACC + row * 1024 + col) = pack8(a);
        }
      }
  }
};
struct EpiOut {
  static constexpr bool PERM = false, AFTER_DRAIN = false;
  const float* src; float* dst; const float* gt;
  DI void operator()(const pg8::f32x4 (&acc)[2][2][4][2], const pg8::Unit& u, int wr, int wc, int fr, int fq) const {
    const int row0 = u.pm * 256 + wr * 64 + fr, col0 = u.pn * 256 + wc * 32 + 4 * fq;
#pragma unroll
    for (int bj = 0; bj < 2; ++bj)
#pragma unroll
      for (int n = 0; n < 2; ++n) {
        const int col = col0 + bj * 128 + n * 16;
        const float4 gv = *(const float4*)(gt + col);
#pragma unroll
        for (int ai = 0; ai < 2; ++ai)
#pragma unroll
          for (int m = 0; m < 4; ++m) {
            const size_t idx = (size_t)(row0 + ai * 128 + m * 16) * 1024 + col;
            const float4 sv = *(const float4*)(src + idx);
            const pg8::f32x4 v = acc[ai][bj][m][n];
            float4 o; o.x = sv.x + gv.x * v[0]; o.y = sv.y + gv.y * v[1]; o.z = sv.z + gv.z * v[2]; o.w = sv.w + gv.w * v[3];
            *(float4*)(dst + idx) = o;
          }
      }
  }
};
template <class Epi>
DI void run_gemm(char* smem, const bf16_t* A, int lda, const bf16_t* Bt, int M, int N, int K, const Epi& E) {
  pg8::Gemm g; g.A = A; g.Bt = Bt; g.M = M; g.N = N; g.K = K; g.lda = lda;
  pg8::StaticOrder S; S.init(M, N, (int)gridDim.x, get_bid());
  __syncthreads();
  pg8::gemm_phase<Epi, pg8::StaticOrder, false>((PG8_LAS unsigned char*)smem, g, S, E, nullptr);
  __syncthreads();
}

DI void transpose_tile(const float* __restrict__ src, int K, int N, bf16_t* __restrict__ dst, int tile, char* smem) {
  float* tS = (float*)smem;
  const int tid = get_tid();
  const int ntk = K >> 6;
  const int kt = tile % ntk, nt = tile / ntk;
  __syncthreads();
  {
    const int kk = tid >> 3, c8 = (tid & 7) * 8;
    const int col = nt * 64 + c8;
    float v[8];
    if (col < N) {
      const float4 a = *(const float4*)(src + (size_t)(kt * 64 + kk) * N + col);
      const float4 b = *(const float4*)(src + (size_t)(kt * 64 + kk) * N + col + 4);
      v[0] = a.x; v[1] = a.y; v[2] = a.z; v[3] = a.w; v[4] = b.x; v[5] = b.y; v[6] = b.z; v[7] = b.w;
    } else {
#pragma unroll
      for (int e = 0; e < 8; ++e) v[e] = 0.f;
    }
#pragma unroll
    for (int e = 0; e < 8; ++e) tS[kk * 65 + c8 + e] = v[e];
  }
  __syncthreads();
  {
    const int n = tid >> 3, k8 = (tid & 7) * 8;
    float v[8];
#pragma unroll
    for (int e = 0; e < 8; ++e) v[e] = tS[(k8 + e) * 65 + n];
    *(uint4*)(dst + (size_t)(nt * 64 + n) * K + kt * 64 + k8) = pack8(v);
  }
}
constexpr int WT_TILES = 1728 + 1024 + 512 + 256 + 48 + 64;
DI void weights_tile(const Params& p, int l, int flat, char* smem) {
  char* ws = p.ws;
  if (flat < 1728) {
    transpose_tile(p.in[I_WIN] + (size_t)l * 1024 * NIN, 1024, NIN, (bf16_t*)(ws + OFF_WINT) + (size_t)l * NPAD * 1024, flat, smem);
  } else if (flat < 2752) {
    const int f = flat - 1728, i = f >> 8;
    transpose_tile(p.in[I_MGW] + (size_t)(l * 4 + i) * 1024 * 1024, 1024, 1024, (bf16_t*)(ws + OFF_MGT) + (size_t)(l * 4 + i) * 1024 * 1024, f & 255, smem);
  } else if (flat < 3264) {
    const int f = flat - 2752, i = f >> 7;
    transpose_tile(p.in[I_WBR] + (size_t)(l * 4 + i) * 512 * 1024, 512, 1024, (bf16_t*)(ws + OFF_BRT) + (size_t)(l * 4 + i) * 1024 * 512, f & 127, smem);
  } else if (flat < 3520) {
    transpose_tile(p.in[I_WOUT] + (size_t)l * 1024 * 1024, 1024, 1024, (bf16_t*)(ws + OFF_OUTT) + (size_t)l * 1024 * 1024, flat - 3264, smem);
  } else if (flat < 3568) {
    transpose_tile(p.in[I_MLAWUQ] + (size_t)l * 256 * 768, 256, 768, (bf16_t*)(ws + OFF_WUQT) + (size_t)l * 768 * 256, flat - 3520, smem);
  } else {
    transpose_tile(p.in[I_MLAWUKV] + (size_t)l * 256 * 1024, 256, 1024, (bf16_t*)(ws + OFF_WUKVT) + (size_t)l * 1024 * 256, flat - 3568, smem);
  }
}

DI void phase_prep(const Params& p, char* smem) {
  const int tid = get_tid();
  char* ws = p.ws;
  if (get_bid() == 0 && tid < 64) ((int*)(ws + OFF_CTR))[tid] = 0;
  for (int t = get_bid(); t < WT_TILES; t += gridDim.x) weights_tile(p, 0, t, smem);
  {
    float* sv = (float*)smem;
    float* red = sv + 3 * 1024;
    float* modv = (float*)(ws + OFF_MODV);
    for (int job = get_bid(); job < 96; job += gridDim.x) {
      const int l = job / 48, cg0 = (job % 48) * 64;
      __syncthreads();
      for (int i = tid; i < 3072; i += 512) {
        const int rr = i >> 10, k = i & 1023;
        const float cv = (rr < 2) ? p.in[I_C][rr * 1024 + k] : p.in[I_CCTX][k];
        sv[i] = siluf_(cv);
      }
      __syncthreads();
      const int cl = tid & 63, ks = tid >> 6;
      float a0 = 0.f, a1 = 0.f, a2 = 0.f;
      const float* mw = p.in[I_MODW] + (size_t)l * 1024 * 3072 + cg0 + cl;
      for (int k = ks * 128; k < ks * 128 + 128; ++k) {
        const float wv = mw[(size_t)k * 3072];
        a0 += sv[k] * wv; a1 += sv[1024 + k] * wv; a2 += sv[2048 + k] * wv;
      }
      red[(ks * 3 + 0) * 64 + cl] = a0; red[(ks * 3 + 1) * 64 + cl] = a1; red[(ks * 3 + 2) * 64 + cl] = a2;
      __syncthreads();
      if (tid < 192) {
        const int rr = tid >> 6, c = tid & 63;
        float s = 0.f;
        for (int q = 0; q < 8; ++q) s += red[(q * 3 + rr) * 64 + c];
        modv[(l * 3 + rr) * 3072 + cg0 + c] = s + p.in[I_MODB][l * 3072 + cg0 + c];
      }
    }
  }
  {
    float* cosH = (float*)(ws + OFF_ROPE);
    float* sinH = cosH + SEQ * 32;
    float* cosM = sinH + SEQ * 32;
    float* sinM = cosM + SEQ * 16;
    for (int idx = get_bid() * 512 + tid; idx < SEQ * 48; idx += gridDim.x * 512) {
      if (idx < SEQ * 32) {
        const int t = idx >> 5, i = idx & 31, f = i & 15;
        const float pos = (i < 16) ? (float)(t >> 6) : (float)(t & 63);
        const float inv = exp2f(-(float)f * (13.287712379549449f / 16.f));
        const float ang = pos * inv;
        cosH[idx] = cosf(ang); sinH[idx] = sinf(ang);
      } else {
        const int j = idx - SEQ * 32;
        const int t = j >> 4, i = j & 15, f = i & 7;
        const float pos = (i < 8) ? (float)(t >> 6) : (float)(t & 63);
        const float inv = exp2f(-(float)f * (13.287712379549449f / 8.f));
        const float ang = pos * inv;
        cosM[j] = cosf(ang); sinM[j] = sinf(ang);
      }
    }
  }
}

DI void phase_h(const Params& p, int l, int b) {
  const int tid = get_tid(), lane = tid & 63, w = tid >> 6;
  const float* xin = (l == 0) ? p.in[I_X] : p.out;
  const float* cin = (l == 0) ? p.in[I_CTX] : (const float*)(p.ws + OFF_CX1);
  const float* ng = p.in[I_NORMG] + l * 1024;
  const float* modv = (const float*)(p.ws + OFF_MODV);
  bf16_t* H = (bf16_t*)(p.ws + OFF_H);
  for (int row = get_bid() * 8 + w; row < TR; row += gridDim.x * 8) {
    const float* src; const float* mv;
    if (row < 256) { src = cin + ((size_t)b * 256 + row) * 1024; mv = modv + (l * 3 + 2) * 3072; }
    else { src = xin + ((size_t)b * SEQ + (row - 256)) * 1024; mv = modv + (l * 3 + b) * 3072; }
    float4 v[4];
    float ss = 0.f;
#pragma unroll
    for (int i = 0; i < 4; ++i) {
      v[i] = *(const float4*)(src + i * 256 + lane * 4);
      ss += v[i].x * v[i].x + v[i].y * v[i].y + v[i].z * v[i].z + v[i].w * v[i].w;
    }
    ss = red64(ss);
    const float rs = rsqrtf(ss * (1.f / 1024.f) + 1e-6f);
#pragma unroll
    for (int i = 0; i < 4; ++i) {
      const int c = i * 256 + lane * 4;
      const float4 g = *(const float4*)(ng + c);
      const float4 sh = *(const float4*)(mv + c);
      const float4 sc = *(const float4*)(mv + 1024 + c);
      float o[4];
      o[0] = v[i].x * rs * g.x * (1.f + sc.x) + sh.x;
      o[1] = v[i].y * rs * g.y * (1.f + sc.y) + sh.y;
      o[2] = v[i].z * rs * g.z * (1.f + sc.z) + sh.z;
      o[3] = v[i].w * rs * g.w * (1.f + sc.w) + sh.w;
      *(uint2*)(H + (size_t)row * 1024 + c) = pack4(o);
    }
  }
}

DI void phase_g1(const Params& p, int l, char* smem) {
  EpiStoreBf16 E; E.O = (bf16_t*)(p.ws + OFF_P); E.ldc = LDP;
  run_gemm(smem, (const bf16_t*)(p.ws + OFF_H), 1024, (const bf16_t*)(p.ws + OFF_WINT) + (size_t)l * NPAD * 1024, TR, NPAD, 1024, E);
}

DI int swap23(int p) { return (p & 3) | ((p & 4) << 1) | ((p & 8) >> 1); }
DI void vt_tile(const bf16_t* __restrict__ src, int ld, bf16_t* __restrict__ dst, int tok0, char* smem) {
  bf16_t* tS = (bf16_t*)smem;
  const int tid = get_tid();
  __syncthreads();
  {
    const int tok = tid >> 3, c8 = (tid & 7) * 8;
    *(uint4*)(tS + tok * 72 + c8) = *(const uint4*)(src + (size_t)(tok0 + tok) * ld + c8);
  }
  __syncthreads();
  {
    const int dv = tid >> 3, pc = tid & 7;
    unsigned short v[8];
#pragma unroll
    for (int j = 0; j < 8; ++j) {
      const int pos = 8 * pc + j;
      const int tokoff = (pos & ~15) | swap23(pos & 15);
      v[j] = tS[tokoff * 72 + dv];
    }
    uint4 o;
    o.x = v[0] | ((unsigned)v[1] << 16); o.y = v[2] | ((unsigned)v[3] << 16);
    o.z = v[4] | ((unsigned)v[5] << 16); o.w = v[6] | ((unsigned)v[7] << 16);
    *(uint4*)(dst + (size_t)dv * TR + tok0 + 8 * pc) = o;
  }
}

DI void phase_post(const Params& p, int l, char* smem) {
  const int tid = get_tid(), lane = tid & 63, w = tid >> 6;
  bf16_t* P = (bf16_t*)(p.ws + OFF_P);
  const float* cosH = (const float*)(p.ws + OFF_ROPE);
  const float* sinH = cosH + SEQ * 32;
  const int m = lane & 7;
  for (int row = get_bid() * 8 + w; row < TR; row += gridDim.x * 8) {
    bf16_t* Pr = P + (size_t)row * LDP;
    float x[8];
    const uint4 vaq = *(const uint4*)(Pr + A_Q + lane * 8);
    const uint4 vak = *(const uint4*)(Pr + A_K + lane * 8);
    const uint4 vdq = *(const uint4*)(Pr + D_Q + lane * 8);
    const uint4 vdk = *(const uint4*)(Pr + D_K + (lane & 15) * 8);
    const uint4 vcc = *(const uint4*)(Pr + C_CQ + 256 * (lane >> 5) + (lane & 31) * 8);
    float cs8[8], sn8[8];
    {
      const int t = (row >= 256) ? (row - 256) : 0;
      const float4 c0 = *(const float4*)(cosH + t * 32 + 8 * (m & 3)), c1 = *(const float4*)(cosH + t * 32 + 8 * (m & 3) + 4);
      const float4 s0 = *(const float4*)(sinH + t * 32 + 8 * (m & 3)), s1 = *(const float4*)(sinH + t * 32 + 8 * (m & 3) + 4);
      cs8[0] = c0.x; cs8[1] = c0.y; cs8[2] = c0.z; cs8[3] = c0.w; cs8[4] = c1.x; cs8[5] = c1.y; cs8[6] = c1.z; cs8[7] = c1.w;
      sn8[0] = s0.x; sn8[1] = s0.y; sn8[2] = s0.z; sn8[3] = s0.w; sn8[4] = s1.x; sn8[5] = s1.y; sn8[6] = s1.z; sn8[7] = s1.w;
    }
    {
      unpack8(vaq, x);
      float ss = 0.f;
#pragma unroll
      for (int e = 0; e < 8; ++e) ss += x[e] * x[e];
      ss = red8(ss);
      const float rs = rsqrtf(ss * (1.f / 64.f) + 1e-6f) * SC64;
#pragma unroll
      for (int e = 0; e < 8; ++e) x[e] = x[e] * rs * p.in[I_NAQG][l * 64 + m * 8 + e];
      *(uint4*)(Pr + A_Q + lane * 8) = pack8(x);
    }
    {
      unpack8(vak, x);
      float ss = 0.f;
#pragma unroll
      for (int e = 0; e < 8; ++e) ss += x[e] * x[e];
      ss = red8(ss);
      const float rs = rsqrtf(ss * (1.f / 64.f) + 1e-6f);
#pragma unroll
      for (int e = 0; e < 8; ++e) x[e] = x[e] * rs * p.in[I_NAKG][l * 64 + m * 8 + e];
      *(uint4*)(Pr + A_K + lane * 8) = pack8(x);
    }
#pragma unroll
    for (int which = 0; which < 2; ++which) {
      const int lc = which ? (lane & 15) : lane;
      bf16_t* ptr = Pr + (which ? D_K : D_Q) + lc * 8;
      const float* gg = (which ? p.in[I_GQAKG] : p.in[I_GQAQG]) + l * 64 + m * 8;
      unpack8(which ? vdk : vdq, x);
      float ss = 0.f;
#pragma unroll
      for (int e = 0; e < 8; ++e) ss += x[e] * x[e];
      ss = red8(ss);
      const float rs = rsqrtf(ss * (1.f / 64.f) + 1e-6f);
#pragma unroll
      for (int e = 0; e < 8; ++e) x[e] = x[e] * rs * gg[e];
      if (row >= 256) {
        const float sgn = (m < 4) ? -1.f : 1.f;
#pragma unroll
        for (int e = 0; e < 8; ++e) {
          const float pr = __shfl_xor(x[e], 4);
          x[e] = x[e] * cs8[e] + sgn * pr * sn8[e];
        }
      }
      if (!which) {
#pragma unroll
        for (int e = 0; e < 8; ++e) x[e] *= SC64;
      }
      if (!which || lane < 16) *(uint4*)ptr = pack8(x);
    }
    {
      const int hh = lane >> 5, li = lane & 31;
      bf16_t* ptr = Pr + C_CQ + 256 * hh + li * 8;
      const float* gg = (hh ? p.in[I_MLAKVAG] : p.in[I_MLAQAG]) + l * 256 + li * 8;
      unpack8(vcc, x);
      float ss = 0.f;
#pragma unroll
      for (int e = 0; e < 8; ++e) ss += x[e] * x[e];
      ss = red32(ss);
      const float rs = rsqrtf(ss * (1.f / 256.f) + 1e-6f);
#pragma unroll
      for (int e = 0; e < 8; ++e) x[e] = x[e] * rs * gg[e];
      *(uint4*)ptr = pack8(x);
    }
  }
  {
    bf16_t* XWA = (bf16_t*)(p.ws + OFF_XWA);
    const float* mu = p.in[I_RWMU] + l * 1792;
    const int dd = lane >> 5, which = (lane >> 4) & 1, c4 = (lane & 15) * 4;
    const int col = B_U + 1536 + 128 * which + 64 * dd + c4;
    for (int row = get_bid() * 8 + w; row < TR; row += gridDim.x * 8) {
      const int segb = (row < 256) ? 0 : 256, sege = (row < 256) ? 256 : TR;
      const bf16_t* pc = P + (size_t)row * LDP + col;
      float u0[4], um[4], up[4], o[4];
      unpack4(*(const uint2*)pc, u0);
      if (row > segb) unpack4(*(const uint2*)(pc - LDP), um); else { um[0] = um[1] = um[2] = um[3] = 0.f; }
      if (row < sege - 1) unpack4(*(const uint2*)(pc + LDP), up); else { up[0] = up[1] = up[2] = up[3] = 0.f; }
      const float4 m4 = *(const float4*)(mu + (col - B_U));
      const float mm[4] = {m4.x, m4.y, m4.z, m4.w};
#pragma unroll
      for (int e = 0; e < 4; ++e) {
        const float v = u0[e] + mm[e] * (0.5f * (um[e] + up[e]) - u0[e]);
        o[e] = which ? v : fast_tanh(v);
      }
      *(uint2*)(XWA + ((size_t)dd * TR + row) * 128 + 64 * which + c4) = pack4(o);
    }
  }
  for (int tile = get_bid(); tile < 260 * 10; tile += gridDim.x) {
    const int tt = tile % 260, hd = tile / 260;
    if (hd < 8) vt_tile(P + A_V + hd * 64, LDP, (bf16_t*)(p.ws + OFF_VTA) + (size_t)hd * 64 * TR, tt * 64, smem);
    else vt_tile(P + D_V + (hd - 8) * 64, LDP, (bf16_t*)(p.ws + OFF_VTD) + (size_t)(hd - 8) * 64 * TR, tt * 64, smem);
  }
}

DI void phase_mlaproj(const Params& p, int l, char* smem) {
  const bf16_t* P = (const bf16_t*)(p.ws + OFF_P);
  EpiStoreBf16 E;
  E.O = (bf16_t*)(p.ws + OFF_QM); E.ldc = 768;
  run_gemm(smem, P + C_CQ, LDP, (const bf16_t*)(p.ws + OFF_WUQT) + (size_t)l * 768 * 256, TR, 768, 256, E);
  E.O = (bf16_t*)(p.ws + OFF_KVRAW); E.ldc = 1024;
  run_gemm(smem, P + C_CKV, LDP, (const bf16_t*)(p.ws + OFF_WUKVT) + (size_t)l * 1024 * 256, TR, 1024, 256, E);
}

DI void phase_mlapost(const Params& p, int l, char* smem) {
  const int tid = get_tid(), lane = tid & 63, w = tid >> 6;
  const bf16_t* P = (const bf16_t*)(p.ws + OFF_P);
  bf16_t* Qm = (bf16_t*)(p.ws + OFF_QM);
  const bf16_t* KV = (const bf16_t*)(p.ws + OFF_KVRAW);
  bf16_t* Km = (bf16_t*)(p.ws + OFF_KM);
  const float* cosM = (const float*)(p.ws + OFF_ROPE) + SEQ * 64;
  const float* sinM = cosM + SEQ * 16;
  const int hh = lane >> 3, m = lane & 7;
  for (int row = get_bid() * 8 + w; row < TR; row += gridDim.x * 8) {
    const uint4 vnq = *(const uint4*)(Qm + (size_t)row * 768 + hh * 96 + 8 * m);
    const uint2 vtq = *(const uint2*)(Qm + (size_t)row * 768 + hh * 96 + 64 + 4 * m);
    const uint4 vnk = *(const uint4*)(KV + (size_t)row * 1024 + hh * 128 + 8 * m);
    const uint2 vtk = *(const uint2*)(P + (size_t)row * LDP + C_KR + 4 * m);
    float4 c4, s4;
    {
      const int t = (row >= 256) ? (row - 256) : 0;
      c4 = *(const float4*)(cosM + t * 16 + 4 * (m & 3));
      s4 = *(const float4*)(sinM + t * 16 + 4 * (m & 3));
    }
    const float cc[4] = {c4.x, c4.y, c4.z, c4.w}, sn[4] = {s4.x, s4.y, s4.z, s4.w};
#pragma unroll
    for (int which = 0; which < 2; ++which) {
      float x[12];
      const float* gg = (which ? p.in[I_MLAKG] : p.in[I_MLAQG]) + l * 96;
      unpack8(which ? vnk : vnq, x); unpack4(which ? vtk : vtq, x + 8);
      float ss = 0.f;
#pragma unroll
      for (int e = 0; e < 12; ++e) ss += x[e] * x[e];
      ss = red8(ss);
      const float rs = rsqrtf(ss * (1.f / 96.f) + 1e-6f);
#pragma unroll
      for (int e = 0; e < 8; ++e) x[e] = x[e] * rs * gg[8 * m + e];
#pragma unroll
      for (int e = 0; e < 4; ++e) x[8 + e] = x[8 + e] * rs * gg[64 + 4 * m + e];
      if (row >= 256) {
        const float sgn = (m < 4) ? -1.f : 1.f;
#pragma unroll
        for (int e = 0; e < 4; ++e) {
          const float pr = __shfl_xor(x[8 + e], 4);
          x[8 + e] = x[8 + e] * cc[e] + sgn * pr * sn[e];
        }
      }
      if (!which) {
#pragma unroll
        for (int e = 0; e < 12; ++e) x[e] *= SC96;
      }
      bf16_t* dn = which ? (Km + (size_t)row * 768 + hh * 96 + 8 * m) : (Qm + (size_t)row * 768 + hh * 96 + 8 * m);
      bf16_t* dt = which ? (Km + (size_t)row * 768 + hh * 96 + 64 + 4 * m) : (Qm + (size_t)row * 768 + hh * 96 + 64 + 4 * m);
      *(uint4*)dn = pack8(x);
      *(uint2*)dt = pack4(x + 8);
    }
  }
  for (int tile = get_bid(); tile < 260 * 8; tile += gridDim.x) {
    const int tt = tile % 260, hd = tile / 260;
    vt_tile(KV + hd * 128 + 64, 1024, (bf16_t*)(p.ws + OFF_VTM) + (size_t)hd * 64 * TR, tt * 64, smem);
  }
}

template <int DK, int SUB, bool HALF = false>
DI void attn_item(const bf16_t* __restrict__ Qp, int ldq, const bf16_t* __restrict__ Kp, int ldk,
                  const bf16_t* __restrict__ Vt, bf16_t* __restrict__ Gp, int ldg, int q0,
                  int r0a, int n0, int r1a, int n1, int na_mode, const float* __restrict__ rpb, char* smem) {
  constexpr int KS = DK / 16, LK = DK + 8, CPR = DK / 8;
  constexpr int KR = SUB * 64;
  constexpr int LV = KR + 8;
  constexpr int NKC = KR * CPR / 512;
  constexpr int NKR = (KR * CPR) % 512;
  const int tid = get_tid(), lane = tid & 63, w = tid >> 6, r = lane & 31, h = lane >> 5;
  const int grp = w >> 2;
  bf16_t* Ks = (bf16_t*)smem;
  bf16_t* Vs = Ks + 2 * KR * LK;
  float* rpbS = (float*)(Vs + 3 * 64 * LV);
  __syncthreads();
  if (na_mode) for (int i = tid; i < 466; i += 512) rpbS[i] = (i < 465) ? rpb[i] * LOG2E : -1e30f;
  const int qrow = q0 + 32 * (HALF ? (w & 3) : w) + r;
  bf16x8 qf[KS];
#pragma unroll
  for (int ks = 0; ks < KS; ++ks) qf[ks] = *(const bf16x8*)(Qp + (size_t)qrow * ldq + ks * 16 + h * 8);
  f32x16 o[2]; o[0] = zero16(); o[1] = zero16();
  f32x16 s[2]; s[0] = zero16(); s[1] = zero16();
  float mrun = 0.f;
  bool first = true;
  f32x16 negm = zero16();
  float lsa = 0.f, lsb = 0.f;
  const int nsteps = n0 + n1;
  const int nsup = nsteps / SUB;
  const int tq = qrow - 256;
  const int qr = tq >> 6, qc = tq & 63;
  const int rs = min(max(qr - 4, 0), 248), cs = min(max(qc - 8, 0), 48);
  constexpr int NK = NKC + (NKR ? 1 : 0);
  uint4 k0 = make_uint4(0, 0, 0, 0), k1 = k0, k2 = k0, v0 = k0, v1 = k0;
  auto kaddr = [&](int rowstart, int i) { const int c = tid + 512 * i; return Kp + (size_t)(rowstart + c / CPR) * ldk + (c % CPR) * 8; };
  auto vaddr = [&](int rowstart, int i) { const int c = tid + 512 * i; return Vt + (size_t)(c / (8 * SUB)) * TR + rowstart + (c % (8 * SUB)) * 8; };
  auto klds = [&](int kb, int i) { const int c = tid + 512 * i; return Ks + (kb * KR + c / CPR) * LK + (c % CPR) * 8; };
  auto vlds = [&](int vb, int i) { const int c = tid + 512 * i; return Vs + (vb * 64 + c / (8 * SUB)) * LV + (c % (8 * SUB)) * 8; };
  auto gload = [&](int T) {
    const int t64 = T * SUB;
    const int rowstart = (t64 < n0) ? (r0a + 64 * t64) : (r1a + 64 * (t64 - n0));
    k0 = *(const uint4*)kaddr(rowstart, 0);
    if (NK >= 2) { if (NKC >= 2 || tid < NKR) k1 = *(const uint4*)kaddr(rowstart, 1); }
    if (NK >= 3) { if (NKC >= 3 || tid < NKR) k2 = *(const uint4*)kaddr(rowstart, 2); }
    v0 = *(const uint4*)vaddr(rowstart, 0);
    if (SUB >= 2) v1 = *(const uint4*)vaddr(rowstart, 1);
  };
  auto sstore = [&](int kb, int vb) {
    *(uint4*)klds(kb, 0) = k0;
    if (NK >= 2) { if (NKC >= 2 || tid < NKR) *(uint4*)klds(kb, 1) = k1; }
    if (NK >= 3) { if (NKC >= 3 || tid < NKR) *(uint4*)klds(kb, 2) = k2; }
    *(uint4*)vlds(vb, 0) = v0;
    if (SUB >= 2) *(uint4*)vlds(vb, 1) = v1;
  };
  auto do_qk = [&](int u, int kb) {
    const int sub = u % SUB;
#pragma unroll
    for (int kt2 = 0; kt2 < 2; ++kt2) {
      const bf16_t* kbp = Ks + (kb * KR + 64 * sub + 32 * kt2 + r) * LK + h * 8;
#pragma unroll
      for (int ks = 0; ks < KS; ++ks) {
        bf16x8 a = *(const bf16x8*)(kbp + ks * 16);
        s[kt2] = (ks == 0) ? MFMA32(a, qf[ks], negm) : MFMA32(a, qf[ks], s[kt2]);
      }
    }
    if (na_mode && u >= n0) {
      const int kr = ((r1a - 256) >> 6) + (u - n0);
      const bool rowok = (kr >= rs) && (kr <= rs + 7);
      const int rbase = rowok ? ((kr - qr + 7) * 31 - qc + 15) : -100000;
      const int clo = cs, chi = cs + 15;
#pragma unroll
      for (int kt2 = 0; kt2 < 2; ++kt2)
#pragma unroll
        for (int e = 0; e < 16; ++e) {
          const int kc = 32 * kt2 + crow(e, h);
          const bool ok = (rbase >= -1000) && (kc >= clo) && (kc <= chi);
          const int idx = ok ? (rbase + kc) : 465;
          s[kt2][e] += rpbS[idx];
        }
    }
  };
  auto do_sm_pv = [&](int u, int vb) {
    const int sub = u % SUB;
    float mx = fmaxf(s[0][0], s[1][0]);
#pragma unroll
    for (int e = 1; e < 16; ++e) mx = fmaxf(mx, fmaxf(s[0][e], s[1][e]));
    mx = fmaxf(mx, __shfl_xor(mx, 32));
    if (first || __builtin_amdgcn_ballot_w64(mx > 8.f) != 0ull) {
      const float mnew = first ? (mrun + mx) : fmaxf(mrun, mrun + mx);
      const float dlt = mrun - mnew;
      const float alpha = first ? 1.f : __builtin_amdgcn_exp2f(dlt);
      mrun = mnew;
      lsa *= alpha; lsb *= alpha;
#pragma unroll
      for (int e = 0; e < 16; ++e) {
        o[0][e] *= alpha; o[1][e] *= alpha;
        s[0][e] += dlt; s[1][e] += dlt;
        negm[e] = -mnew;
      }
      first = false;
    }
#pragma unroll
    for (int kt2 = 0; kt2 < 2; ++kt2)
#pragma unroll
      for (int sx = 0; sx < 2; ++sx) {
        unsigned pk[4];
#pragma unroll
        for (int jj = 0; jj < 4; ++jj) {
          const float p0 = __builtin_amdgcn_exp2f(s[kt2][8 * sx + 2 * jj]);
          const float p1 = __builtin_amdgcn_exp2f(s[kt2][8 * sx + 2 * jj + 1]);
          lsa += p0; lsb += p1;
          pk[jj] = pack2(p0, p1);
        }
        uint4 pk4; pk4.x = pk[0]; pk4.y = pk[1]; pk4.z = pk[2]; pk4.w = pk[3];
        const bf16x8 pf = __builtin_bit_cast(bf16x8, pk4);
#pragma unroll
        for (int d2 = 0; d2 < 2; ++d2) {
          bf16x8 a = *(const bf16x8*)(Vs + (vb * 64 + 32 * d2 + r) * LV + 64 * sub + 32 * kt2 + 16 * sx + 8 * h);
          o[d2] = MFMA32(a, pf, o[d2]);
        }
      }
  };
  gload(0); sstore(0, 0);
  __syncthreads();
  int vcur = 0;
  for (int T = 0; T < nsup; ++T) {
    const int vprev = (vcur == 0) ? 2 : (vcur - 1);
    const int vnext = (vcur == 2) ? 0 : (vcur + 1);
    if (T + 1 < nsup) gload(T + 1);
    if (HALF) {
      const int u = T * SUB + grp;
      do_qk(u, T & 1); do_sm_pv(u, vcur);
    } else {
#pragma unroll
      for (int sub = 0; sub < SUB; ++sub) {
        const int u = T * SUB + sub;
        if (grp == 0) { do_qk(u, T & 1); do_sm_pv(u, vcur); }
        else { if (u > 0) do_sm_pv(u - 1, (sub == 0) ? vprev : vcur); do_qk(u, T & 1); }
      }
    }
    if (T + 1 < nsup) sstore((T + 1) & 1, vnext);
    __syncthreads();
    vcur = vnext;
  }
  if (!HALF) {
    if (grp == 1) {
      const int vlast = (vcur == 0) ? 2 : (vcur - 1);
      do_sm_pv(nsteps - 1, vlast);
    }
  }
  float lsum = lsa + lsb;
  if (HALF) {
    float* xch = (float*)smem + ((w & 3) * 64 + lane) * 36;
    if (grp == 1) {
#pragma unroll
      for (int d2 = 0; d2 < 2; ++d2)
#pragma unroll
        for (int q4 = 0; q4 < 4; ++q4)
          *(float4*)(xch + d2 * 16 + q4 * 4) = make_float4(o[d2][4 * q4], o[d2][4 * q4 + 1], o[d2][4 * q4 + 2], o[d2][4 * q4 + 3]);
      xch[32] = mrun; xch[33] = lsum;
    }
    __syncthreads();
    if (grp == 0) {
      const float m1 = xch[32], l1 = xch[33];
      const float mm = fmaxf(mrun, m1);
      const float a0 = __builtin_amdgcn_exp2f(mrun - mm), a1 = __builtin_amdgcn_exp2f(m1 - mm);
      lsum = lsum * a0 + l1 * a1;
#pragma unroll
      for (int d2 = 0; d2 < 2; ++d2)
#pragma unroll
        for (int q4 = 0; q4 < 4; ++q4) {
          const float4 ov = *(const float4*)(xch + d2 * 16 + q4 * 4);
          o[d2][4 * q4] = o[d2][4 * q4] * a0 + ov.x * a1;
          o[d2][4 * q4 + 1] = o[d2][4 * q4 + 1] * a0 + ov.y * a1;
          o[d2][4 * q4 + 2] = o[d2][4 * q4 + 2] * a0 + ov.z * a1;
          o[d2][4 * q4 + 3] = o[d2][4 * q4 + 3] * a0 + ov.w * a1;
        }
    }
  }
  const float lt = lsum + __shfl_xor(lsum, 32);
  const float inv = 1.f / lt;
  if (!HALF || grp == 0)
#pragma unroll
  for (int d2 = 0; d2 < 2; ++d2)
#pragma unroll
    for (int gq = 0; gq < 4; ++gq) {
      const int dv0 = 32 * d2 + 8 * gq + 4 * h;
      bf16_t* ptr = Gp + (size_t)qrow * ldg + dv0;
      uint2 gv = *(const uint2*)ptr;
      float g[4]; unpack4(gv, g);
      float y[4];
#pragma unroll
      for (int e = 0; e < 4; ++e) y[e] = o[d2][4 * gq + e] * inv * siluf_(g[e]);
      *(uint2*)ptr = pack4(y);
    }
}

DI float dpp_x1(float v) { return __builtin_bit_cast(float, __builtin_amdgcn_update_dpp(0, __builtin_bit_cast(int, v), 0xB1, 0xF, 0xF, true)); }
DI float dpp_x2(float v) { return __builtin_bit_cast(float, __builtin_amdgcn_update_dpp(0, __builtin_bit_cast(int, v), 0x4E, 0xF, 0xF, true)); }
DI float dpp_hm(float v) { return __builtin_bit_cast(float, __builtin_amdgcn_update_dpp(0, __builtin_bit_cast(int, v), 0x141, 0xF, 0xF, true)); }
DI float dpp_rm(float v) { return __builtin_bit_cast(float, __builtin_amdgcn_update_dpp(0, __builtin_bit_cast(int, v), 0x140, 0xF, 0xF, true)); }
DI float dpp_red8(float v) { v += dpp_x1(v); v += dpp_x2(v); v += dpp_hm(v); return v; }
DI float dpp_red16(float v) { v += dpp_x1(v); v += dpp_x2(v); v += dpp_hm(v); v += dpp_rm(v); return v; }

struct ScanVec { float4 w, k, b, n, r; float v; };
DI void scan_load(ScanVec& sv, const float* cb, const float* vb) {
  sv.w = *(const float4*)(cb);
  sv.k = *(const float4*)(cb + 2048);
  sv.b = *(const float4*)(cb + 2 * 2048);
  sv.n = *(const float4*)(cb + 3 * 2048);
  sv.r = *(const float4*)(cb + 4 * 2048);
  sv.v = *vb;
}

DI void scan_item(const Params& p, int l, int hd, int d, int rp, char* smem) {
  const int tid = get_tid(), lane = tid & 63, w = tid >> 6;
  float* CH = (float*)smem;
  float* YC = CH + 2 * 6 * 2048;
  bf16_t* W2T = (bf16_t*)(YC + 4096);
  bf16_t* XW = W2T + 2 * 64 * 72;
  float* LO = (float*)(XW + 4 * 2 * 8 * 72);
  const bf16_t* P = (const bf16_t*)(p.ws + OFF_P);
  bf16_t* Yd = (bf16_t*)(p.ws + (d ? OFF_Y1 : OFF_Y0));
  float* Cb = (float*)(p.ws + OFF_CB) + (size_t)d * TR * 8;
  __syncthreads();
  {
    const float* w2 = p.in[I_RWW2] + (size_t)(l * 2 + d) * 64 * 512 + hd * 64;
    const float* a2 = p.in[I_RWA2] + (size_t)(l * 2 + d) * 64 * 512 + hd * 64;
    for (int i = tid; i < 4096; i += 512) {
      const int j = i >> 6, c = i & 63;
      W2T[c * 72 + j] = f2bf(w2[(size_t)j * 512 + c]);
      W2T[64 * 72 + c * 72 + j] = f2bf(a2[(size_t)j * 512 + c]);
    }
  }
  __syncthreads();
  const int NCH = 520;
  const float* mu = p.in[I_RWMU] + l * 1792;
#ifdef PROBE_SCAN2
  for (int rep = 0; rep < 2; ++rep) {
#endif
  v2f S01 = {0.f, 0.f}, S23 = {0.f, 0.f};
  for (int ci = 0; ci <= NCH + 1; ++ci) {
    if (w >= 4) {
      const int pw = w - 4;
      if (ci < NCH) {
        const int buf = ci & 1;
        int segbase, seglen, cs;
        if (ci < 8) { segbase = 0; seglen = 256; cs = d ? (7 - ci) : ci; }
        else { segbase = 256; seglen = SEQ; cs = d ? (511 - (ci - 8)) : (ci - 8); }
        const int tl = lane >> 3, m = lane & 7;
        const int tc = 8 * pw + tl;
        const int t = 32 * cs + tc;
        const size_t row = (size_t)(segbase + t);
        const bool hm = t > 0, hp = t < seglen - 1;
        float xr[8], xk[8], xv[8];
        const int cols[3] = {B_U + hd * 64 + 8 * m, B_U + 512 + hd * 64 + 8 * m, B_U + 1024 + hd * 64 + 8 * m};
        uint4 r0[3], rm[3], rq[3];
#pragma unroll
        for (int vv = 0; vv < 3; ++vv) {
          const bf16_t* pc = P + row * LDP + cols[vv];
          r0[vv] = *(const uint4*)pc;
          rm[vv] = hm ? *(const uint4*)(pc - LDP) : make_uint4(0, 0, 0, 0);
          rq[vv] = hp ? *(const uint4*)(pc + LDP) : make_uint4(0, 0, 0, 0);
        }
        const bf16_t* xsrc = (const bf16_t*)(p.ws + OFF_XWA) + ((size_t)d * TR + row) * 128 + 8 * m;
        const uint4 xw16 = *(const uint4*)xsrc, xa16 = *(const uint4*)(xsrc + 64);
#pragma unroll
        for (int vv = 0; vv < 3; ++vv) {
          float* dst = (vv == 0) ? xr : (vv == 1) ? xk : xv;
          float u0[8], um[8], up[8];
          unpack8(r0[vv], u0); unpack8(rm[vv], um); unpack8(rq[vv], up);
          const float* mp = mu + (cols[vv] - B_U);
          const float4 m0 = *(const float4*)mp, m1 = *(const float4*)(mp + 4);
          const float mm[8] = {m0.x, m0.y, m0.z, m0.w, m1.x, m1.y, m1.z, m1.w};
#pragma unroll
          for (int e = 0; e < 8; ++e) dst[e] = u0[e] + mm[e] * (0.5f * (um[e] + up[e]) - u0[e]);
        }
        const int c0 = hd * 64 + 8 * m;
        float kk[8];
        {
          const float4 q0 = *(const float4*)(p.in[I_RWKK] + l * 512 + c0), q1 = *(const float4*)(p.in[I_RWKK] + l * 512 + c0 + 4);
          const float qq[8] = {q0.x, q0.y, q0.z, q0.w, q1.x, q1.y, q1.z, q1.w};
          float ss = 0.f;
#pragma unroll
          for (int e = 0; e < 8; ++e) { kk[e] = xk[e] * qq[e]; ss += kk[e] * kk[e]; }
          ss = dpp_red8(ss);
          const float rn = rsqrtf(ss + 1e-12f);
#pragma unroll
          for (int e = 0; e < 8; ++e) kk[e] *= rn;
        }
        bf16_t* xwp = XW + pw * (2 * 8 * 72);
        *(uint4*)(xwp + tl * 72 + 8 * m) = xw16;
        *(uint4*)(xwp + 8 * 72 + tl * 72 + 8 * m) = xa16;
        __builtin_amdgcn_fence(__ATOMIC_RELEASE, "wavefront");
        __builtin_amdgcn_wave_barrier();
        __builtin_amdgcn_fence(__ATOMIC_ACQUIRE, "wavefront");
        {
          const int r = lane & 31, h = lane >> 5;
          float* lop = LO + pw * (2 * 8 * 64);
#pragma unroll
          for (int mat = 0; mat < 2; ++mat) {
            f32x16 acc[2]; acc[0] = zero16(); acc[1] = zero16();
#pragma unroll
            for (int ks = 0; ks < 4; ++ks) {
              bf16x8 a;
              if (r < 8) a = *(const bf16x8*)(xwp + mat * 8 * 72 + r * 72 + ks * 16 + h * 8);
              else {
#pragma unroll
                for (int e = 0; e < 8; ++e) a[e] = 0;
              }
#pragma unroll
              for (int nt = 0; nt < 2; ++nt) {
                bf16x8 bb = *(const bf16x8*)(W2T + mat * 64 * 72 + (32 * nt + r) * 72 + ks * 16 + h * 8);
                acc[nt] = MFMA32(a, bb, acc[nt]);
              }
            }
#pragma unroll
            for (int nt = 0; nt < 2; ++nt)
#pragma unroll
              for (int e = 0; e < 4; ++e) lop[mat * 8 * 64 + (4 * h + e) * 64 + 32 * nt + r] = acc[nt][e];
          }
        }
        __builtin_amdgcn_fence(__ATOMIC_RELEASE, "wavefront");
        __builtin_amdgcn_wave_barrier();
        __builtin_amdgcn_fence(__ATOMIC_ACQUIRE, "wavefront");
        {
          const float* lop = LO + pw * (2 * 8 * 64);
          float* chb = CH + buf * (6 * 2048) + tc * 64 + 8 * m;
          const float4 lw0 = *(const float4*)(lop + tl * 64 + 8 * m), lw1 = *(const float4*)(lop + tl * 64 + 8 * m + 4);
          const float4 la0 = *(const float4*)(lop + 512 + tl * 64 + 8 * m), la1 = *(const float4*)(lop + 512 + tl * 64 + 8 * m + 4);
          const float lw[8] = {lw0.x, lw0.y, lw0.z, lw0.w, lw1.x, lw1.y, lw1.z, lw1.w};
          const float la[8] = {la0.x, la0.y, la0.z, la0.w, la1.x, la1.y, la1.z, la1.w};
          const float* pw0 = p.in[I_RWW0] + (l * 2 + d) * 512 + c0;
          const float* pa0 = p.in[I_RWA0] + (l * 2 + d) * 512 + c0;
          const float* pka = p.in[I_RWKA] + l * 512 + c0;
          const float* prk = p.in[I_RWRK] + l * 512 + c0;
          float bon = 0.f;
          float ow[8], okd[8], obd[8], onk[8];
#pragma unroll
          for (int e = 0; e < 8; ++e) {
            const float xwl = pw0[e] + lw[e];
            const float xal = pa0[e] + la[e];
            const float dec = __expf(-0.6065306597126334f * fast_sigmoid(xwl));
            const float a = fast_sigmoid(xal);
            const float kd = xk[e] * (1.f + (a - 1.f) * pka[e]);
            ow[e] = dec; okd[e] = kd; obd[e] = kk[e] * a; onk[e] = -kk[e];
            bon += xr[e] * kd * prk[e];
          }
          bon = dpp_red8(bon);
          if (m == 0 && rp == 0) Cb[row * 8 + hd] = bon;
          *(float4*)(chb + 0 * 2048) = make_float4(ow[0], ow[1], ow[2], ow[3]);
          *(float4*)(chb + 0 * 2048 + 4) = make_float4(ow[4], ow[5], ow[6], ow[7]);
          *(float4*)(chb + 1 * 2048) = make_float4(okd[0], okd[1], okd[2], okd[3]);
          *(float4*)(chb + 1 * 2048 + 4) = make_float4(okd[4], okd[5], okd[6], okd[7]);
          *(float4*)(chb + 2 * 2048) = make_float4(obd[0], obd[1], obd[2], obd[3]);
          *(float4*)(chb + 2 * 2048 + 4) = make_float4(obd[4], obd[5], obd[6], obd[7]);
          *(float4*)(chb + 3 * 2048) = make_float4(onk[0], onk[1], onk[2], onk[3]);
          *(float4*)(chb + 3 * 2048 + 4) = make_float4(onk[4], onk[5], onk[6], onk[7]);
          *(float4*)(chb + 4 * 2048) = make_float4(xr[0], xr[1], xr[2], xr[3]);
          *(float4*)(chb + 4 * 2048 + 4) = make_float4(xr[4], xr[5], xr[6], xr[7]);
          *(float4*)(chb + 5 * 2048) = make_float4(xv[0], xv[1], xv[2], xv[3]);
          *(float4*)(chb + 5 * 2048 + 4) = make_float4(xv[4], xv[5], xv[6], xv[7]);
        }
      }
      if (ci >= 2) {
        const int cj = ci - 2;
        int segbase, cs;
        if (cj < 8) { segbase = 0; cs = d ? (7 - cj) : cj; }
        else { segbase = 256; cs = d ? (511 - (cj - 8)) : (cj - 8); }
        const int ptid = tid - 256;
        const int tf = ptid >> 3, i2 = (ptid & 7) * 2;
        const float* yc = YC + (cj & 1) * 2048 + tf * 64 + i2 * 4;
        const float4 ya = *(const float4*)yc, yb = *(const float4*)(yc + 4);
        const size_t row = (size_t)(segbase + 32 * cs + tf);
        *(unsigned*)(Yd + row * 512 + hd * 64 + 16 * rp + i2) = pack2((ya.x + ya.y) + (ya.z + ya.w), (yb.x + yb.y) + (yb.z + yb.w));
      }
    } else {
      if (ci >= 1 && ci <= NCH) {
        __builtin_amdgcn_s_setprio(3);
        const int cj = ci - 1;
        const int il = tid >> 4, js = tid & 15;
        const float* chb = CH + (cj & 1) * (6 * 2048) + 4 * js;
        const float* vb = CH + (cj & 1) * (6 * 2048) + 5 * 2048 + 16 * rp + il;
        float* yc = YC + (cj & 1) * 2048 + il * 4 + (js >> 2);
        const int tstep = d ? -64 : 64;
        const int t0 = d ? 31 * 64 : 0;
        ScanVec cur, nxt;
        scan_load(cur, chb + t0, vb + t0);
        int toff = t0;
#pragma unroll 8
        for (int sidx = 0; sidx < 32; ++sidx) {
          const int tn = (sidx < 31) ? (toff + tstep) : toff;
          scan_load(nxt, chb + tn, vb + tn);
          const v2f n01 = {cur.n.x, cur.n.y}, n23 = {cur.n.z, cur.n.w};
          v2f pa = S01 * n01;
          pa = S23 * n23 + pa;
          float sa = dpp_red16(pa.x + pa.y);
          const v2f k01 = {cur.k.x, cur.k.y}, k23 = {cur.k.z, cur.k.w};
          const v2f b01 = {cur.b.x, cur.b.y}, b23 = {cur.b.z, cur.b.w};
          const v2f w01 = {cur.w.x, cur.w.y}, w23 = {cur.w.z, cur.w.w};
          const v2f vv2 = {cur.v, cur.v}, sa2 = {sa, sa};
          v2f t01 = vv2 * k01, t23 = vv2 * k23;
          t01 = sa2 * b01 + t01; t23 = sa2 * b23 + t23;
          S01 = S01 * w01 + t01; S23 = S23 * w23 + t23;
          const v2f r01 = {cur.r.x, cur.r.y}, r23 = {cur.r.z, cur.r.w};
          v2f qa = S01 * r01;
          qa = S23 * r23 + qa;
          float y = qa.x + qa.y;
          y += dpp_x1(y); y += dpp_x2(y);
          if ((js & 3) == 0) yc[(toff >> 6) * 64] = y;
          cur = nxt;
          toff = tn;
        }
        __builtin_amdgcn_s_setprio(0);
      }
    }
    __syncthreads();
  }
#ifdef PROBE_SCAN2
  }
#endif
}

DI void phase_mix(const Params& p, int l, int lb, char* smem, int* s_item) {
  const int tid = get_tid();
  int* ctr = (int*)(p.ws + OFF_CTR) + lb;
  const bf16_t* P = (const bf16_t*)(p.ws + OFF_P);
  bf16_t* Pw = (bf16_t*)(p.ws + OFF_P);
  const int nctx = (l == 0) ? 24 : 0;
  constexpr int NSPLIT = 128;
  constexpr int E_MLA = 64 + 512, E_GQF = E_MLA + (512 - NSPLIT), E_GQH = E_GQF + 2 * NSPLIT, E_NA = E_GQH + 512;
  const int total = E_NA + nctx;
  while (true) {
    __syncthreads();
    if (tid == 0) *s_item = atomicAdd(ctr, 1);
    __syncthreads();
    const int item = *s_item;
    if (item >= total) {
      if (lb != 0) break;
      const int wt = item - total;
      if (wt >= WT_TILES) break;
      weights_tile(p, 1, wt, smem);
      continue;
    }
    if (item < 64) {
      scan_item(p, l, item >> 3, (item >> 2) & 1, item & 3, smem);
    } else {
      int ty, hd, q0, n0 = 4, r1a = 0, n1 = 0, na = 0, half = 0;
      if (item < E_MLA) { const int it = item - 64; ty = 0; hd = it >> 6; q0 = 256 + 256 * (it & 63); n0 = 260; }
      else if (item < E_GQF) { const int it = item - E_MLA; ty = 1; hd = it >> 6; q0 = 256 + 256 * (it & 63); n0 = 260; }
      else if (item < E_GQH) { const int it = item - E_GQF + 2 * (512 - NSPLIT); ty = 1; hd = it >> 7; q0 = 256 + 128 * (it & 127); n0 = 260; half = 1; }
      else if (item < E_NA) {
        const int it = item - E_GQH; ty = 2; hd = it >> 6; const int qt = it & 63; q0 = 256 + 256 * qt;
        const int rsmin = min(max(4 * qt - 4, 0), 248);
        const int rsend = min(max(4 * qt + 3 - 4, 0), 248) + 7;
        r1a = 256 + 64 * rsmin; n1 = rsend - rsmin + 1; na = 1;
      } else { const int it = item - E_NA; ty = it >> 3; hd = it & 7; q0 = 0; }
      if (ty == 0) {
        attn_item<96, 2>((const bf16_t*)(p.ws + OFF_QM) + hd * 96, 768, (const bf16_t*)(p.ws + OFF_KM) + hd * 96, 768,
                         (const bf16_t*)(p.ws + OFF_VTM) + (size_t)hd * 64 * TR, Pw + C_G + hd * 64, LDP, q0,
                         0, n0, 0, 0, 0, nullptr, smem);
      } else {
        const bf16_t* Qp = (ty == 1) ? (P + D_Q + hd * 64) : (P + A_Q + hd * 64);
        const bf16_t* Kp = (ty == 1) ? (P + D_K + (hd >> 2) * 64) : (P + A_K + hd * 64);
        const bf16_t* Vt = (ty == 1) ? ((const bf16_t*)(p.ws + OFF_VTD) + (size_t)(hd >> 2) * 64 * TR)
                                     : ((const bf16_t*)(p.ws + OFF_VTA) + (size_t)hd * 64 * TR);
        bf16_t* Gp = (ty == 1) ? (Pw + D_G + hd * 64) : (Pw + A_G + hd * 64);
        if (na)
          attn_item<64, 1>(Qp, LDP, Kp, LDP, Vt, Gp, LDP, q0, 0, n0, r1a, n1, 1, p.in[I_NARPB] + (size_t)(l * 8 + hd) * 465, smem);
        else if (half)
          attn_item<64, 2, true>(Qp, LDP, Kp, LDP, Vt, Gp, LDP, q0, 0, n0, 0, 0, 0, nullptr, smem);
        else
          attn_item<64, 2>(Qp, LDP, Kp, LDP, Vt, Gp, LDP, q0, 0, n0, 0, 0, 0, nullptr, smem);
      }
    }
  }
}

DI void phase_fin(const Params& p, int l) {
  const int tid = get_tid(), lane = tid & 63, w = tid >> 6;
  bf16_t* P = (bf16_t*)(p.ws + OFF_P);
  const bf16_t* Y0 = (const bf16_t*)(p.ws + OFF_Y0);
  const bf16_t* Y1 = (const bf16_t*)(p.ws + OFF_Y1);
  const float* Cb = (const float*)(p.ws + OFF_CB);
  const float* mu = p.in[I_RWMU] + l * 1792 + 1024;
  const int hh = lane >> 3, c = lane * 8;
  for (int row = get_bid() * 8 + w; row < TR; row += gridDim.x * 8) {
    float a[8], b2[8], ys[8];
    unpack8(*(const uint4*)(Y0 + (size_t)row * 512 + c), a);
    unpack8(*(const uint4*)(Y1 + (size_t)row * 512 + c), b2);
    float sm = 0.f;
#pragma unroll
    for (int e = 0; e < 8; ++e) { ys[e] = a[e] + b2[e]; sm += ys[e]; }
    const float mean = red8(sm) * (1.f / 64.f);
    float vs = 0.f;
#pragma unroll
    for (int e = 0; e < 8; ++e) { const float dd = ys[e] - mean; vs += dd * dd; }
    const float var = red8(vs) * (1.f / 64.f);
    const float rstd = rsqrtf(var + 64e-5f);
    const int segb = (row < 256) ? 0 : 256, sege = (row < 256) ? 256 : TR;
    bf16_t* Pr = P + (size_t)row * LDP;
    float u0[8], um[8], up[8];
    unpack8(*(const uint4*)(Pr + B_U + 1024 + c), u0);
    if (row > segb) unpack8(*(const uint4*)(Pr - LDP + B_U + 1024 + c), um); else {
#pragma unroll
      for (int e = 0; e < 8; ++e) um[e] = 0.f;
    }
    if (row < sege - 1) unpack8(*(const uint4*)(Pr + LDP + B_U + 1024 + c), up); else {
#pragma unroll
      for (int e = 0; e < 8; ++e) up[e] = 0.f;
    }
    const float bon = Cb[(size_t)row * 8 + hh] + Cb[(size_t)TR * 8 + (size_t)row * 8 + hh];
    float g[8], o[8];
    unpack8(*(const uint4*)(Pr + B_G + c), g);
#pragma unroll
    for (int e = 0; e < 8; ++e) {
      const float v = u0[e] + mu[c + e] * (0.5f * (um[e] + up[e]) - u0[e]);
      const float yn = (ys[e] - mean) * rstd * p.in[I_RWGNW][l * 512 + c + e] + p.in[I_RWGNB][l * 512 + c + e];
      o[e] = (yn + bon * v) * siluf_(g[e]);
    }
    *(uint4*)(Pr + B_G + c) = pack8(o);
  }
}

DI void phase_gate(const Params& p, int l, char* smem) {
  const bf16_t* H = (const bf16_t*)(p.ws + OFF_H);
  const bf16_t* W = (const bf16_t*)(p.ws + OFF_MGT) + (size_t)l * 4096 * 1024;
  bf16_t* SG = (bf16_t*)(p.ws + OFF_SG);
#ifdef PROBE_GATE
  { EpiStoreBf16 E0; E0.O = SG + (size_t)256 * 4096; E0.ldc = 4096; run_gemm(smem, H + (size_t)256 * 1024, 1024, W, SEQ, 4096, 1024, E0); }
#endif
  float* sb = (float*)(smem + 131072);
  __syncthreads();
  for (int i = get_tid(); i < 4096; i += 512) sb[i] = p.in[I_MGB][l * 4096 + i];
  __syncthreads();
  EpiGate E; E.ldc = 4096; E.bias = sb;
  E.O = SG + (size_t)256 * 4096;
  run_gemm(smem, H + (size_t)256 * 1024, 1024, W, SEQ, 4096, 1024, E);
  if (l == 0) { E.O = SG; run_gemm(smem, H, 1024, W, 256, 4096, 1024, E); }
}

struct ZOrder {
  int ntile, G, c;
  DI bool next(int i, pg8::Unit& u) const {
    int tile;
    if (((ntile | G) & 7) == 0) {
      const int per = ntile >> 3, local = (c >> 3) + (i >> 2) * (G >> 3);
      if (local >= per) return false;
      tile = (c & 7) * per + local;
    } else {
      tile = c + (i >> 2) * G;
      if (tile >= ntile) return false;
    }
    u.pm = tile >> 2; u.pn = ((i & 3) << 2) | (tile & 3); return true;
  }
  DI size_t a_off(const pg8::Unit& u) const {
    const int i = u.pn >> 2;
    const int ycol = (i == 0) ? A_G : (i == 1) ? B_G : (i == 2) ? C_G : D_G;
    return (size_t)ycol * 2;
  }
  DI void a_ready(const pg8::Unit&) const {}
  DI void done(const pg8::Unit&) const {}
};
DI unsigned z_touch(const bf16_t* Abase, const bf16_t* SG, int pm, int ct, int br, int tid) {
  const int ycol = (br == 0) ? A_G : (br == 1) ? B_G : (br == 2) ? C_G : D_G;
  const unsigned a = *(const unsigned*)(Abase + (size_t)(pm * 256 + 64 * ct + (tid >> 3)) * LDP + ycol + (tid & 7) * 64);
  const bf16_t* sgp = SG + (size_t)(pm * 256) * 4096 + br * 1024 + ct * 256;
  const unsigned g0 = *(const unsigned*)(sgp + (size_t)(tid >> 2) * 4096 + (tid & 3) * 64);
  const unsigned g1 = *(const unsigned*)(sgp + (size_t)(128 + (tid >> 2)) * 4096 + (tid & 3) * 64);
  return a ^ g0 ^ g1;
}
struct EpiZ2 {
  static constexpr bool PERM = true, AFTER_DRAIN = false;
  bf16_t* ACC; const bf16_t* SG;
  const bf16_t* Abase;
  DI void operator()(const pg8::f32x4 (&acc)[2][2][4][2], const pg8::Unit& u, int wr, int wc, int fr, int fq) const {
    const int br = u.pn >> 2;
    unsigned touched = 0;
    if (br < 3) touched = z_touch(Abase, SG, u.pm, u.pn & 3, br + 1, (wr * 4 + wc) * 64 + fq * 16 + fr);
    const int row0 = u.pm * 256 + wr * 64 + fr, col0 = (u.pn & 3) * 256 + wc * 32 + 8 * fq;
#pragma unroll
    for (int ai = 0; ai < 2; ++ai)
#pragma unroll
      for (int m = 0; m < 4; ++m) {
        const size_t row = (size_t)(row0 + ai * 128 + m * 16);
#pragma unroll
        for (int bj = 0; bj < 2; ++bj) {
          const int col = col0 + bj * 128;
          float g[8], a[8];
          unpack8(*(const uint4*)(SG + row * 4096 + br * 1024 + col), g);
          const pg8::f32x4 v0 = acc[ai][bj][m][0], v1 = acc[ai][bj][m][1];
          const float z[8] = {v0[0], v0[1], v0[2], v0[3], v1[0], v1[1], v1[2], v1[3]};
          if (br == 0) {
#pragma unroll
            for (int e = 0; e < 8; ++e) a[e] = g[e] * z[e];
          } else {
            unpack8(*(const uint4*)(ACC + row * 1024 + col), a);
#pragma unroll
            for (int e = 0; e < 8; ++e) a[e] += g[e] * z[e];
          }
          *(uint4*)(ACC + row * 1024 + col) = pack8(a);
        }
      }
    asm volatile("" :: "v"(touched));
  }
};
struct EpiZdry {
  static constexpr bool PERM = true, AFTER_DRAIN = false;
  bf16_t* ACC;
  DI void operator()(const pg8::f32x4 (&acc)[2][2][4][2], const pg8::Unit& u, int wr, int wc, int fr, int fq) const {
    const int row0 = u.pm * 256 + wr * 64 + fr, col0 = (u.pn & 3) * 256 + wc * 32 + 8 * fq;
#pragma unroll
    for (int ai = 0; ai < 2; ++ai)
#pragma unroll
      for (int m = 0; m < 4; ++m) {
        const size_t row = (size_t)(row0 + ai * 128 + m * 16);
#pragma unroll
        for (int bj = 0; bj < 2; ++bj) {
          const int col = col0 + bj * 128;
          const pg8::f32x4 v0 = acc[ai][bj][m][0], v1 = acc[ai][bj][m][1];
          const float z[8] = {v0[0], v0[1], v0[2], v0[3], v1[0], v1[1], v1[2], v1[3]};
          *(uint4*)(ACC + row * 1024 + col) = pack8(z);
        }
      }
  }
};
DI void z_stream(const Params& p, int l, int row0, int M, char* smem) {
#ifdef PROBE_ZDRY
  {
    EpiZdry E0; E0.ACC = (bf16_t*)(p.ws + OFF_ACC) + (size_t)row0 * 1024;
    pg8::Gemm g0; g0.A = (const bf16_t*)(p.ws + OFF_P) + (size_t)row0 * LDP; g0.Bt = (const bf16_t*)(p.ws + OFF_BRT) + (size_t)l * 4096 * 512;
    g0.M = M; g0.N = 4096; g0.K = 512; g0.lda = LDP;
    ZOrder S0; S0.ntile = (M >> 8) * 4; S0.G = (int)gridDim.x; S0.c = get_bid();
    __syncthreads();
    pg8::gemm_phase<EpiZdry, ZOrder, false>((PG8_LAS unsigned char*)smem, g0, S0, E0, nullptr);
    __syncthreads();
  }
#endif
  EpiZ2 E;
  E.ACC = (bf16_t*)(p.ws + OFF_ACC) + (size_t)row0 * 1024;
  E.SG = (const bf16_t*)(p.ws + OFF_SG) + (size_t)row0 * 4096;
  pg8::Gemm g; g.A = (const bf16_t*)(p.ws + OFF_P) + (size_t)row0 * LDP; g.Bt = (const bf16_t*)(p.ws + OFF_BRT) + (size_t)l * 4096 * 512;
  g.M = M; g.N = 4096; g.K = 512; g.lda = LDP;
  ZOrder S; S.ntile = (M >> 8) * 4; S.G = (int)gridDim.x; S.c = get_bid();
  E.Abase = g.A;
  {
    pg8::Unit u0;
    if (S.next(0, u0)) { const unsigned t0 = z_touch(E.Abase, E.SG, u0.pm, u0.pn & 3, 0, get_tid()); asm volatile("" :: "v"(t0)); }
  }
  __syncthreads();
  pg8::gemm_phase<EpiZ2, ZOrder, false>((PG8_LAS unsigned char*)smem, g, S, E, nullptr);
  __syncthreads();
}
DI void phase_z(const Params& p, int l, char* smem) {
  z_stream(p, l, 256, SEQ, smem);
  if (l == 0) z_stream(p, l, 0, 256, smem);
}

DI void phase_merge2(const Params& p, int l, int b, char* smem) {
  const bf16_t* ACC = (const bf16_t*)(p.ws + OFF_ACC);
  const bf16_t* W = (const bf16_t*)(p.ws + OFF_OUTT) + (size_t)l * 1024 * 1024;
  const float* modv = (const float*)(p.ws + OFF_MODV);
  EpiOut E;
  E.src = ((l == 0) ? p.in[I_X] : p.out) + (size_t)b * SEQ * 1024;
  E.dst = p.out + (size_t)b * SEQ * 1024;
  E.gt = modv + (l * 3 + b) * 3072 + 2048;
  run_gemm(smem, ACC + (size_t)256 * 1024, 1024, W, SEQ, 1024, 1024, E);
  if (l == 0) {
    E.src = p.in[I_CTX] + (size_t)b * 256 * 1024;
    E.dst = (float*)(p.ws + OFF_CX1) + (size_t)b * 256 * 1024;
    E.gt = modv + (l * 3 + 2) * 3072 + 2048;
    run_gemm(smem, ACC, 1024, W, 256, 1024, 1024, E);
  }
}

__global__ void __launch_bounds__(512) mk_forward(Params p, int ph_lo, int ph_hi) {
  __shared__ __attribute__((aligned(16))) char smem[158720];
  __shared__ int s_item;
  cg::grid_group grid = cg::this_grid();
#ifdef TMASK
  unsigned long long t_acc = 0;
#define TIMED(bit, call) do { if ((TMASK >> (bit)) & 1) { const unsigned long long t0_ = wall_clock64(); call; __syncthreads(); t_acc += wall_clock64() - t0_; } else { call; } } while (0)
#else
#define TIMED(bit, call) do { call; } while (0)
#endif
  for (int ph = ph_lo; ph < ph_hi; ++ph) {
    if (ph == 0) {
      if (PH_ON(9)) TIMED(10, phase_prep(p, smem));
    } else if (ph == 1) {
      if (PH_ON(0)) TIMED(0, phase_h(p, 0, 0));
    } else {
      const int q = ph - 2;
      const int lb = q / 8, k = q % 8 + 1;
      const int l = lb >> 1, b = lb & 1;
      if (k == 1) { if (PH_ON(1)) TIMED(1, phase_g1(p, l, smem)); }
      else if (k == 2) { if (PH_ON(2)) TIMED(2, phase_post(p, l, smem)); }
      else if (k == 3) { if (PH_ON(3)) TIMED(3, phase_mlaproj(p, l, smem)); }
      else if (k == 4) { if (PH_ON(4)) TIMED(4, phase_mlapost(p, l, smem)); }
      else if (k == 5) { if (PH_ON(5)) TIMED(5, phase_mix(p, l, lb, smem, &s_item)); }
      else if (k == 6) { if (PH_ON(6)) { TIMED(6, phase_fin(p, l)); TIMED(7, phase_gate(p, l, smem)); } }
      else if (k == 7) { if (PH_ON(7)) TIMED(8, phase_z(p, l, smem)); }
      else {
        if (PH_ON(8)) TIMED(9, phase_merge2(p, l, b, smem));
        if (lb < 3) { const int nl = (lb + 1) >> 1, nb = (lb + 1) & 1; if (PH_ON(0)) TIMED(0, phase_h(p, nl, nb)); }
      }
    }
    if (ph + 1 < ph_hi) grid.sync();
  }
#ifdef TMASK
  { const unsigned long long t0_ = wall_clock64(); while (wall_clock64() - t0_ < t_acc) { __builtin_amdgcn_s_sleep(8); } }
#endif
}

extern "C" void kernel_launch(void* const* d_in, const int* in_sizes, int n_in, void* d_out, int out_size, void* d_ws,
                              size_t ws_size, hipStream_t stream) {
  Params p{};
  for (int i = 0; i < 33; ++i) p.in[i] = (const float*)d_in[i];
  p.out = (float*)d_out;
  p.ws = (char*)d_ws;
  const int NPH = 2 + 4 * 8;
#if MULTI
  for (int ph = 0; ph < NPH; ++ph) {
    hipLaunchKernelGGL(mk_forward, dim3(256), dim3(512), 0, stream, p, ph, ph + 1);
  }
#else
  static int grid_blocks = 0;
  if (!grid_blocks) {
    int dev = 0, cus = 0, per_cu = 0;
    hipGetDevice(&dev);
    hipDeviceGetAttribute(&cus, hipDeviceAttributeMultiprocessorCount, dev);
    hipOccupancyMaxActiveBlocksPerMultiprocessor(&per_cu, mk_forward, 512, 0);
    if (per_cu < 1) per_cu = 1;
    grid_blocks = cus * per_cu;
  }
  int lo = 0, hi = NPH;
  void* args[] = {&p, &lo, &hi};
  hipError_t e = hipLaunchCooperativeKernel((void*)mk_forward, dim3(grid_blocks), dim3(512), args, 0, stream);
  if (e != hipSuccess) fprintf(stderr, "cooperative launch failed: %s (grid %d)\n", hipGetErrorString(e), grid_blocks);
#endif
}
```

```cpp
#include <hip/hip_runtime.h>
#include <hip/hip_cooperative_groups.h>
#include <cstdio>
namespace cg = cooperative_groups;

#ifndef ONLY
#define ONLY (-1)
#endif
#define PH_ON(x) (ONLY < 0 || ONLY == (x))
#ifndef MULTI
#define MULTI 0
#endif

typedef unsigned short bf16_t;
typedef __attribute__((ext_vector_type(8))) short bf16x8;
typedef __attribute__((ext_vector_type(16))) float f32x16;
#define DI __device__ __forceinline__
#define MFMA32(a, b, c) __builtin_amdgcn_mfma_f32_32x32x16_bf16((a), (b), (c), 0, 0, 0)

#define DM 1024
#define SEQ 16384
#define CTXL 256
#define TR 16640
#define LDP 6912
#define NIN 6688
#define NPAD 6912
#define A_Q 0
#define A_K 512
#define A_V 1024
#define A_G 1536
#define B_U 2048
#define B_G 3840
#define C_CQ 4352
#define C_CKV 4608
#define C_KR 4864
#define C_G 4896
#define D_Q 5408
#define D_K 5920
#define D_V 6048
#define D_G 6176
#define LOG2E 1.4426950408889634f
#define SC64 (0.125f * LOG2E)
#define SC96 (0.10206207261596575f * LOG2E)

constexpr size_t SZ_WINT = (size_t)2 * NPAD * 1024 * 2;
constexpr size_t SZ_MGT = (size_t)2 * 4 * 1024 * 1024 * 2;
constexpr size_t SZ_BRT = (size_t)2 * 4 * 1024 * 512 * 2;
constexpr size_t SZ_OUTT = (size_t)2 * 1024 * 1024 * 2;
constexpr size_t SZ_WUQT = (size_t)2 * 768 * 256 * 2;
constexpr size_t SZ_WUKVT = (size_t)2 * 1024 * 256 * 2;
constexpr size_t SZ_MODV = (size_t)2 * 3 * 3072 * 4;
constexpr size_t SZ_ROPE = (size_t)SEQ * 96 * 4;
constexpr size_t SZ_CX1 = (size_t)2 * 256 * 1024 * 4;
constexpr size_t SZ_CTR = 256;
constexpr size_t SZ_H = (size_t)TR * 1024 * 2;
constexpr size_t SZ_P = (size_t)TR * LDP * 2;
constexpr size_t SZ_VTA = (size_t)8 * 64 * TR * 2;
constexpr size_t SZ_VTD = (size_t)2 * 64 * TR * 2;
constexpr size_t SZ_QM = (size_t)TR * 768 * 2;
constexpr size_t SZ_KVRAW = (size_t)TR * 1024 * 2;
constexpr size_t SZ_KM = (size_t)TR * 768 * 2;
constexpr size_t SZ_VTM = (size_t)8 * 64 * TR * 2;
constexpr size_t SZ_Y = (size_t)TR * 512 * 2;
constexpr size_t SZ_CB = (size_t)2 * TR * 8 * 4;

constexpr size_t SZ_SG = (size_t)TR * 4096 * 2;
constexpr size_t OFF_WINT = 0;
constexpr size_t OFF_MGT = OFF_WINT + SZ_WINT;
constexpr size_t OFF_BRT = OFF_MGT + SZ_MGT;
constexpr size_t OFF_OUTT = OFF_BRT + SZ_BRT;
constexpr size_t OFF_WUQT = OFF_OUTT + SZ_OUTT;
constexpr size_t OFF_WUKVT = OFF_WUQT + SZ_WUQT;
constexpr size_t OFF_MODV = OFF_WUKVT + SZ_WUKVT;
constexpr size_t OFF_ROPE = OFF_MODV + SZ_MODV;
constexpr size_t OFF_CX1 = OFF_ROPE + SZ_ROPE;
constexpr size_t OFF_CTR = OFF_CX1 + SZ_CX1;
constexpr size_t OFF_H = OFF_CTR + SZ_CTR;
constexpr size_t OFF_P = OFF_H + SZ_H;
constexpr size_t OFF_Y0 = OFF_P + SZ_P;
constexpr size_t OFF_Y1 = OFF_Y0 + SZ_Y;
constexpr size_t OFF_CB = OFF_Y1 + SZ_Y;
constexpr size_t OFF_VTA = OFF_CB + SZ_CB;
constexpr size_t OFF_VTD = OFF_VTA + SZ_VTA;
constexpr size_t OFF_QM = OFF_VTD + SZ_VTD;
constexpr size_t OFF_KVRAW = OFF_QM + SZ_QM;
constexpr size_t OFF_KM = OFF_KVRAW + SZ_KVRAW;
constexpr size_t OFF_VTM = OFF_KM + SZ_KM;
constexpr size_t OFF_END = OFF_VTM + SZ_VTM;
constexpr size_t OFF_XWA = OFF_END;
constexpr size_t SZ_XWA = (size_t)2 * TR * 128 * 2;
constexpr size_t OFF_SG = OFF_VTA;
constexpr size_t OFF_ACC = OFF_Y0;
static_assert(OFF_SG + SZ_SG <= (size_t)536870912, "workspace overflow");
static_assert(OFF_XWA + SZ_XWA <= (size_t)536870912, "workspace overflow");

struct Params {
  const float* in[33];
  float* out;
  char* ws;
};
enum { I_X = 0, I_C, I_CTX, I_CCTX, I_NORMG, I_MODW, I_MODB, I_WIN, I_NAQG, I_NAKG, I_NARPB, I_RWMU, I_RWW0, I_RWW2,
       I_RWA0, I_RWA2, I_RWKK, I_RWKA, I_RWRK, I_RWGNW, I_RWGNB, I_MLAQAG, I_MLAKVAG, I_MLAWUQ, I_MLAWUKV, I_MLAQG,
       I_MLAKG, I_GQAQG, I_GQAKG, I_MGW, I_MGB, I_WBR, I_WOUT };

DI int get_tid() { int t = threadIdx.x; asm volatile("" : "+v"(t)); return t; }
DI int get_bid() { int b = blockIdx.x; asm volatile("" : "+s"(b)); return b; }
typedef __attribute__((ext_vector_type(2))) float v2f;
typedef __attribute__((ext_vector_type(2))) __bf16 v2bf_t;
DI unsigned pack2(float a, float b) { v2f f = {a, b}; v2bf_t hv = __builtin_convertvector(f, v2bf_t); return __builtin_bit_cast(unsigned, hv); }
DI bf16_t f2bf(float x) { return (bf16_t)(pack2(x, 0.f) & 0xffffu); }
DI float bf2f(bf16_t b) { return __uint_as_float(((unsigned)b) << 16); }
DI float lo2f(unsigned u) { return __uint_as_float(u << 16); }
DI float hi2f(unsigned u) { return __uint_as_float(u & 0xffff0000u); }
DI void unpack8(const uint4& v, float* x) {
  x[0] = lo2f(v.x); x[1] = hi2f(v.x); x[2] = lo2f(v.y); x[3] = hi2f(v.y);
  x[4] = lo2f(v.z); x[5] = hi2f(v.z); x[6] = lo2f(v.w); x[7] = hi2f(v.w);
}
DI uint4 pack8(const float* x) {
  uint4 v; v.x = pack2(x[0], x[1]); v.y = pack2(x[2], x[3]); v.z = pack2(x[4], x[5]); v.w = pack2(x[6], x[7]); return v;
}
DI void unpack4(const uint2& v, float* x) { x[0] = lo2f(v.x); x[1] = hi2f(v.x); x[2] = lo2f(v.y); x[3] = hi2f(v.y); }
DI uint2 pack4(const float* x) { uint2 v; v.x = pack2(x[0], x[1]); v.y = pack2(x[2], x[3]); return v; }
DI float red8(float v) { v += __shfl_xor(v, 1); v += __shfl_xor(v, 2); v += __shfl_xor(v, 4); return v; }
DI float red32(float v) { v = red8(v); v += __shfl_xor(v, 8); v += __shfl_xor(v, 16); return v; }
DI float red64(float v) { v = red32(v); v += __shfl_xor(v, 32); return v; }
DI float sigmoidf_(float x) { return 1.f / (1.f + __expf(-x)); }
DI float siluf_(float x) { return x / (1.f + __expf(-x)); }
DI float fast_tanh(float x) { return 1.f - 2.f * __builtin_amdgcn_rcpf(1.f + __builtin_amdgcn_exp2f(2.8853900817779268f * x)); }
DI float fast_sigmoid(float x) { return __builtin_amdgcn_rcpf(1.f + __builtin_amdgcn_exp2f(-1.4426950408889634f * x)); }
DI int crow(int e, int h) { return (e & 3) + 8 * (e >> 2) + 4 * h; }
DI f32x16 zero16() { f32x16 z; for (int i = 0; i < 16; ++i) z[i] = 0.f; return z; }

template <int NJ>
DI void gemm_core(const bf16_t* __restrict__ A, int lda, const bf16_t* __restrict__ Bt, int ldb, int K,
                  f32x16 (&acc)[2][NJ], char* smem) {
  const int tid = get_tid(), lane = tid & 63, w = tid >> 6, r = lane & 31, h = lane >> 5;
  const int wm = w >> 1, wn = w & 1;
  bf16_t* As = (bf16_t*)smem;
  bf16_t* Bs = As + 2 * 256 * 72;
  uint4 ra[4], rb[NJ];
  const int nk = K >> 6;
  const bf16_t* Ag = A + (size_t)(tid >> 3) * lda + (tid & 7) * 8;
  const bf16_t* Bg = Bt + (size_t)(tid >> 3) * ldb + (tid & 7) * 8;
  bf16_t* Asw = As + (tid >> 3) * 72 + (tid & 7) * 8;
  bf16_t* Bsw = Bs + (tid >> 3) * 72 + (tid & 7) * 8;
  __syncthreads();
#pragma unroll
  for (int i = 0; i < 4; ++i) ra[i] = *(const uint4*)(Ag + (size_t)(64 * i) * lda);
#pragma unroll
  for (int i = 0; i < NJ; ++i) rb[i] = *(const uint4*)(Bg + (size_t)(64 * i) * ldb);
#pragma unroll
  for (int i = 0; i < 4; ++i) *(uint4*)(Asw + 64 * i * 72) = ra[i];
#pragma unroll
  for (int i = 0; i < NJ; ++i) *(uint4*)(Bsw + 64 * i * 72) = rb[i];
  __syncthreads();
  for (int kt = 0; kt < nk; ++kt) {
    const int buf = kt & 1;
    if (kt + 1 < nk) {
      const int ko = (kt + 1) * 64;
#pragma unroll
      for (int i = 0; i < 4; ++i) ra[i] = *(const uint4*)(Ag + (size_t)(64 * i) * lda + ko);
#pragma unroll
      for (int i = 0; i < NJ; ++i) rb[i] = *(const uint4*)(Bg + (size_t)(64 * i) * ldb + ko);
    }
    const bf16_t* Ab = As + (buf * 256 + 64 * wm + r) * 72 + h * 8;
    const bf16_t* Bb = Bs + (buf * 64 * NJ + 32 * NJ * wn + r) * 72 + h * 8;
#pragma unroll
    for (int ks = 0; ks < 4; ++ks) {
      bf16x8 a0 = *(const bf16x8*)(Ab + ks * 16);
      bf16x8 a1 = *(const bf16x8*)(Ab + 32 * 72 + ks * 16);
#pragma unroll
      for (int j = 0; j < NJ; ++j) {
        bf16x8 b0 = *(const bf16x8*)(Bb + j * 32 * 72 + ks * 16);
        acc[0][j] = MFMA32(a0, b0, acc[0][j]);
        acc[1][j] = MFMA32(a1, b0, acc[1][j]);
      }
    }
    if (kt + 1 < nk) {
      const int nb = buf ^ 1;
#pragma unroll
      for (int i = 0; i < 4; ++i) *(uint4*)(Asw + (nb * 256 + 64 * i) * 72) = ra[i];
#pragma unroll
      for (int i = 0; i < NJ; ++i) *(uint4*)(Bsw + (nb * 64 * NJ + 64 * i) * 72) = rb[i];
    }
    __syncthreads();
  }
}

template <int NJ>
DI void store_tile_bf16(const f32x16 (&acc)[2][NJ], bf16_t* dst, int ld, int ncols) {
  const int tid = get_tid(), lane = tid & 63, w = tid >> 6, r = lane & 31, h = lane >> 5;
  const int wm = w >> 1, wn = w & 1;
#pragma unroll
  for (int i = 0; i < 2; ++i)
#pragma unroll
    for (int j = 0; j < NJ; ++j) {
      const int col = 32 * NJ * wn + 32 * j + r;
      if (col < ncols) {
        bf16_t* d0 = dst + (size_t)(64 * wm + 32 * i + 4 * h) * ld + col;
#pragma unroll
        for (int e = 0; e < 16; ++e) d0[(size_t)((e & 3) + 8 * (e >> 2)) * ld] = f2bf(acc[i][j][e]);
      }
    }
}

namespace pg8 {
#define PG8_LAS __attribute__((address_space(3)))
typedef unsigned short bf16_t;
typedef short bf16x8 __attribute__((ext_vector_type(8)));
typedef float f32x4 __attribute__((ext_vector_type(4)));
typedef unsigned u32x4 __attribute__((ext_vector_type(4)));
constexpr int BM = 256, BK = 64, HALF = 128, HTB = HALF * BK * 2  , STAGE_BYTES = 8 * HTB, NXCD = 8, WGM = 8;

__host__ __device__ __forceinline__ int lds_byte(int r, int c) { const int st = (r >> 4) * 2 + (c >> 5), rr = r & 15, cc = c & 31, ob = rr * 64 + cc * 2; return st * 1024 + (ob ^ (((ob >> 9) & 1) << 5)); }
__host__ __device__ __forceinline__ void stage_rc(int b, int& R, int& C) { const int st = b / 1024, sb = b % 1024, swz = sb ^ (((sb >> 9) & 1) << 5); R = (st >> 1) * 16 + swz / 64; C = (st & 1) * 32 + (swz % 64) / 2; }
__host__ __device__ __forceinline__ int perm32(int rho) { const int n = rho >> 4, i = rho & 15; return 8 * (i >> 2) + 4 * n + (i & 3); }

struct Unit { int pm, pn; };
struct Gemm { const bf16_t* A; const bf16_t* Bt; int M, N, K, lda; };

struct StaticOrder {
    int nM, nN, nwg, G, c;
    __host__ __device__ void init(int M, int N, int G_, int c_) { nM = M / BM; nN = N / BM; nwg = nM * nN; G = G_; c = c_; }
    __host__ __device__ bool next(int i, Unit& u) const {
        const long L = (long)i * G + c; if (L >= nwg) return false;
        int wgid = (int)L; { const int q = nwg / NXCD, r = nwg % NXCD, xcd = wgid % NXCD, off = wgid / NXCD; wgid = (xcd < r ? xcd * (q + 1) : r * (q + 1) + (xcd - r) * q) + off; }
        const int nig = WGM * nN, gid = wgid / nig, fm = gid * WGM, gsz = (nM - fm) < WGM ? (nM - fm) : WGM;
        u.pm = fm + ((wgid % nig) % gsz); u.pn = (wgid % nig) / gsz; return true;
    }
    __device__ __forceinline__ void a_ready(const Unit&) const {}
    __device__ __forceinline__ void done(const Unit&) const {}
    __device__ __forceinline__ size_t a_off(const Unit&) const { return 0; }
};
template <class Epi, class Sched, bool STAMP = false>
__device__ __forceinline__ void gemm_phase(PG8_LAS unsigned char* lds, const Gemm g, const Sched& S, const Epi& E, unsigned long long* stamps) {
    const int tid = get_tid(), wid = __builtin_amdgcn_readfirstlane(tid >> 6), lane = tid & 63, wr = wid >> 2, wc = wid & 3, fr = lane & 15, fq = lane >> 4;
    const int K = g.K, nt = K / BK;
    int ts_lo = 0, ts_hi = 0, nts = 0; const unsigned long long rt_entry = STAMP ? (unsigned long long)wall_clock64() : 0ull;
#define PG8_STAMP() do { if (STAMP && wid == 0 && nts < 64) { const unsigned long long _c = (unsigned long long)clock64(); \
        ts_lo = (lane == nts) ? (int)(unsigned)_c : ts_lo; ts_hi = (lane == nts) ? (int)(unsigned)(_c >> 32) : ts_hi; ++nts; } } while (0)
    PG8_STAMP();
    unsigned voffA[2], voffB[2];
#pragma unroll
    for (int i = 0; i < 2; ++i) { int R, C; stage_rc(tid * 16 + i * 8192, R, C); const int Rb = Epi::PERM ? ((R & ~31) + perm32(R & 31)) : R;
        voffA[i] = (unsigned)(R * g.lda + C) * 2u; voffB[i] = (unsigned)(Rb * K + C) * 2u; }
    const size_t kstep = (size_t)(BK * 2);
    const size_t hstep = (size_t)HALF * K * 2; const size_t hstepA = (size_t)HALF * g.lda * 2; const size_t tstepA = 2 * hstepA;
    const size_t tstep = 2 * hstep;
    const unsigned ldsw = (unsigned)wid * 1024u;
    const int aoff = lds_byte(wr * 64 + fr, fq * 8), boff = lds_byte(wc * 32 + fr, fq * 8);
#define PG8_SA(b, h) (((b) * 2 + (h)) * HTB)
#define PG8_SB(b, h) ((4 + (b) * 2 + (h)) * HTB)
#define PG8_STAGE(bufoff, gbase, voff) do { _Pragma("unroll") for (int _i = 0; _i < 2; ++_i) \
        __builtin_amdgcn_global_load_lds((const unsigned*)((const char*)(gbase) + (voff)[_i]), (PG8_LAS unsigned*)(lds + (bufoff) + ldsw + _i * 8192), 16, 0, 0); } while (0)
#define PG8_LDA(dst, b, h) do { _Pragma("unroll") for (int m = 0; m < 4; ++m) _Pragma("unroll") for (int k = 0; k < 2; ++k) dst[m][k] = *(const PG8_LAS bf16x8*)(lds + PG8_SA(b, h) + aoff + m * 2048 + k * 1024); } while (0)
#define PG8_LDB(dst, b, h) do { _Pragma("unroll") for (int n = 0; n < 2; ++n) _Pragma("unroll") for (int k = 0; k < 2; ++k) dst[n][k] = *(const PG8_LAS bf16x8*)(lds + PG8_SB(b, h) + boff + n * 2048 + k * 1024); } while (0)
#define PG8_MMA(ai, bj, At, Bt) do { __builtin_amdgcn_s_setprio(1); _Pragma("unroll") for (int m = 0; m < 4; ++m) _Pragma("unroll") for (int n = 0; n < 2; ++n) _Pragma("unroll") for (int k = 0; k < 2; ++k) \
        acc[ai][bj][m][n] = __builtin_amdgcn_mfma_f32_16x16x32_bf16(Bt[n][k], At[m][k], acc[ai][bj][m][n], 0, 0, 0); __builtin_amdgcn_s_setprio(0); } while (0)
#define PG8_WAIT_V(n) asm volatile("s_waitcnt vmcnt(" #n ")" ::: "memory")
#define PG8_WAIT_L(n) asm volatile("s_waitcnt lgkmcnt(" #n ")" ::: "memory")
#define PG8_BAR __builtin_amdgcn_s_barrier()
#define PG8_SCHED __builtin_amdgcn_sched_barrier(0)
    Unit cur, nxt; int ui = 0;
    if (!S.next(0, cur)) return;
    f32x4 acc[2][2][4][2];
#pragma unroll
    for (int a = 0; a < 2; ++a)
#pragma unroll
        for (int b = 0; b < 2; ++b)
#pragma unroll
            for (int m = 0; m < 4; ++m)
#pragma unroll
                for (int n = 0; n < 2; ++n) acc[a][b][m][n] = (f32x4){0.f, 0.f, 0.f, 0.f};
    bf16x8 At[4][2], B0[2][2], B1[2][2];
    const char* cA = (const char*)g.A + (size_t)cur.pm * tstepA + S.a_off(cur); const char* cB = (const char*)g.Bt + (size_t)cur.pn * tstep;
    S.a_ready(cur);
    PG8_STAGE(PG8_SB(0, 0), cB, voffB); PG8_STAGE(PG8_SA(0, 0), cA, voffA); PG8_STAGE(PG8_SB(0, 1), cB + hstep, voffB); PG8_STAGE(PG8_SA(0, 1), cA + hstepA, voffA);
    if (wr == 1) PG8_BAR;
    PG8_WAIT_V(4); PG8_BAR;
    PG8_STAGE(PG8_SB(1, 0), cB + kstep, voffB); PG8_STAGE(PG8_SA(1, 0), cA + kstep, voffA); PG8_STAGE(PG8_SB(1, 1), cB + hstep + kstep, voffB);
    PG8_WAIT_V(6); PG8_BAR;
    PG8_STAMP();
    for (;;) {
        const bool has_next = S.next(ui + 1, nxt);
        const char* nA = has_next ? (const char*)g.A + (size_t)nxt.pm * tstepA + S.a_off(nxt) : cA; const char* nB = has_next ? (const char*)g.Bt + (size_t)nxt.pn * tstep : cB;
        for (int t = 0; t < nt; t += 2) {
            const bool last = (t == nt - 2);
            const char* a1 = cA + (size_t)(t + 1) * kstep;
            const char* a2 = last ? nA : cA + (size_t)(t + 2) * kstep; const char* b2 = last ? nB : cB + (size_t)(t + 2) * kstep;
            const char* a3 = a2 + kstep; const char* b3 = b2 + kstep;
            if (last && has_next) S.a_ready(nxt);
            PG8_LDB(B0, 0, 0); PG8_SCHED; PG8_LDA(At, 0, 0); PG8_STAGE(PG8_SA(1, 1), a1 + hstepA, voffA);
            PG8_WAIT_L(8); PG8_BAR; PG8_WAIT_L(0); PG8_MMA(0, 0, At, B0); PG8_BAR; PG8_SCHED;
            PG8_LDB(B1, 0, 1); PG8_STAGE(PG8_SB(0, 0), b2, voffB);
            PG8_BAR; PG8_WAIT_L(0); PG8_MMA(0, 1, At, B1); PG8_BAR;
            PG8_LDA(At, 0, 1); PG8_STAGE(PG8_SA(0, 0), a2, voffA);
            PG8_BAR; PG8_WAIT_L(0); PG8_MMA(1, 0, At, B0); PG8_BAR; PG8_SCHED;
            PG8_STAGE(PG8_SB(0, 1), b2 + hstep, voffB);
            PG8_WAIT_V(6); PG8_BAR; PG8_MMA(1, 1, At, B1); PG8_BAR;
            PG8_LDB(B0, 1, 0); PG8_SCHED; PG8_LDA(At, 1, 0); PG8_STAGE(PG8_SA(0, 1), a2 + hstepA, voffA);
            PG8_WAIT_L(8); PG8_BAR; PG8_WAIT_L(0); PG8_MMA(0, 0, At, B0); PG8_BAR; PG8_SCHED;
            PG8_LDB(B1, 1, 1); PG8_STAGE(PG8_SB(1, 0), b3, voffB);
            PG8_BAR; PG8_WAIT_L(0); PG8_MMA(0, 1, At, B1); PG8_BAR;
            PG8_LDA(At, 1, 1); PG8_STAGE(PG8_SA(1, 0), a3, voffA);
            PG8_BAR; PG8_WAIT_L(0); PG8_MMA(1, 0, At, B0); PG8_BAR; PG8_SCHED;
            PG8_STAGE(PG8_SB(1, 1), b3 + hstep, voffB);
            PG8_WAIT_V(6); PG8_BAR; PG8_MMA(1, 1, At, B1); PG8_BAR;
        }
        PG8_STAMP();
        if constexpr (!Epi::AFTER_DRAIN) { E(acc, cur, wr, wc, fr, fq); S.done(cur); }
        PG8_STAMP();
        if (!has_next) break;
#pragma unroll
        for (int a = 0; a < 2; ++a)
#pragma unroll
            for (int b = 0; b < 2; ++b)
#pragma unroll
                for (int m = 0; m < 4; ++m)
#pragma unroll
                    for (int n = 0; n < 2; ++n) acc[a][b][m][n] = (f32x4){0.f, 0.f, 0.f, 0.f};
        cur = nxt; cA = nA; cB = nB; ++ui;
    }
    PG8_WAIT_V(0);
    if (wr == 0) PG8_BAR;
    PG8_BAR;
    if constexpr (Epi::AFTER_DRAIN) { E.fused(acc, cur, wr, wc, fr, fq, lds, wid, lane); S.done(cur); }
    PG8_STAMP();
    if (STAMP && wid == 0) { stamps[lane] = lane < nts ? (((unsigned long long)(unsigned)ts_hi << 32) | (unsigned)ts_lo) : 0ull;
        if (lane == 62) stamps[62] = rt_entry; if (lane == 63) stamps[63] = (unsigned long long)wall_clock64(); }
#undef PG8_STAMP
#undef PG8_SA
#undef PG8_SB
#undef PG8_STAGE
#undef PG8_LDA
#undef PG8_LDB
#undef PG8_MMA
#undef PG8_WAIT_V
#undef PG8_WAIT_L
#undef PG8_BAR
#undef PG8_SCHED
}
}

struct EpiStoreBf16 {
  static constexpr bool PERM = true, AFTER_DRAIN = false;
  bf16_t* O; int ldc;
  DI void operator()(const pg8::f32x4 (&acc)[2][2][4][2], const pg8::Unit& u, int wr, int wc, int fr, int fq) const {
    const int row0 = u.pm * 256 + wr * 64 + fr, col0 = u.pn * 256 + wc * 32 + 8 * fq;
#pragma unroll
    for (int ai = 0; ai < 2; ++ai)
#pragma unroll
      for (int m = 0; m < 4; ++m) {
        bf16_t* rowp = O + (size_t)(row0 + ai * 128 + m * 16) * ldc + col0;
#pragma unroll
        for (int bj = 0; bj < 2; ++bj) {
          const pg8::f32x4 v0 = acc[ai][bj][m][0], v1 = acc[ai][bj][m][1];
          uint4 o; o.x = pack2(v0[0], v0[1]); o.y = pack2(v0[2], v0[3]); o.z = pack2(v1[0], v1[1]); o.w = pack2(v1[2], v1[3]);
          *(uint4*)(rowp + bj * 128) = o;
        }
      }
  }
};
struct EpiGate {
  static constexpr bool PERM = true, AFTER_DRAIN = false;
  bf16_t* O; int ldc; const float* bias;
  DI void operator()(const pg8::f32x4 (&acc)[2][2][4][2], const pg8::Unit& u, int wr, int wc, int fr, int fq) const {
    const int row0 = u.pm * 256 + wr * 64 + fr, col0 = u.pn * 256 + wc * 32 + 8 * fq;
#pragma unroll
    for (int bj = 0; bj < 2; ++bj) {
      const float4 b0 = *(const float4*)(bias + col0 + bj * 128), b1 = *(const float4*)(bias + col0 + bj * 128 + 4);
#pragma unroll
      for (int ai = 0; ai < 2; ++ai)
#pragma unroll
        for (int m = 0; m < 4; ++m) {
          bf16_t* rowp = O + (size_t)(row0 + ai * 128 + m * 16) * ldc + col0 + bj * 128;
          const pg8::f32x4 v0 = acc[ai][bj][m][0], v1 = acc[ai][bj][m][1];
          uint4 o;
          o.x = pack2(fast_sigmoid(v0[0] + b0.x), fast_sigmoid(v0[1] + b0.y));
          o.y = pack2(fast_sigmoid(v0[2] + b0.z), fast_sigmoid(v0[3] + b0.w));
          o.z = pack2(fast_sigmoid(v1[0] + b1.x), fast_sigmoid(v1[1] + b1.y));
          o.w = pack2(fast_sigmoid(v1[2] + b1.z), fast_sigmoid(v1[3] + b1.w));
          *(uint4*)rowp = o;
        }
    }
  }
};
template <int FIRST>
struct EpiZ {
  static constexpr bool PERM = true, AFTER_DRAIN = false;
  bf16_t* ACC; const bf16_t* SG;
  DI void operator()(const pg8::f32x4 (&acc)[2][2][4][2], const pg8::Unit& u, int wr, int wc, int fr, int fq) const {
    const int row0 = u.pm * 256 + wr * 64 + fr, col0 = u.pn * 256 + wc * 32 + 8 * fq;
#pragma unroll
    for (int ai = 0; ai < 2; ++ai)
#pragma unroll
      for (int m = 0; m < 4; ++m) {
        const size_t row = (size_t)(row0 + ai * 128 + m * 16);
#pragma unroll
        for (int bj = 0; bj < 2; ++bj) {
          const int col = col0 + bj * 128;
          float g[8], a[8];
          unpack8(*(const uint4*)(SG + row * 4096 + col), g);
          const pg8::f32x4 v0 = acc[ai][bj][m][0], v1 = acc[ai][bj][m][1];
          const float z[8] = {v0[0], v0[1], v0[2], v0[3], v1[0], v1[1], v1[2], v1[3]};
          if (FIRST) {
#pragma unroll
            for (int e = 0; e < 8; ++e) a[e] = g[e] * z[e];
          } else {
            {
              const unsigned long long* ap = (const unsigned long long*)(ACC + row * 1024 + col);
              const unsigned long long q0 = __hip_atomic_load(ap, __ATOMIC_RELAXED, __HIP_MEMORY_SCOPE_AGENT);
              const unsigned long long q1 = __hip_atomic_load(ap + 1, __ATOMIC_RELAXED, __HIP_MEMORY_SCOPE_AGENT);
              uint4 av; av.x = (unsigned)q0; av.y = (unsigned)(q0 >> 32); av.z = (unsigned)q1; av.w = (unsigned)(q1 >> 32);
              unpack8(av, a);
            }
#pragma unroll
            for (int e = 0; e < 8; ++e) a[e] += g[e] * z[e];
          }
          *(uint4*)(ACC + row * 1024 + col) = pack8(a);
        }
      }
  }
};
struct EpiOut {
  static constexpr bool PERM = false, AFTER_DRAIN = false;
  const float* src; float* dst; const float* gt;
  DI void operator()(const pg8::f32x4 (&acc)[2][2][4][2], const pg8::Unit& u, int wr, int wc, int fr, int fq) const {
    const int row0 = u.pm * 256 + wr * 64 + fr, col0 = u.pn * 256 + wc * 32 + 4 * fq;
#pragma unroll
    for (int bj = 0; bj < 2; ++bj)
#pragma unroll
      for (int n = 0; n < 2; ++n) {
        const int col = col0 + bj * 128 + n * 16;
        const float4 gv = *(const float4*)(gt + col);
#pragma unroll
        for (int ai = 0; ai < 2; ++ai)
#pragma unroll
          for (int m = 0; m < 4; ++m) {
            const size_t idx = (size_t)(row0 + ai * 128 + m * 16) * 1024 + col;
            const float4 sv = *(const float4*)(src + idx);
            const pg8::f32x4 v = acc[ai][bj][m][n];
            float4 o; o.x = sv.x + gv.x * v[0]; o.y = sv.y + gv.y * v[1]; o.z = sv.z + gv.z * v[2]; o.w = sv.w + gv.w * v[3];
            *(float4*)(dst + idx) = o;
          }
      }
  }
};
template <class Epi>
DI void run_gemm(char* smem, const bf16_t* A, int lda, const bf16_t* Bt, int M, int N, int K, const Epi& E) {
  pg8::Gemm g; g.A = A; g.Bt = Bt; g.M = M; g.N = N; g.K = K; g.lda = lda;
  pg8::StaticOrder S; S.init(M, N, (int)gridDim.x, get_bid());
  __syncthreads();
  pg8::gemm_phase<Epi, pg8::StaticOrder, false>((PG8_LAS unsigned char*)smem, g, S, E, nullptr);
  __syncthreads();
}

DI void transpose_job(const float* __restrict__ src, int K, int N, bf16_t* __restrict__ dst, int Npad, char* smem) {
  float* tS = (float*)smem;
  const int tid = get_tid();
  const int ntk = K >> 6, ntn = Npad >> 6;
  for (int tile = get_bid(); tile < ntk * ntn; tile += gridDim.x) {
    const int kt = tile % ntk, nt = tile / ntk;
    __syncthreads();
    {
      const int kk = tid >> 3, c8 = (tid & 7) * 8;
      const int col = nt * 64 + c8;
      float v[8];
      if (col < N) {
        const float4 a = *(const float4*)(src + (size_t)(kt * 64 + kk) * N + col);
        const float4 b = *(const float4*)(src + (size_t)(kt * 64 + kk) * N + col + 4);
        v[0] = a.x; v[1] = a.y; v[2] = a.z; v[3] = a.w; v[4] = b.x; v[5] = b.y; v[6] = b.z; v[7] = b.w;
      } else {
#pragma unroll
        for (int e = 0; e < 8; ++e) v[e] = 0.f;
      }
#pragma unroll
      for (int e = 0; e < 8; ++e) tS[kk * 65 + c8 + e] = v[e];
    }
    __syncthreads();
    {
      const int n = tid >> 3, k8 = (tid & 7) * 8;
      float v[8];
#pragma unroll
      for (int e = 0; e < 8; ++e) v[e] = tS[(k8 + e) * 65 + n];
      *(uint4*)(dst + (size_t)(nt * 64 + n) * K + kt * 64 + k8) = pack8(v);
    }
  }
}

DI void phase_prep(const Params& p, char* smem) {
  const int tid = get_tid();
  char* ws = p.ws;
  if (get_bid() == 0 && tid < 64) ((int*)(ws + OFF_CTR))[tid] = 0;
  for (int l = 0; l < 2; ++l) {
    transpose_job(p.in[I_WIN] + (size_t)l * 1024 * NIN, 1024, NIN, (bf16_t*)(ws + OFF_WINT) + (size_t)l * NPAD * 1024, NPAD, smem);
    for (int i = 0; i < 4; ++i) {
      transpose_job(p.in[I_MGW] + (size_t)(l * 4 + i) * 1024 * 1024, 1024, 1024, (bf16_t*)(ws + OFF_MGT) + (size_t)(l * 4 + i) * 1024 * 1024, 1024, smem);
      transpose_job(p.in[I_WBR] + (size_t)(l * 4 + i) * 512 * 1024, 512, 1024, (bf16_t*)(ws + OFF_BRT) + (size_t)(l * 4 + i) * 1024 * 512, 1024, smem);
    }
    transpose_job(p.in[I_WOUT] + (size_t)l * 1024 * 1024, 1024, 1024, (bf16_t*)(ws + OFF_OUTT) + (size_t)l * 1024 * 1024, 1024, smem);
    transpose_job(p.in[I_MLAWUQ] + (size_t)l * 256 * 768, 256, 768, (bf16_t*)(ws + OFF_WUQT) + (size_t)l * 768 * 256, 768, smem);
    transpose_job(p.in[I_MLAWUKV] + (size_t)l * 256 * 1024, 256, 1024, (bf16_t*)(ws + OFF_WUKVT) + (size_t)l * 1024 * 256, 1024, smem);
  }
  {
    float* sv = (float*)smem;
    float* red = sv + 3 * 1024;
    float* modv = (float*)(ws + OFF_MODV);
    for (int job = get_bid(); job < 96; job += gridDim.x) {
      const int l = job / 48, cg0 = (job % 48) * 64;
      __syncthreads();
      for (int i = tid; i < 3072; i += 512) {
        const int rr = i >> 10, k = i & 1023;
        const float cv = (rr < 2) ? p.in[I_C][rr * 1024 + k] : p.in[I_CCTX][k];
        sv[i] = siluf_(cv);
      }
      __syncthreads();
      const int cl = tid & 63, ks = tid >> 6;
      float a0 = 0.f, a1 = 0.f, a2 = 0.f;
      const float* mw = p.in[I_MODW] + (size_t)l * 1024 * 3072 + cg0 + cl;
      for (int k = ks * 128; k < ks * 128 + 128; ++k) {
        const float wv = mw[(size_t)k * 3072];
        a0 += sv[k] * wv; a1 += sv[1024 + k] * wv; a2 += sv[2048 + k] * wv;
      }
      red[(ks * 3 + 0) * 64 + cl] = a0; red[(ks * 3 + 1) * 64 + cl] = a1; red[(ks * 3 + 2) * 64 + cl] = a2;
      __syncthreads();
      if (tid < 192) {
        const int rr = tid >> 6, c = tid & 63;
        float s = 0.f;
        for (int q = 0; q < 8; ++q) s += red[(q * 3 + rr) * 64 + c];
        modv[(l * 3 + rr) * 3072 + cg0 + c] = s + p.in[I_MODB][l * 3072 + cg0 + c];
      }
    }
  }
  {
    float* cosH = (float*)(ws + OFF_ROPE);
    float* sinH = cosH + SEQ * 32;
    float* cosM = sinH + SEQ * 32;
    float* sinM = cosM + SEQ * 16;
    for (int idx = get_bid() * 512 + tid; idx < SEQ * 48; idx += gridDim.x * 512) {
      if (idx < SEQ * 32) {
        const int t = idx >> 5, i = idx & 31, f = i & 15;
        const float pos = (i < 16) ? (float)(t >> 6) : (float)(t & 63);
        const float inv = exp2f(-(float)f * (13.287712379549449f / 16.f));
        const float ang = pos * inv;
        cosH[idx] = cosf(ang); sinH[idx] = sinf(ang);
      } else {
        const int j = idx - SEQ * 32;
        const int t = j >> 4, i = j & 15, f = i & 7;
        const float pos = (i < 8) ? (float)(t >> 6) : (float)(t & 63);
        const float inv = exp2f(-(float)f * (13.287712379549449f / 8.f));
        const float ang = pos * inv;
        cosM[j] = cosf(ang); sinM[j] = sinf(ang);
      }
    }
  }
}

DI void phase_h(const Params& p, int l, int b) {
  const int tid = get_tid(), lane = tid & 63, w = tid >> 6;
  const float* xin = (l == 0) ? p.in[I_X] : p.out;
  const float* cin = (l == 0) ? p.in[I_CTX] : (const float*)(p.ws + OFF_CX1);
  const float* ng = p.in[I_NORMG] + l * 1024;
  const float* modv = (const float*)(p.ws + OFF_MODV);
  bf16_t* H = (bf16_t*)(p.ws + OFF_H);
  for (int row = get_bid() * 8 + w; row < TR; row += gridDim.x * 8) {
    const float* src; const float* mv;
    if (row < 256) { src = cin + ((size_t)b * 256 + row) * 1024; mv = modv + (l * 3 + 2) * 3072; }
    else { src = xin + ((size_t)b * SEQ + (row - 256)) * 1024; mv = modv + (l * 3 + b) * 3072; }
    float4 v[4];
    float ss = 0.f;
#pragma unroll
    for (int i = 0; i < 4; ++i) {
      v[i] = *(const float4*)(src + i * 256 + lane * 4);
      ss += v[i].x * v[i].x + v[i].y * v[i].y + v[i].z * v[i].z + v[i].w * v[i].w;
    }
    ss = red64(ss);
    const float rs = rsqrtf(ss * (1.f / 1024.f) + 1e-6f);
#pragma unroll
    for (int i = 0; i < 4; ++i) {
      const int c = i * 256 + lane * 4;
      const float4 g = *(const float4*)(ng + c);
      const float4 sh = *(const float4*)(mv + c);
      const float4 sc = *(const float4*)(mv + 1024 + c);
      float o[4];
      o[0] = v[i].x * rs * g.x * (1.f + sc.x) + sh.x;
      o[1] = v[i].y * rs * g.y * (1.f + sc.y) + sh.y;
      o[2] = v[i].z * rs * g.z * (1.f + sc.z) + sh.z;
      o[3] = v[i].w * rs * g.w * (1.f + sc.w) + sh.w;
      *(uint2*)(H + (size_t)row * 1024 + c) = pack4(o);
    }
  }
}

DI void phase_g1(const Params& p, int l, char* smem) {
  EpiStoreBf16 E; E.O = (bf16_t*)(p.ws + OFF_P); E.ldc = LDP;
  run_gemm(smem, (const bf16_t*)(p.ws + OFF_H), 1024, (const bf16_t*)(p.ws + OFF_WINT) + (size_t)l * NPAD * 1024, TR, NPAD, 1024, E);
}

DI int swap23(int p) { return (p & 3) | ((p & 4) << 1) | ((p & 8) >> 1); }
DI void vt_tile(const bf16_t* __restrict__ src, int ld, bf16_t* __restrict__ dst, int tok0, char* smem) {
  bf16_t* tS = (bf16_t*)smem;
  const int tid = get_tid();
  __syncthreads();
  {
    const int tok = tid >> 3, c8 = (tid & 7) * 8;
    *(uint4*)(tS + tok * 72 + c8) = *(const uint4*)(src + (size_t)(tok0 + tok) * ld + c8);
  }
  __syncthreads();
  {
    const int dv = tid >> 3, pc = tid & 7;
    unsigned short v[8];
#pragma unroll
    for (int j = 0; j < 8; ++j) {
      const int pos = 8 * pc + j;
      const int tokoff = (pos & ~15) | swap23(pos & 15);
      v[j] = tS[tokoff * 72 + dv];
    }
    uint4 o;
    o.x = v[0] | ((unsigned)v[1] << 16); o.y = v[2] | ((unsigned)v[3] << 16);
    o.z = v[4] | ((unsigned)v[5] << 16); o.w = v[6] | ((unsigned)v[7] << 16);
    *(uint4*)(dst + (size_t)dv * TR + tok0 + 8 * pc) = o;
  }
}

DI void phase_post(const Params& p, int l, char* smem) {
  const int tid = get_tid(), lane = tid & 63, w = tid >> 6;
  bf16_t* P = (bf16_t*)(p.ws + OFF_P);
  const float* cosH = (const float*)(p.ws + OFF_ROPE);
  const float* sinH = cosH + SEQ * 32;
  const int m = lane & 7;
  for (int row = get_bid() * 8 + w; row < TR; row += gridDim.x * 8) {
    bf16_t* Pr = P + (size_t)row * LDP;
    float x[8];
    const uint4 vaq = *(const uint4*)(Pr + A_Q + lane * 8);
    const uint4 vak = *(const uint4*)(Pr + A_K + lane * 8);
    const uint4 vdq = *(const uint4*)(Pr + D_Q + lane * 8);
    const uint4 vdk = *(const uint4*)(Pr + D_K + (lane & 15) * 8);
    const uint4 vcc = *(const uint4*)(Pr + C_CQ + 256 * (lane >> 5) + (lane & 31) * 8);
    float cs8[8], sn8[8];
    {
      const int t = (row >= 256) ? (row - 256) : 0;
      const float4 c0 = *(const float4*)(cosH + t * 32 + 8 * (m & 3)), c1 = *(const float4*)(cosH + t * 32 + 8 * (m & 3) + 4);
      const float4 s0 = *(const float4*)(sinH + t * 32 + 8 * (m & 3)), s1 = *(const float4*)(sinH + t * 32 + 8 * (m & 3) + 4);
      cs8[0] = c0.x; cs8[1] = c0.y; cs8[2] = c0.z; cs8[3] = c0.w; cs8[4] = c1.x; cs8[5] = c1.y; cs8[6] = c1.z; cs8[7] = c1.w;
      sn8[0] = s0.x; sn8[1] = s0.y; sn8[2] = s0.z; sn8[3] = s0.w; sn8[4] = s1.x; sn8[5] = s1.y; sn8[6] = s1.z; sn8[7] = s1.w;
    }
    {
      unpack8(vaq, x);
      float ss = 0.f;
#pragma unroll
      for (int e = 0; e < 8; ++e) ss += x[e] * x[e];
      ss = red8(ss);
      const float rs = rsqrtf(ss * (1.f / 64.f) + 1e-6f) * SC64;
#pragma unroll
      for (int e = 0; e < 8; ++e) x[e] = x[e] * rs * p.in[I_NAQG][l * 64 + m * 8 + e];
      *(uint4*)(Pr + A_Q + lane * 8) = pack8(x);
    }
    {
      unpack8(vak, x);
      float ss = 0.f;
#pragma unroll
      for (int e = 0; e < 8; ++e) ss += x[e] * x[e];
      ss = red8(ss);
      const float rs = rsqrtf(ss * (1.f / 64.f) + 1e-6f);
#pragma unroll
      for (int e = 0; e < 8; ++e) x[e] = x[e] * rs * p.in[I_NAKG][l * 64 + m * 8 + e];
      *(uint4*)(Pr + A_K + lane * 8) = pack8(x);
    }
#pragma unroll
    for (int which = 0; which < 2; ++which) {
      const int lc = which ? (lane & 15) : lane;
      bf16_t* ptr = Pr + (which ? D_K : D_Q) + lc * 8;
      const float* gg = (which ? p.in[I_GQAKG] : p.in[I_GQAQG]) + l * 64 + m * 8;
      unpack8(which ? vdk : vdq, x);
      float ss = 0.f;
#pragma unroll
      for (int e = 0; e < 8; ++e) ss += x[e] * x[e];
      ss = red8(ss);
      const float rs = rsqrtf(ss * (1.f / 64.f) + 1e-6f);
#pragma unroll
      for (int e = 0; e < 8; ++e) x[e] = x[e] * rs * gg[e];
      if (row >= 256) {
        const float sgn = (m < 4) ? -1.f : 1.f;
#pragma unroll
        for (int e = 0; e < 8; ++e) {
          const float pr = __shfl_xor(x[e], 4);
          x[e] = x[e] * cs8[e] + sgn * pr * sn8[e];
        }
      }
      if (!which) {
#pragma unroll
        for (int e = 0; e < 8; ++e) x[e] *= SC64;
      }
      if (!which || lane < 16) *(uint4*)ptr = pack8(x);
    }
    {
      const int hh = lane >> 5, li = lane & 31;
      bf16_t* ptr = Pr + C_CQ + 256 * hh + li * 8;
      const float* gg = (hh ? p.in[I_MLAKVAG] : p.in[I_MLAQAG]) + l * 256 + li * 8;
      unpack8(vcc, x);
      float ss = 0.f;
#pragma unroll
      for (int e = 0; e < 8; ++e) ss += x[e] * x[e];
      ss = red32(ss);
      const float rs = rsqrtf(ss * (1.f / 256.f) + 1e-6f);
#pragma unroll
      for (int e = 0; e < 8; ++e) x[e] = x[e] * rs * gg[e];
      *(uint4*)ptr = pack8(x);
    }
  }
  {
    bf16_t* XWA = (bf16_t*)(p.ws + OFF_XWA);
    const float* mu = p.in[I_RWMU] + l * 1792;
    const int dd = lane >> 5, which = (lane >> 4) & 1, c4 = (lane & 15) * 4;
    const int col = B_U + 1536 + 128 * which + 64 * dd + c4;
    for (int row = get_bid() * 8 + w; row < TR; row += gridDim.x * 8) {
      const int segb = (row < 256) ? 0 : 256, sege = (row < 256) ? 256 : TR;
      const bf16_t* pc = P + (size_t)row * LDP + col;
      float u0[4], um[4], up[4], o[4];
      unpack4(*(const uint2*)pc, u0);
      if (row > segb) unpack4(*(const uint2*)(pc - LDP), um); else { um[0] = um[1] = um[2] = um[3] = 0.f; }
      if (row < sege - 1) unpack4(*(const uint2*)(pc + LDP), up); else { up[0] = up[1] = up[2] = up[3] = 0.f; }
      const float4 m4 = *(const float4*)(mu + (col - B_U));
      const float mm[4] = {m4.x, m4.y, m4.z, m4.w};
#pragma unroll
      for (int e = 0; e < 4; ++e) {
        const float v = u0[e] + mm[e] * (0.5f * (um[e] + up[e]) - u0[e]);
        o[e] = which ? v : fast_tanh(v);
      }
      *(uint2*)(XWA + ((size_t)dd * TR + row) * 128 + 64 * which + c4) = pack4(o);
    }
  }
  for (int tile = get_bid(); tile < 260 * 10; tile += gridDim.x) {
    const int tt = tile % 260, hd = tile / 260;
    if (hd < 8) vt_tile(P + A_V + hd * 64, LDP, (bf16_t*)(p.ws + OFF_VTA) + (size_t)hd * 64 * TR, tt * 64, smem);
    else vt_tile(P + D_V + (hd - 8) * 64, LDP, (bf16_t*)(p.ws + OFF_VTD) + (size_t)(hd - 8) * 64 * TR, tt * 64, smem);
  }
}

DI void phase_mlaproj(const Params& p, int l, char* smem) {
  const bf16_t* P = (const bf16_t*)(p.ws + OFF_P);
  EpiStoreBf16 E;
  E.O = (bf16_t*)(p.ws + OFF_QM); E.ldc = 768;
  run_gemm(smem, P + C_CQ, LDP, (const bf16_t*)(p.ws + OFF_WUQT) + (size_t)l * 768 * 256, TR, 768, 256, E);
  E.O = (bf16_t*)(p.ws + OFF_KVRAW); E.ldc = 1024;
  run_gemm(smem, P + C_CKV, LDP, (const bf16_t*)(p.ws + OFF_WUKVT) + (size_t)l * 1024 * 256, TR, 1024, 256, E);
}

DI void phase_mlapost(const Params& p, int l, char* smem) {
  const int tid = get_tid(), lane = tid & 63, w = tid >> 6;
  const bf16_t* P = (const bf16_t*)(p.ws + OFF_P);
  bf16_t* Qm = (bf16_t*)(p.ws + OFF_QM);
  const bf16_t* KV = (const bf16_t*)(p.ws + OFF_KVRAW);
  bf16_t* Km = (bf16_t*)(p.ws + OFF_KM);
  const float* cosM = (const float*)(p.ws + OFF_ROPE) + SEQ * 64;
  const float* sinM = cosM + SEQ * 16;
  const int hh = lane >> 3, m = lane & 7;
  for (int row = get_bid() * 8 + w; row < TR; row += gridDim.x * 8) {
    const uint4 vnq = *(const uint4*)(Qm + (size_t)row * 768 + hh * 96 + 8 * m);
    const uint2 vtq = *(const uint2*)(Qm + (size_t)row * 768 + hh * 96 + 64 + 4 * m);
    const uint4 vnk = *(const uint4*)(KV + (size_t)row * 1024 + hh * 128 + 8 * m);
    const uint2 vtk = *(const uint2*)(P + (size_t)row * LDP + C_KR + 4 * m);
    float4 c4, s4;
    {
      const int t = (row >= 256) ? (row - 256) : 0;
      c4 = *(const float4*)(cosM + t * 16 + 4 * (m & 3));
      s4 = *(const float4*)(sinM + t * 16 + 4 * (m & 3));
    }
    const float cc[4] = {c4.x, c4.y, c4.z, c4.w}, sn[4] = {s4.x, s4.y, s4.z, s4.w};
#pragma unroll
    for (int which = 0; which < 2; ++which) {
      float x[12];
      const float* gg = (which ? p.in[I_MLAKG] : p.in[I_MLAQG]) + l * 96;
      unpack8(which ? vnk : vnq, x); unpack4(which ? vtk : vtq, x + 8);
      float ss = 0.f;
#pragma unroll
      for (int e = 0; e < 12; ++e) ss += x[e] * x[e];
      ss = red8(ss);
      const float rs = rsqrtf(ss * (1.f / 96.f) + 1e-6f);
#pragma unroll
      for (int e = 0; e < 8; ++e) x[e] = x[e] * rs * gg[8 * m + e];
#pragma unroll
      for (int e = 0; e < 4; ++e) x[8 + e] = x[8 + e] * rs * gg[64 + 4 * m + e];
      if (row >= 256) {
        const float sgn = (m < 4) ? -1.f : 1.f;
#pragma unroll
        for (int e = 0; e < 4; ++e) {
          const float pr = __shfl_xor(x[8 + e], 4);
          x[8 + e] = x[8 + e] * cc[e] + sgn * pr * sn[e];
        }
      }
      if (!which) {
#pragma unroll
        for (int e = 0; e < 12; ++e) x[e] *= SC96;
      }
      bf16_t* dn = which ? (Km + (size_t)row * 768 + hh * 96 + 8 * m) : (Qm + (size_t)row * 768 + hh * 96 + 8 * m);
      bf16_t* dt = which ? (Km + (size_t)row * 768 + hh * 96 + 64 + 4 * m) : (Qm + (size_t)row * 768 + hh * 96 + 64 + 4 * m);
      *(uint4*)dn = pack8(x);
      *(uint2*)dt = pack4(x + 8);
    }
  }
  for (int tile = get_bid(); tile < 260 * 8; tile += gridDim.x) {
    const int tt = tile % 260, hd = tile / 260;
    vt_tile(KV + hd * 128 + 64, 1024, (bf16_t*)(p.ws + OFF_VTM) + (size_t)hd * 64 * TR, tt * 64, smem);
  }
}

template <int DK, int SUB, bool HALF = false>
DI void attn_item(const bf16_t* __restrict__ Qp, int ldq, const bf16_t* __restrict__ Kp, int ldk,
                  const bf16_t* __restrict__ Vt, bf16_t* __restrict__ Gp, int ldg, int q0,
                  int r0a, int n0, int r1a, int n1, int na_mode, const float* __restrict__ rpb, char* smem) {
  constexpr int KS = DK / 16, LK = DK + 8, CPR = DK / 8;
  constexpr int KR = SUB * 64;
  constexpr int LV = KR + 8;
  constexpr int NKC = KR * CPR / 512;
  constexpr int NKR = (KR * CPR) % 512;
  const int tid = get_tid(), lane = tid & 63, w = tid >> 6, r = lane & 31, h = lane >> 5;
  const int grp = w >> 2;
  bf16_t* Ks = (bf16_t*)smem;
  bf16_t* Vs = Ks + 2 * KR * LK;
  float* rpbS = (float*)(Vs + 3 * 64 * LV);
  __syncthreads();
  if (na_mode) for (int i = tid; i < 466; i += 512) rpbS[i] = (i < 465) ? rpb[i] * LOG2E : -1e30f;
  const int qrow = q0 + 32 * (HALF ? (w & 3) : w) + r;
  bf16x8 qf[KS];
#pragma unroll
  for (int ks = 0; ks < KS; ++ks) qf[ks] = *(const bf16x8*)(Qp + (size_t)qrow * ldq + ks * 16 + h * 8);
  f32x16 o[2]; o[0] = zero16(); o[1] = zero16();
  f32x16 s[2]; s[0] = zero16(); s[1] = zero16();
  float mrun = 0.f;
  bool first = true;
  f32x16 negm = zero16();
  float lsa = 0.f, lsb = 0.f;
  const int nsteps = n0 + n1;
  const int nsup = nsteps / SUB;
  const int tq = qrow - 256;
  const int qr = tq >> 6, qc = tq & 63;
  const int rs = min(max(qr - 4, 0), 248), cs = min(max(qc - 8, 0), 48);
  constexpr int NK = NKC + (NKR ? 1 : 0);
  uint4 k0 = make_uint4(0, 0, 0, 0), k1 = k0, k2 = k0, v0 = k0, v1 = k0;
  auto kaddr = [&](int rowstart, int i) { const int c = tid + 512 * i; return Kp + (size_t)(rowstart + c / CPR) * ldk + (c % CPR) * 8; };
  auto vaddr = [&](int rowstart, int i) { const int c = tid + 512 * i; return Vt + (size_t)(c / (8 * SUB)) * TR + rowstart + (c % (8 * SUB)) * 8; };
  auto klds = [&](int kb, int i) { const int c = tid + 512 * i; return Ks + (kb * KR + c / CPR) * LK + (c % CPR) * 8; };
  auto vlds = [&](int vb, int i) { const int c = tid + 512 * i; return Vs + (vb * 64 + c / (8 * SUB)) * LV + (c % (8 * SUB)) * 8; };
  auto gload = [&](int T) {
    const int t64 = T * SUB;
    const int rowstart = (t64 < n0) ? (r0a + 64 * t64) : (r1a + 64 * (t64 - n0));
    k0 = *(const uint4*)kaddr(rowstart, 0);
    if (NK >= 2) { if (NKC >= 2 || tid < NKR) k1 = *(const uint4*)kaddr(rowstart, 1); }
    if (NK >= 3) { if (NKC >= 3 || tid < NKR) k2 = *(const uint4*)kaddr(rowstart, 2); }
    v0 = *(const uint4*)vaddr(rowstart, 0);
    if (SUB >= 2) v1 = *(const uint4*)vaddr(rowstart, 1);
  };
  auto sstore = [&](int kb, int vb) {
    *(uint4*)klds(kb, 0) = k0;
    if (NK >= 2) { if (NKC >= 2 || tid < NKR) *(uint4*)klds(kb, 1) = k1; }
    if (NK >= 3) { if (NKC >= 3 || tid < NKR) *(uint4*)klds(kb, 2) = k2; }
    *(uint4*)vlds(vb, 0) = v0;
    if (SUB >= 2) *(uint4*)vlds(vb, 1) = v1;
  };
  auto do_qk = [&](int u, int kb) {
    const int sub = u % SUB;
#pragma unroll
    for (int kt2 = 0; kt2 < 2; ++kt2) {
      const bf16_t* kbp = Ks + (kb * KR + 64 * sub + 32 * kt2 + r) * LK + h * 8;
#pragma unroll
      for (int ks = 0; ks < KS; ++ks) {
        bf16x8 a = *(const bf16x8*)(kbp + ks * 16);
        s[kt2] = (ks == 0) ? MFMA32(a, qf[ks], negm) : MFMA32(a, qf[ks], s[kt2]);
      }
    }
    if (na_mode && u >= n0) {
      const int kr = ((r1a - 256) >> 6) + (u - n0);
      const bool rowok = (kr >= rs) && (kr <= rs + 7);
      const int rbase = rowok ? ((kr - qr + 7) * 31 - qc + 15) : -100000;
      const int clo = cs, chi = cs + 15;
#pragma unroll
      for (int kt2 = 0; kt2 < 2; ++kt2)
#pragma unroll
        for (int e = 0; e < 16; ++e) {
          const int kc = 32 * kt2 + crow(e, h);
          const bool ok = (rbase >= -1000) && (kc >= clo) && (kc <= chi);
          const int idx = ok ? (rbase + kc) : 465;
          s[kt2][e] += rpbS[idx];
        }
    }
  };
  auto do_sm_pv = [&](int u, int vb) {
    const int sub = u % SUB;
    float mx = __builtin_elementwise_maximum(s[0][0], s[1][0]);
#pragma unroll
    for (int e = 1; e < 16; ++e) mx = __builtin_elementwise_maximum(__builtin_elementwise_maximum(mx, s[0][e]), s[1][e]);
    mx = __builtin_elementwise_maximum(mx, __shfl_xor(mx, 32));
    if (first || __builtin_amdgcn_ballot_w64(mx > 8.f) != 0ull) {
      const float mnew = first ? (mrun + mx) : fmaxf(mrun, mrun + mx);
      const float dlt = mrun - mnew;
      const float alpha = first ? 1.f : __builtin_amdgcn_exp2f(dlt);
      mrun = mnew;
      lsa *= alpha; lsb *= alpha;
#pragma unroll
      for (int e = 0; e < 16; ++e) {
        o[0][e] *= alpha; o[1][e] *= alpha;
        s[0][e] += dlt; s[1][e] += dlt;
        negm[e] = -mnew;
      }
      first = false;
    }
#pragma unroll
    for (int kt2 = 0; kt2 < 2; ++kt2)
#pragma unroll
      for (int sx = 0; sx < 2; ++sx) {
        unsigned pk[4];
#pragma unroll
        for (int jj = 0; jj < 4; ++jj) {
          const float p0 = __builtin_amdgcn_exp2f(s[kt2][8 * sx + 2 * jj]);
          const float p1 = __builtin_amdgcn_exp2f(s[kt2][8 * sx + 2 * jj + 1]);
          lsa += p0; lsb += p1;
          pk[jj] = pack2(p0, p1);
        }
        uint4 pk4; pk4.x = pk[0]; pk4.y = pk[1]; pk4.z = pk[2]; pk4.w = pk[3];
        const bf16x8 pf = __builtin_bit_cast(bf16x8, pk4);
#pragma unroll
        for (int d2 = 0; d2 < 2; ++d2) {
          bf16x8 a = *(const bf16x8*)(Vs + (vb * 64 + 32 * d2 + r) * LV + 64 * sub + 32 * kt2 + 16 * sx + 8 * h);
          o[d2] = MFMA32(a, pf, o[d2]);
        }
      }
  };
  gload(0); sstore(0, 0);
  __syncthreads();
  int vcur = 0;
  for (int T = 0; T < nsup; ++T) {
    const int vprev = (vcur == 0) ? 2 : (vcur - 1);
    const int vnext = (vcur == 2) ? 0 : (vcur + 1);
    if (T + 1 < nsup) gload(T + 1);
    if (HALF) {
      const int u = T * SUB + grp;
      do_qk(u, T & 1); do_sm_pv(u, vcur);
    } else {
#pragma unroll
      for (int sub = 0; sub < SUB; ++sub) {
        const int u = T * SUB + sub;
        if (grp == 0) { do_qk(u, T & 1); do_sm_pv(u, vcur); }
        else { if (u > 0) do_sm_pv(u - 1, (sub == 0) ? vprev : vcur); do_qk(u, T & 1); }
      }
    }
    if (T + 1 < nsup) sstore((T + 1) & 1, vnext);
    __syncthreads();
    vcur = vnext;
  }
  if (!HALF) {
    if (grp == 1) {
      const int vlast = (vcur == 0) ? 2 : (vcur - 1);
      do_sm_pv(nsteps - 1, vlast);
    }
  }
  float lsum = lsa + lsb;
  if (HALF) {
    float* xch = (float*)smem + ((w & 3) * 64 + lane) * 36;
    if (grp == 1) {
#pragma unroll
      for (int d2 = 0; d2 < 2; ++d2)
#pragma unroll
        for (int q4 = 0; q4 < 4; ++q4)
          *(float4*)(xch + d2 * 16 + q4 * 4) = make_float4(o[d2][4 * q4], o[d2][4 * q4 + 1], o[d2][4 * q4 + 2], o[d2][4 * q4 + 3]);
      xch[32] = mrun; xch[33] = lsum;
    }
    __syncthreads();
    if (grp == 0) {
      const float m1 = xch[32], l1 = xch[33];
      const float mm = fmaxf(mrun, m1);
      const float a0 = __builtin_amdgcn_exp2f(mrun - mm), a1 = __builtin_amdgcn_exp2f(m1 - mm);
      lsum = lsum * a0 + l1 * a1;
#pragma unroll
      for (int d2 = 0; d2 < 2; ++d2)
#pragma unroll
        for (int q4 = 0; q4 < 4; ++q4) {
          const float4 ov = *(const float4*)(xch + d2 * 16 + q4 * 4);
          o[d2][4 * q4] = o[d2][4 * q4] * a0 + ov.x * a1;
          o[d2][4 * q4 + 1] = o[d2][4 * q4 + 1] * a0 + ov.y * a1;
          o[d2][4 * q4 + 2] = o[d2][4 * q4 + 2] * a0 + ov.z * a1;
          o[d2][4 * q4 + 3] = o[d2][4 * q4 + 3] * a0 + ov.w * a1;
        }
    }
  }
  const float lt = lsum + __shfl_xor(lsum, 32);
  const float inv = 1.f / lt;
  if (!HALF || grp == 0)
#pragma unroll
  for (int d2 = 0; d2 < 2; ++d2)
#pragma unroll
    for (int gq = 0; gq < 4; ++gq) {
      const int dv0 = 32 * d2 + 8 * gq + 4 * h;
      bf16_t* ptr = Gp + (size_t)qrow * ldg + dv0;
      uint2 gv = *(const uint2*)ptr;
      float g[4]; unpack4(gv, g);
      float y[4];
#pragma unroll
      for (int e = 0; e < 4; ++e) y[e] = o[d2][4 * gq + e] * inv * siluf_(g[e]);
      *(uint2*)ptr = pack4(y);
    }
}

DI float dpp_x1(float v) { return __builtin_bit_cast(float, __builtin_amdgcn_update_dpp(0, __builtin_bit_cast(int, v), 0xB1, 0xF, 0xF, true)); }
DI float dpp_x2(float v) { return __builtin_bit_cast(float, __builtin_amdgcn_update_dpp(0, __builtin_bit_cast(int, v), 0x4E, 0xF, 0xF, true)); }
DI float dpp_hm(float v) { return __builtin_bit_cast(float, __builtin_amdgcn_update_dpp(0, __builtin_bit_cast(int, v), 0x141, 0xF, 0xF, true)); }
DI float dpp_rm(float v) { return __builtin_bit_cast(float, __builtin_amdgcn_update_dpp(0, __builtin_bit_cast(int, v), 0x140, 0xF, 0xF, true)); }
DI float dpp_red8(float v) { v += dpp_x1(v); v += dpp_x2(v); v += dpp_hm(v); return v; }
DI float dpp_red16(float v) { v += dpp_x1(v); v += dpp_x2(v); v += dpp_hm(v); v += dpp_rm(v); return v; }

struct ScanVec { float4 w, k, b, n, r; float v; };
DI void scan_load(ScanVec& sv, const float* cb, const float* vb) {
  sv.w = *(const float4*)(cb);
  sv.k = *(const float4*)(cb + 2048);
  sv.b = *(const float4*)(cb + 2 * 2048);
  sv.n = *(const float4*)(cb + 3 * 2048);
  sv.r = *(const float4*)(cb + 4 * 2048);
  sv.v = *vb;
}

DI void scan_item(const Params& p, int l, int hd, int d, int rp, char* smem) {
  const int tid = get_tid(), lane = tid & 63, w = tid >> 6;
  float* CH = (float*)smem;
  float* YC = CH + 2 * 6 * 2048;
  bf16_t* W2T = (bf16_t*)(YC + 4096);
  bf16_t* XW = W2T + 2 * 64 * 72;
  float* LO = (float*)(XW + 4 * 2 * 8 * 72);
  const bf16_t* P = (const bf16_t*)(p.ws + OFF_P);
  bf16_t* Yd = (bf16_t*)(p.ws + (d ? OFF_Y1 : OFF_Y0));
  float* Cb = (float*)(p.ws + OFF_CB) + (size_t)d * TR * 8;
  __syncthreads();
  {
    const float* w2 = p.in[I_RWW2] + (size_t)(l * 2 + d) * 64 * 512 + hd * 64;
    const float* a2 = p.in[I_RWA2] + (size_t)(l * 2 + d) * 64 * 512 + hd * 64;
    for (int i = tid; i < 4096; i += 512) {
      const int j = i >> 6, c = i & 63;
      W2T[c * 72 + j] = f2bf(w2[(size_t)j * 512 + c]);
      W2T[64 * 72 + c * 72 + j] = f2bf(a2[(size_t)j * 512 + c]);
    }
  }
  __syncthreads();
  const int NCH = 520;
  const float* mu = p.in[I_RWMU] + l * 1792;
#ifdef PROBE_SCAN2
  for (int rep = 0; rep < 2; ++rep) {
#endif
  v2f S01 = {0.f, 0.f}, S23 = {0.f, 0.f};
  for (int ci = 0; ci <= NCH + 1; ++ci) {
    if (w >= 4) {
      const int pw = w - 4;
      if (ci < NCH) {
        const int buf = ci & 1;
        int segbase, seglen, cs;
        if (ci < 8) { segbase = 0; seglen = 256; cs = d ? (7 - ci) : ci; }
        else { segbase = 256; seglen = SEQ; cs = d ? (511 - (ci - 8)) : (ci - 8); }
        const int tl = lane >> 3, m = lane & 7;
        const int tc = 8 * pw + tl;
        const int t = 32 * cs + tc;
        const size_t row = (size_t)(segbase + t);
        const bool hm = t > 0, hp = t < seglen - 1;
        float xr[8], xk[8], xv[8];
        const int cols[3] = {B_U + hd * 64 + 8 * m, B_U + 512 + hd * 64 + 8 * m, B_U + 1024 + hd * 64 + 8 * m};
        uint4 r0[3], rm[3], rq[3];
#pragma unroll
        for (int vv = 0; vv < 3; ++vv) {
          const bf16_t* pc = P + row * LDP + cols[vv];
          r0[vv] = *(const uint4*)pc;
          rm[vv] = hm ? *(const uint4*)(pc - LDP) : make_uint4(0, 0, 0, 0);
          rq[vv] = hp ? *(const uint4*)(pc + LDP) : make_uint4(0, 0, 0, 0);
        }
        const bf16_t* xsrc = (const bf16_t*)(p.ws + OFF_XWA) + ((size_t)d * TR + row) * 128 + 8 * m;
        const uint4 xw16 = *(const uint4*)xsrc, xa16 = *(const uint4*)(xsrc + 64);
#pragma unroll
        for (int vv = 0; vv < 3; ++vv) {
          float* dst = (vv == 0) ? xr : (vv == 1) ? xk : xv;
          float u0[8], um[8], up[8];
          unpack8(r0[vv], u0); unpack8(rm[vv], um); unpack8(rq[vv], up);
          const float* mp = mu + (cols[vv] - B_U);
          const float4 m0 = *(const float4*)mp, m1 = *(const float4*)(mp + 4);
          const float mm[8] = {m0.x, m0.y, m0.z, m0.w, m1.x, m1.y, m1.z, m1.w};
#pragma unroll
          for (int e = 0; e < 8; ++e) dst[e] = u0[e] + mm[e] * (0.5f * (um[e] + up[e]) - u0[e]);
        }
        const int c0 = hd * 64 + 8 * m;
        float kk[8];
        {
          const float4 q0 = *(const float4*)(p.in[I_RWKK] + l * 512 + c0), q1 = *(const float4*)(p.in[I_RWKK] + l * 512 + c0 + 4);
          const float qq[8] = {q0.x, q0.y, q0.z, q0.w, q1.x, q1.y, q1.z, q1.w};
          float ss = 0.f;
#pragma unroll
          for (int e = 0; e < 8; ++e) { kk[e] = xk[e] * qq[e]; ss += kk[e] * kk[e]; }
          ss = dpp_red8(ss);
          const float rn = rsqrtf(ss + 1e-12f);
#pragma unroll
          for (int e = 0; e < 8; ++e) kk[e] *= rn;
        }
        bf16_t* xwp = XW + pw * (2 * 8 * 72);
        *(uint4*)(xwp + tl * 72 + 8 * m) = xw16;
        *(uint4*)(xwp + 8 * 72 + tl * 72 + 8 * m) = xa16;
        __builtin_amdgcn_fence(__ATOMIC_RELEASE, "wavefront");
        __builtin_amdgcn_wave_barrier();
        __builtin_amdgcn_fence(__ATOMIC_ACQUIRE, "wavefront");
        {
          const int r = lane & 31, h = lane >> 5;
          float* lop = LO + pw * (2 * 8 * 64);
#pragma unroll
          for (int mat = 0; mat < 2; ++mat) {
            f32x16 acc[2]; acc[0] = zero16(); acc[1] = zero16();
#pragma unroll
            for (int ks = 0; ks < 4; ++ks) {
              bf16x8 a;
              if (r < 8) a = *(const bf16x8*)(xwp + mat * 8 * 72 + r * 72 + ks * 16 + h * 8);
              else {
#pragma unroll
                for (int e = 0; e < 8; ++e) a[e] = 0;
              }
#pragma unroll
              for (int nt = 0; nt < 2; ++nt) {
                bf16x8 bb = *(const bf16x8*)(W2T + mat * 64 * 72 + (32 * nt + r) * 72 + ks * 16 + h * 8);
                acc[nt] = MFMA32(a, bb, acc[nt]);
              }
            }
#pragma unroll
            for (int nt = 0; nt < 2; ++nt)
#pragma unroll
              for (int e = 0; e < 4; ++e) lop[mat * 8 * 64 + (4 * h + e) * 64 + 32 * nt + r] = acc[nt][e];
          }
        }
        __builtin_amdgcn_fence(__ATOMIC_RELEASE, "wavefront");
        __builtin_amdgcn_wave_barrier();
        __builtin_amdgcn_fence(__ATOMIC_ACQUIRE, "wavefront");
        {
          const float* lop = LO + pw * (2 * 8 * 64);
          float* chb = CH + buf * (6 * 2048) + tc * 64 + 8 * m;
          const float4 lw0 = *(const float4*)(lop + tl * 64 + 8 * m), lw1 = *(const float4*)(lop + tl * 64 + 8 * m + 4);
          const float4 la0 = *(const float4*)(lop + 512 + tl * 64 + 8 * m), la1 = *(const float4*)(lop + 512 + tl * 64 + 8 * m + 4);
          const float lw[8] = {lw0.x, lw0.y, lw0.z, lw0.w, lw1.x, lw1.y, lw1.z, lw1.w};
          const float la[8] = {la0.x, la0.y, la0.z, la0.w, la1.x, la1.y, la1.z, la1.w};
          const float* pw0 = p.in[I_RWW0] + (l * 2 + d) * 512 + c0;
          const float* pa0 = p.in[I_RWA0] + (l * 2 + d) * 512 + c0;
          const float* pka = p.in[I_RWKA] + l * 512 + c0;
          const float* prk = p.in[I_RWRK] + l * 512 + c0;
          float bon = 0.f;
          float ow[8], okd[8], obd[8], onk[8];
#pragma unroll
          for (int e = 0; e < 8; ++e) {
            const float xwl = pw0[e] + lw[e];
            const float xal = pa0[e] + la[e];
            const float dec = __expf(-0.6065306597126334f * fast_sigmoid(xwl));
            const float a = fast_sigmoid(xal);
            const float kd = xk[e] * (1.f + (a - 1.f) * pka[e]);
            ow[e] = dec; okd[e] = kd; obd[e] = kk[e] * a; onk[e] = -kk[e];
            bon += xr[e] * kd * prk[e];
          }
          bon = dpp_red8(bon);
          if (m == 0 && rp == 0) Cb[row * 8 + hd] = bon;
          *(float4*)(chb + 0 * 2048) = make_float4(ow[0], ow[1], ow[2], ow[3]);
          *(float4*)(chb + 0 * 2048 + 4) = make_float4(ow[4], ow[5], ow[6], ow[7]);
          *(float4*)(chb + 1 * 2048) = make_float4(okd[0], okd[1], okd[2], okd[3]);
          *(float4*)(chb + 1 * 2048 + 4) = make_float4(okd[4], okd[5], okd[6], okd[7]);
          *(float4*)(chb + 2 * 2048) = make_float4(obd[0], obd[1], obd[2], obd[3]);
          *(float4*)(chb + 2 * 2048 + 4) = make_float4(obd[4], obd[5], obd[6], obd[7]);
          *(float4*)(chb + 3 * 2048) = make_float4(onk[0], onk[1], onk[2], onk[3]);
          *(float4*)(chb + 3 * 2048 + 4) = make_float4(onk[4], onk[5], onk[6], onk[7]);
          *(float4*)(chb + 4 * 2048) = make_float4(xr[0], xr[1], xr[2], xr[3]);
          *(float4*)(chb + 4 * 2048 + 4) = make_float4(xr[4], xr[5], xr[6], xr[7]);
          *(float4*)(chb + 5 * 2048) = make_float4(xv[0], xv[1], xv[2], xv[3]);
          *(float4*)(chb + 5 * 2048 + 4) = make_float4(xv[4], xv[5], xv[6], xv[7]);
        }
      }
      if (ci >= 2) {
        const int cj = ci - 2;
        int segbase, cs;
        if (cj < 8) { segbase = 0; cs = d ? (7 - cj) : cj; }
        else { segbase = 256; cs = d ? (511 - (cj - 8)) : (cj - 8); }
        const int ptid = tid - 256;
        const int tf = ptid >> 3, i2 = (ptid & 7) * 2;
        const float* yc = YC + (cj & 1) * 2048 + tf * 64 + i2 * 4;
        const float4 ya = *(const float4*)yc, yb = *(const float4*)(yc + 4);
        const size_t row = (size_t)(segbase + 32 * cs + tf);
        *(unsigned*)(Yd + row * 512 + hd * 64 + 16 * rp + i2) = pack2((ya.x + ya.y) + (ya.z + ya.w), (yb.x + yb.y) + (yb.z + yb.w));
      }
    } else {
      if (ci >= 1 && ci <= NCH) {
        __builtin_amdgcn_s_setprio(3);
        const int cj = ci - 1;
        const int il = tid >> 4, js = tid & 15;
        const float* chb = CH + (cj & 1) * (6 * 2048) + 4 * js;
        const float* vb = CH + (cj & 1) * (6 * 2048) + 5 * 2048 + 16 * rp + il;
        float* yc = YC + (cj & 1) * 2048 + il * 4 + (js >> 2);
        const int tstep = d ? -64 : 64;
        const int t0 = d ? 31 * 64 : 0;
        ScanVec cur, nxt;
        scan_load(cur, chb + t0, vb + t0);
        int toff = t0;
#pragma unroll 8
        for (int sidx = 0; sidx < 32; ++sidx) {
          const int tn = (sidx < 31) ? (toff + tstep) : toff;
          scan_load(nxt, chb + tn, vb + tn);
          const v2f n01 = {cur.n.x, cur.n.y}, n23 = {cur.n.z, cur.n.w};
          v2f pa = S01 * n01;
          pa = S23 * n23 + pa;
          float sa = dpp_red16(pa.x + pa.y);
          const v2f k01 = {cur.k.x, cur.k.y}, k23 = {cur.k.z, cur.k.w};
          const v2f b01 = {cur.b.x, cur.b.y}, b23 = {cur.b.z, cur.b.w};
          const v2f w01 = {cur.w.x, cur.w.y}, w23 = {cur.w.z, cur.w.w};
          const v2f vv2 = {cur.v, cur.v}, sa2 = {sa, sa};
          v2f t01 = vv2 * k01, t23 = vv2 * k23;
          t01 = sa2 * b01 + t01; t23 = sa2 * b23 + t23;
          S01 = S01 * w01 + t01; S23 = S23 * w23 + t23;
          const v2f r01 = {cur.r.x, cur.r.y}, r23 = {cur.r.z, cur.r.w};
          v2f qa = S01 * r01;
          qa = S23 * r23 + qa;
          float y = qa.x + qa.y;
          y += dpp_x1(y); y += dpp_x2(y);
          if ((js & 3) == 0) yc[(toff >> 6) * 64] = y;
          cur = nxt;
          toff = tn;
        }
        __builtin_amdgcn_s_setprio(0);
      }
    }
    __syncthreads();
  }
#ifdef PROBE_SCAN2
  }
#endif
}

DI void phase_mix(const Params& p, int l, int lb, char* smem, int* s_item) {
  const int tid = get_tid();
  int* ctr = (int*)(p.ws + OFF_CTR) + lb;
  const bf16_t* P = (const bf16_t*)(p.ws + OFF_P);
  bf16_t* Pw = (bf16_t*)(p.ws + OFF_P);
  const int nctx = (l == 0) ? 24 : 0;
  constexpr int NSPLIT = 128;
  constexpr int E_MLA = 64 + 512, E_GQF = E_MLA + (512 - NSPLIT), E_GQH = E_GQF + 2 * NSPLIT, E_NA = E_GQH + 512;
  const int total = E_NA + nctx;
  while (true) {
    __syncthreads();
    if (tid == 0) *s_item = atomicAdd(ctr, 1);
    __syncthreads();
    const int item = *s_item;
    if (item >= total) break;
    if (item < 64) {
      scan_item(p, l, item >> 3, (item >> 2) & 1, item & 3, smem);
    } else {
      int ty, hd, q0, n0 = 4, r1a = 0, n1 = 0, na = 0, half = 0;
      if (item < E_MLA) { const int it = item - 64; ty = 0; hd = it >> 6; q0 = 256 + 256 * (it & 63); n0 = 260; }
      else if (item < E_GQF) { const int it = item - E_MLA; ty = 1; hd = it >> 6; q0 = 256 + 256 * (it & 63); n0 = 260; }
      else if (item < E_GQH) { const int it = item - E_GQF + 2 * (512 - NSPLIT); ty = 1; hd = it >> 7; q0 = 256 + 128 * (it & 127); n0 = 260; half = 1; }
      else if (item < E_NA) {
        const int it = item - E_GQH; ty = 2; hd = it >> 6; const int qt = it & 63; q0 = 256 + 256 * qt;
        const int rsmin = min(max(4 * qt - 4, 0), 248);
        const int rsend = min(max(4 * qt + 3 - 4, 0), 248) + 7;
        r1a = 256 + 64 * rsmin; n1 = rsend - rsmin + 1; na = 1;
      } else { const int it = item - E_NA; ty = it >> 3; hd = it & 7; q0 = 0; }
      if (ty == 0) {
        attn_item<96, 2>((const bf16_t*)(p.ws + OFF_QM) + hd * 96, 768, (const bf16_t*)(p.ws + OFF_KM) + hd * 96, 768,
                         (const bf16_t*)(p.ws + OFF_VTM) + (size_t)hd * 64 * TR, Pw + C_G + hd * 64, LDP, q0,
                         0, n0, 0, 0, 0, nullptr, smem);
      } else {
        const bf16_t* Qp = (ty == 1) ? (P + D_Q + hd * 64) : (P + A_Q + hd * 64);
        const bf16_t* Kp = (ty == 1) ? (P + D_K + (hd >> 2) * 64) : (P + A_K + hd * 64);
        const bf16_t* Vt = (ty == 1) ? ((const bf16_t*)(p.ws + OFF_VTD) + (size_t)(hd >> 2) * 64 * TR)
                                     : ((const bf16_t*)(p.ws + OFF_VTA) + (size_t)hd * 64 * TR);
        bf16_t* Gp = (ty == 1) ? (Pw + D_G + hd * 64) : (Pw + A_G + hd * 64);
        if (na)
          attn_item<64, 1>(Qp, LDP, Kp, LDP, Vt, Gp, LDP, q0, 0, n0, r1a, n1, 1, p.in[I_NARPB] + (size_t)(l * 8 + hd) * 465, smem);
        else if (half)
          attn_item<64, 2, true>(Qp, LDP, Kp, LDP, Vt, Gp, LDP, q0, 0, n0, 0, 0, 0, nullptr, smem);
        else
          attn_item<64, 2>(Qp, LDP, Kp, LDP, Vt, Gp, LDP, q0, 0, n0, 0, 0, 0, nullptr, smem);
      }
    }
  }
}

DI void phase_fin(const Params& p, int l) {
  const int tid = get_tid(), lane = tid & 63, w = tid >> 6;
  bf16_t* P = (bf16_t*)(p.ws + OFF_P);
  const bf16_t* Y0 = (const bf16_t*)(p.ws + OFF_Y0);
  const bf16_t* Y1 = (const bf16_t*)(p.ws + OFF_Y1);
  const float* Cb = (const float*)(p.ws + OFF_CB);
  const float* mu = p.in[I_RWMU] + l * 1792 + 1024;
  const int hh = lane >> 3, c = lane * 8;
  for (int row = get_bid() * 8 + w; row < TR; row += gridDim.x * 8) {
    float a[8], b2[8], ys[8];
    unpack8(*(const uint4*)(Y0 + (size_t)row * 512 + c), a);
    unpack8(*(const uint4*)(Y1 + (size_t)row * 512 + c), b2);
    float sm = 0.f;
#pragma unroll
    for (int e = 0; e < 8; ++e) { ys[e] = a[e] + b2[e]; sm += ys[e]; }
    const float mean = red8(sm) * (1.f / 64.f);
    float vs = 0.f;
#pragma unroll
    for (int e = 0; e < 8; ++e) { const float dd = ys[e] - mean; vs += dd * dd; }
    const float var = red8(vs) * (1.f / 64.f);
    const float rstd = rsqrtf(var + 64e-5f);
    const int segb = (row < 256) ? 0 : 256, sege = (row < 256) ? 256 : TR;
    bf16_t* Pr = P + (size_t)row * LDP;
    float u0[8], um[8], up[8];
    unpack8(*(const uint4*)(Pr + B_U + 1024 + c), u0);
    if (row > segb) unpack8(*(const uint4*)(Pr - LDP + B_U + 1024 + c), um); else {
#pragma unroll
      for (int e = 0; e < 8; ++e) um[e] = 0.f;
    }
    if (row < sege - 1) unpack8(*(const uint4*)(Pr + LDP + B_U + 1024 + c), up); else {
#pragma unroll
      for (int e = 0; e < 8; ++e) up[e] = 0.f;
    }
    const float bon = Cb[(size_t)row * 8 + hh] + Cb[(size_t)TR * 8 + (size_t)row * 8 + hh];
    float g[8], o[8];
    unpack8(*(const uint4*)(Pr + B_G + c), g);
#pragma unroll
    for (int e = 0; e < 8; ++e) {
      const float v = u0[e] + mu[c + e] * (0.5f * (um[e] + up[e]) - u0[e]);
      const float yn = (ys[e] - mean) * rstd * p.in[I_RWGNW][l * 512 + c + e] + p.in[I_RWGNB][l * 512 + c + e];
      o[e] = (yn + bon * v) * siluf_(g[e]);
    }
    *(uint4*)(Pr + B_G + c) = pack8(o);
  }
}

DI void phase_gate(const Params& p, int l, char* smem) {
  const bf16_t* H = (const bf16_t*)(p.ws + OFF_H);
  const bf16_t* W = (const bf16_t*)(p.ws + OFF_MGT) + (size_t)l * 4096 * 1024;
  bf16_t* SG = (bf16_t*)(p.ws + OFF_SG);
#ifdef PROBE_GATE
  { EpiStoreBf16 E0; E0.O = SG + (size_t)256 * 4096; E0.ldc = 4096; run_gemm(smem, H + (size_t)256 * 1024, 1024, W, SEQ, 4096, 1024, E0); }
#endif
  float* sb = (float*)(smem + 131072);
  __syncthreads();
  for (int i = get_tid(); i < 4096; i += 512) sb[i] = p.in[I_MGB][l * 4096 + i];
  __syncthreads();
  EpiGate E; E.ldc = 4096; E.bias = sb;
  E.O = SG + (size_t)256 * 4096;
  run_gemm(smem, H + (size_t)256 * 1024, 1024, W, SEQ, 4096, 1024, E);
  if (l == 0) { E.O = SG; run_gemm(smem, H, 1024, W, 256, 4096, 1024, E); }
}

struct ZOrder {
  int ntile, G, c;
  DI bool next(int i, pg8::Unit& u) const {
    int tile;
    if (((ntile | G) & 7) == 0) {
      const int per = ntile >> 3, local = (c >> 3) + (i >> 2) * (G >> 3);
      if (local >= per) return false;
      tile = (c & 7) * per + local;
    } else {
      tile = c + (i >> 2) * G;
      if (tile >= ntile) return false;
    }
    u.pm = tile >> 2; u.pn = ((i & 3) << 2) | (tile & 3); return true;
  }
  DI size_t a_off(const pg8::Unit& u) const {
    const int i = u.pn >> 2;
    const int ycol = (i == 0) ? A_G : (i == 1) ? B_G : (i == 2) ? C_G : D_G;
    return (size_t)ycol * 2;
  }
  DI void a_ready(const pg8::Unit&) const {}
  DI void done(const pg8::Unit&) const {}
};
DI unsigned z_touch(const bf16_t* Abase, const bf16_t* SG, int pm, int ct, int br, int tid) {
  const int ycol = (br == 0) ? A_G : (br == 1) ? B_G : (br == 2) ? C_G : D_G;
  const unsigned a = *(const unsigned*)(Abase + (size_t)(pm * 256 + 64 * ct + (tid >> 3)) * LDP + ycol + (tid & 7) * 64);
  const bf16_t* sgp = SG + (size_t)(pm * 256) * 4096 + br * 1024 + ct * 256;
  const unsigned g0 = *(const unsigned*)(sgp + (size_t)(tid >> 2) * 4096 + (tid & 3) * 64);
  const unsigned g1 = *(const unsigned*)(sgp + (size_t)(128 + (tid >> 2)) * 4096 + (tid & 3) * 64);
  return a ^ g0 ^ g1;
}
struct EpiZ2 {
  static constexpr bool PERM = true, AFTER_DRAIN = false;
  bf16_t* ACC; const bf16_t* SG;
  const bf16_t* Abase;
  DI void operator()(const pg8::f32x4 (&acc)[2][2][4][2], const pg8::Unit& u, int wr, int wc, int fr, int fq) const {
    const int br = u.pn >> 2;
    unsigned touched = 0;
    if (br < 3) touched = z_touch(Abase, SG, u.pm, u.pn & 3, br + 1, (wr * 4 + wc) * 64 + fq * 16 + fr);
    const int row0 = u.pm * 256 + wr * 64 + fr, col0 = (u.pn & 3) * 256 + wc * 32 + 8 * fq;
#pragma unroll
    for (int ai = 0; ai < 2; ++ai)
#pragma unroll
      for (int m = 0; m < 4; ++m) {
        const size_t row = (size_t)(row0 + ai * 128 + m * 16);
#pragma unroll
        for (int bj = 0; bj < 2; ++bj) {
          const int col = col0 + bj * 128;
          float g[8], a[8];
          unpack8(*(const uint4*)(SG + row * 4096 + br * 1024 + col), g);
          const pg8::f32x4 v0 = acc[ai][bj][m][0], v1 = acc[ai][bj][m][1];
          const float z[8] = {v0[0], v0[1], v0[2], v0[3], v1[0], v1[1], v1[2], v1[3]};
          if (br == 0) {
#pragma unroll
            for (int e = 0; e < 8; ++e) a[e] = g[e] * z[e];
          } else {
            unpack8(*(const uint4*)(ACC + row * 1024 + col), a);
#pragma unroll
            for (int e = 0; e < 8; ++e) a[e] += g[e] * z[e];
          }
          *(uint4*)(ACC + row * 1024 + col) = pack8(a);
        }
      }
    asm volatile("" :: "v"(touched));
  }
};
struct EpiZdry {
  static constexpr bool PERM = true, AFTER_DRAIN = false;
  bf16_t* ACC;
  DI void operator()(const pg8::f32x4 (&acc)[2][2][4][2], const pg8::Unit& u, int wr, int wc, int fr, int fq) const {
    const int row0 = u.pm * 256 + wr * 64 + fr, col0 = (u.pn & 3) * 256 + wc * 32 + 8 * fq;
#pragma unroll
    for (int ai = 0; ai < 2; ++ai)
#pragma unroll
      for (int m = 0; m < 4; ++m) {
        const size_t row = (size_t)(row0 + ai * 128 + m * 16);
#pragma unroll
        for (int bj = 0; bj < 2; ++bj) {
          const int col = col0 + bj * 128;
          const pg8::f32x4 v0 = acc[ai][bj][m][0], v1 = acc[ai][bj][m][1];
          const float z[8] = {v0[0], v0[1], v0[2], v0[3], v1[0], v1[1], v1[2], v1[3]};
          *(uint4*)(ACC + row * 1024 + col) = pack8(z);
        }
      }
  }
};
DI void z_stream(const Params& p, int l, int row0, int M, char* smem) {
#ifdef PROBE_ZDRY
  {
    EpiZdry E0; E0.ACC = (bf16_t*)(p.ws + OFF_ACC) + (size_t)row0 * 1024;
    pg8::Gemm g0; g0.A = (const bf16_t*)(p.ws + OFF_P) + (size_t)row0 * LDP; g0.Bt = (const bf16_t*)(p.ws + OFF_BRT) + (size_t)l * 4096 * 512;
    g0.M = M; g0.N = 4096; g0.K = 512; g0.lda = LDP;
    ZOrder S0; S0.ntile = (M >> 8) * 4; S0.G = (int)gridDim.x; S0.c = get_bid();
    __syncthreads();
    pg8::gemm_phase<EpiZdry, ZOrder, false>((PG8_LAS unsigned char*)smem, g0, S0, E0, nullptr);
    __syncthreads();
  }
#endif
  EpiZ2 E;
  E.ACC = (bf16_t*)(p.ws + OFF_ACC) + (size_t)row0 * 1024;
  E.SG = (const bf16_t*)(p.ws + OFF_SG) + (size_t)row0 * 4096;
  pg8::Gemm g; g.A = (const bf16_t*)(p.ws + OFF_P) + (size_t)row0 * LDP; g.Bt = (const bf16_t*)(p.ws + OFF_BRT) + (size_t)l * 4096 * 512;
  g.M = M; g.N = 4096; g.K = 512; g.lda = LDP;
  ZOrder S; S.ntile = (M >> 8) * 4; S.G = (int)gridDim.x; S.c = get_bid();
  E.Abase = g.A;
  {
    pg8::Unit u0;
    if (S.next(0, u0)) { const unsigned t0 = z_touch(E.Abase, E.SG, u0.pm, u0.pn & 3, 0, get_tid()); asm volatile("" :: "v"(t0)); }
  }
  __syncthreads();
  pg8::gemm_phase<EpiZ2, ZOrder, false>((PG8_LAS unsigned char*)smem, g, S, E, nullptr);
  __syncthreads();
}
DI void phase_z(const Params& p, int l, char* smem) {
  z_stream(p, l, 256, SEQ, smem);
  if (l == 0) z_stream(p, l, 0, 256, smem);
}

DI void phase_merge2(const Params& p, int l, int b, char* smem) {
  const bf16_t* ACC = (const bf16_t*)(p.ws + OFF_ACC);
  const bf16_t* W = (const bf16_t*)(p.ws + OFF_OUTT) + (size_t)l * 1024 * 1024;
  const float* modv = (const float*)(p.ws + OFF_MODV);
  EpiOut E;
  E.src = ((l == 0) ? p.in[I_X] : p.out) + (size_t)b * SEQ * 1024;
  E.dst = p.out + (size_t)b * SEQ * 1024;
  E.gt = modv + (l * 3 + b) * 3072 + 2048;
  run_gemm(smem, ACC + (size_t)256 * 1024, 1024, W, SEQ, 1024, 1024, E);
  if (l == 0) {
    E.src = p.in[I_CTX] + (size_t)b * 256 * 1024;
    E.dst = (float*)(p.ws + OFF_CX1) + (size_t)b * 256 * 1024;
    E.gt = modv + (l * 3 + 2) * 3072 + 2048;
    run_gemm(smem, ACC, 1024, W, 256, 1024, 1024, E);
  }
}

__global__ void __launch_bounds__(512) mk_forward(Params p, int ph_lo, int ph_hi) {
  __shared__ __attribute__((aligned(16))) char smem[158720];
  __shared__ int s_item;
  cg::grid_group grid = cg::this_grid();
#ifdef TMASK
  unsigned long long t_acc = 0;
#define TIMED(bit, call) do { if ((TMASK >> (bit)) & 1) { const unsigned long long t0_ = wall_clock64(); call; __syncthreads(); t_acc += wall_clock64() - t0_; } else { call; } } while (0)
#else
#define TIMED(bit, call) do { call; } while (0)
#endif
  for (int ph = ph_lo; ph < ph_hi; ++ph) {
    if (ph == 0) {
      if (PH_ON(9)) TIMED(10, phase_prep(p, smem));
    } else if (ph == 1) {
      if (PH_ON(0)) TIMED(0, phase_h(p, 0, 0));
    } else {
      const int q = ph - 2;
      const int lb = q / 8, k = q % 8 + 1;
      const int l = lb >> 1, b = lb & 1;
      if (k == 1) { if (PH_ON(1)) TIMED(1, phase_g1(p, l, smem)); }
      else if (k == 2) { if (PH_ON(2)) TIMED(2, phase_post(p, l, smem)); }
      else if (k == 3) { if (PH_ON(3)) TIMED(3, phase_mlaproj(p, l, smem)); }
      else if (k == 4) { if (PH_ON(4)) TIMED(4, phase_mlapost(p, l, smem)); }
      else if (k == 5) { if (PH_ON(5)) TIMED(5, phase_mix(p, l, lb, smem, &s_item)); }
      else if (k == 6) { if (PH_ON(6)) { TIMED(6, phase_fin(p, l)); TIMED(7, phase_gate(p, l, smem)); } }
      else if (k == 7) { if (PH_ON(7)) TIMED(8, phase_z(p, l, smem)); }
      else {
        if (PH_ON(8)) TIMED(9, phase_merge2(p, l, b, smem));
        if (lb < 3) { const int nl = (lb + 1) >> 1, nb = (lb + 1) & 1; if (PH_ON(0)) TIMED(0, phase_h(p, nl, nb)); }
      }
    }
    if (ph + 1 < ph_hi) grid.sync();
  }
#ifdef TMASK
  { const unsigned long long t0_ = wall_clock64(); while (wall_clock64() - t0_ < t_acc) { __builtin_amdgcn_s_sleep(8); } }
#endif
}

extern "C" void kernel_launch(void* const* d_in, const int* in_sizes, int n_in, void* d_out, int out_size, void* d_ws,
                              size_t ws_size, hipStream_t stream) {
  Params p{};
  for (int i = 0; i < 33; ++i) p.in[i] = (const float*)d_in[i];
  p.out = (float*)d_out;
  p.ws = (char*)d_ws;
  const int NPH = 2 + 4 * 8;
#if MULTI
  for (int ph = 0; ph < NPH; ++ph) {
    hipLaunchKernelGGL(mk_forward, dim3(256), dim3(512), 0, stream, p, ph, ph + 1);
  }
#else
  static int grid_blocks = 0;
  if (!grid_blocks) {
    int dev = 0, cus = 0, per_cu = 0;
    hipGetDevice(&dev);
    hipDeviceGetAttribute(&cus, hipDeviceAttributeMultiprocessorCount, dev);
    hipOccupancyMaxActiveBlocksPerMultiprocessor(&per_cu, mk_forward, 512, 0);
    if (per_cu < 1) per_cu = 1;
    grid_blocks = cus * per_cu;
  }
  int lo = 0, hi = NPH;
  void* args[] = {&p, &lo, &hi};
  hipError_t e = hipLaunchCooperativeKernel((void*)mk_forward, dim3(grid_blocks), dim3(512), args, 0, stream);
  if (e != hipSuccess) fprintf(stderr, "cooperative launch failed: %s (grid %d)\n", hipGetErrorString(e), grid_blocks);
#endif
}
```

```cpp
#include <hip/hip_runtime.h>
#include <hip/hip_cooperative_groups.h>
#include <cstdio>
namespace cg = cooperative_groups;

#ifndef ONLY
#define ONLY (-1)
#endif
#define PH_ON(x) (ONLY < 0 || ONLY == (x))
#ifndef MULTI
#define MULTI 0
#endif

typedef unsigned short bf16_t;
typedef __attribute__((ext_vector_type(8))) short bf16x8;
typedef __attribute__((ext_vector_type(16))) float f32x16;
#define DI __device__ __forceinline__
#define MFMA32(a, b, c) __builtin_amdgcn_mfma_f32_32x32x16_bf16((a), (b), (c), 0, 0, 0)

#define DM 1024
#define SEQ 16384
#define CTXL 256
#define TR 16640
#define LDP 6912
#define NIN 6688
#define NPAD 6912
#define A_Q 0
#define A_K 512
#define A_V 1024
#define A_G 1536
#define B_U 2048
#define B_G 3840
#define C_CQ 4352
#define C_CKV 4608
#define C_KR 4864
#define C_G 4896
#define D_Q 5408
#define D_K 5920
#define D_V 6048
#define D_G 6176
#define LOG2E 1.4426950408889634f
#define SC64 (0.125f * LOG2E)
#define SC96 (0.10206207261596575f * LOG2E)

constexpr size_t SZ_WINT = (size_t)2 * NPAD * 1024 * 2;
constexpr size_t SZ_MGT = (size_t)2 * 4 * 1024 * 1024 * 2;
constexpr size_t SZ_BRT = (size_t)2 * 4 * 1024 * 512 * 2;
constexpr size_t SZ_OUTT = (size_t)2 * 1024 * 1024 * 2;
constexpr size_t SZ_WUQT = (size_t)2 * 768 * 256 * 2;
constexpr size_t SZ_WUKVT = (size_t)2 * 1024 * 256 * 2;
constexpr size_t SZ_MODV = (size_t)2 * 3 * 3072 * 4;
constexpr size_t SZ_ROPE = (size_t)SEQ * 96 * 4;
constexpr size_t SZ_CX1 = (size_t)2 * 256 * 1024 * 4;
constexpr size_t SZ_CTR = 256;
constexpr size_t SZ_H = (size_t)TR * 1024 * 2;
constexpr size_t SZ_P = (size_t)TR * LDP * 2;
constexpr size_t SZ_VTA = (size_t)8 * 64 * TR * 2;
constexpr size_t SZ_VTD = (size_t)2 * 64 * TR * 2;
constexpr size_t SZ_QM = (size_t)TR * 768 * 2;
constexpr size_t SZ_KVRAW = (size_t)TR * 1024 * 2;
constexpr size_t SZ_KM = (size_t)TR * 768 * 2;
constexpr size_t SZ_VTM = (size_t)8 * 64 * TR * 2;
constexpr size_t SZ_Y = (size_t)TR * 512 * 2;
constexpr size_t SZ_CB = (size_t)2 * TR * 8 * 4;

constexpr size_t SZ_SG = (size_t)TR * 4096 * 2;
constexpr size_t OFF_WINT = 0;
constexpr size_t OFF_MGT = OFF_WINT + SZ_WINT;
constexpr size_t OFF_BRT = OFF_MGT + SZ_MGT;
constexpr size_t OFF_OUTT = OFF_BRT + SZ_BRT;
constexpr size_t OFF_WUQT = OFF_OUTT + SZ_OUTT;
constexpr size_t OFF_WUKVT = OFF_WUQT + SZ_WUQT;
constexpr size_t OFF_MODV = OFF_WUKVT + SZ_WUKVT;
constexpr size_t OFF_ROPE = OFF_MODV + SZ_MODV;
constexpr size_t OFF_CX1 = OFF_ROPE + SZ_ROPE;
constexpr size_t OFF_CTR = OFF_CX1 + SZ_CX1;
constexpr size_t OFF_H = OFF_CTR + SZ_CTR;
constexpr size_t OFF_P = OFF_H + SZ_H;
constexpr size_t OFF_Y0 = OFF_P + SZ_P;
constexpr size_t OFF_Y1 = OFF_Y0 + SZ_Y;
constexpr size_t OFF_CB = OFF_Y1 + SZ_Y;
constexpr size_t OFF_VTA = OFF_CB + SZ_CB;
constexpr size_t OFF_VTD = OFF_VTA + SZ_VTA;
constexpr size_t OFF_QM = OFF_VTD + SZ_VTD;
constexpr size_t OFF_KVRAW = OFF_QM + SZ_QM;
constexpr size_t OFF_KM = OFF_KVRAW + SZ_KVRAW;
constexpr size_t OFF_VTM = OFF_KM + SZ_KM;
constexpr size_t OFF_END = OFF_VTM + SZ_VTM;
constexpr size_t OFF_XWA = OFF_END;
constexpr size_t SZ_XWA = (size_t)2 * TR * 128 * 2;
constexpr size_t OFF_SG = OFF_VTA;
constexpr size_t OFF_ACC = OFF_Y0;
static_assert(OFF_SG + SZ_SG <= (size_t)536870912, "workspace overflow");
static_assert(OFF_XWA + SZ_XWA <= (size_t)536870912, "workspace overflow");

struct Params {
  const float* in[33];
  float* out;
  char* ws;
};
enum { I_X = 0, I_C, I_CTX, I_CCTX, I_NORMG, I_MODW, I_MODB, I_WIN, I_NAQG, I_NAKG, I_NARPB, I_RWMU, I_RWW0, I_RWW2,
       I_RWA0, I_RWA2, I_RWKK, I_RWKA, I_RWRK, I_RWGNW, I_RWGNB, I_MLAQAG, I_MLAKVAG, I_MLAWUQ, I_MLAWUKV, I_MLAQG,
       I_MLAKG, I_GQAQG, I_GQAKG, I_MGW, I_MGB, I_WBR, I_WOUT };

DI int get_tid() { int t = threadIdx.x; asm volatile("" : "+v"(t)); return t; }
DI int get_bid() { int b = blockIdx.x; asm volatile("" : "+s"(b)); return b; }
typedef __attribute__((ext_vector_type(2))) float v2f;
typedef __attribute__((ext_vector_type(2))) __bf16 v2bf_t;
DI unsigned pack2(float a, float b) { v2f f = {a, b}; v2bf_t hv = __builtin_convertvector(f, v2bf_t); return __builtin_bit_cast(unsigned, hv); }
DI bf16_t f2bf(float x) { return (bf16_t)(pack2(x, 0.f) & 0xffffu); }
DI float bf2f(bf16_t b) { return __uint_as_float(((unsigned)b) << 16); }
DI float lo2f(unsigned u) { return __uint_as_float(u << 16); }
DI float hi2f(unsigned u) { return __uint_as_float(u & 0xffff0000u); }
DI void unpack8(const uint4& v, float* x) {
  x[0] = lo2f(v.x); x[1] = hi2f(v.x); x[2] = lo2f(v.y); x[3] = hi2f(v.y);
  x[4] = lo2f(v.z); x[5] = hi2f(v.z); x[6] = lo2f(v.w); x[7] = hi2f(v.w);
}
DI uint4 pack8(const float* x) {
  uint4 v; v.x = pack2(x[0], x[1]); v.y = pack2(x[2], x[3]); v.z = pack2(x[4], x[5]); v.w = pack2(x[6], x[7]); return v;
}
DI void unpack4(const uint2& v, float* x) { x[0] = lo2f(v.x); x[1] = hi2f(v.x); x[2] = lo2f(v.y); x[3] = hi2f(v.y); }
DI uint2 pack4(const float* x) { uint2 v; v.x = pack2(x[0], x[1]); v.y = pack2(x[2], x[3]); return v; }
DI float red8(float v) { v += __shfl_xor(v, 1); v += __shfl_xor(v, 2); v += __shfl_xor(v, 4); return v; }
DI float red32(float v) { v = red8(v); v += __shfl_xor(v, 8); v += __shfl_xor(v, 16); return v; }
DI float red64(float v) { v = red32(v); v += __shfl_xor(v, 32); return v; }
DI float sigmoidf_(float x) { return 1.f / (1.f + __expf(-x)); }
DI float siluf_(float x) { return x / (1.f + __expf(-x)); }
DI float fast_tanh(float x) { return 1.f - 2.f * __builtin_amdgcn_rcpf(1.f + __builtin_amdgcn_exp2f(2.8853900817779268f * x)); }
DI float fast_sigmoid(float x) { return __builtin_amdgcn_rcpf(1.f + __builtin_amdgcn_exp2f(-1.4426950408889634f * x)); }
DI int crow(int e, int h) { return (e & 3) + 8 * (e >> 2) + 4 * h; }
DI f32x16 zero16() { f32x16 z; for (int i = 0; i < 16; ++i) z[i] = 0.f; return z; }

template <int NJ>
DI void gemm_core(const bf16_t* __restrict__ A, int lda, const bf16_t* __restrict__ Bt, int ldb, int K,
                  f32x16 (&acc)[2][NJ], char* smem) {
  const int tid = get_tid(), lane = tid & 63, w = tid >> 6, r = lane & 31, h = lane >> 5;
  const int wm = w >> 1, wn = w & 1;
  bf16_t* As = (bf16_t*)smem;
  bf16_t* Bs = As + 2 * 256 * 72;
  uint4 ra[4], rb[NJ];
  const int nk = K >> 6;
  const bf16_t* Ag = A + (size_t)(tid >> 3) * lda + (tid & 7) * 8;
  const bf16_t* Bg = Bt + (size_t)(tid >> 3) * ldb + (tid & 7) * 8;
  bf16_t* Asw = As + (tid >> 3) * 72 + (tid & 7) * 8;
  bf16_t* Bsw = Bs + (tid >> 3) * 72 + (tid & 7) * 8;
  __syncthreads();
#pragma unroll
  for (int i = 0; i < 4; ++i) ra[i] = *(const uint4*)(Ag + (size_t)(64 * i) * lda);
#pragma unroll
  for (int i = 0; i < NJ; ++i) rb[i] = *(const uint4*)(Bg + (size_t)(64 * i) * ldb);
#pragma unroll
  for (int i = 0; i < 4; ++i) *(uint4*)(Asw + 64 * i * 72) = ra[i];
#pragma unroll
  for (int i = 0; i < NJ; ++i) *(uint4*)(Bsw + 64 * i * 72) = rb[i];
  __syncthreads();
  for (int kt = 0; kt < nk; ++kt) {
    const int buf = kt & 1;
    if (kt + 1 < nk) {
      const int ko = (kt + 1) * 64;
#pragma unroll
      for (int i = 0; i < 4; ++i) ra[i] = *(const uint4*)(Ag + (size_t)(64 * i) * lda + ko);
#pragma unroll
      for (int i = 0; i < NJ; ++i) rb[i] = *(const uint4*)(Bg + (size_t)(64 * i) * ldb + ko);
    }
    const bf16_t* Ab = As + (buf * 256 + 64 * wm + r) * 72 + h * 8;
    const bf16_t* Bb = Bs + (buf * 64 * NJ + 32 * NJ * wn + r) * 72 + h * 8;
#pragma unroll
    for (int ks = 0; ks < 4; ++ks) {
      bf16x8 a0 = *(const bf16x8*)(Ab + ks * 16);
      bf16x8 a1 = *(const bf16x8*)(Ab + 32 * 72 + ks * 16);
#pragma unroll
      for (int j = 0; j < NJ; ++j) {
        bf16x8 b0 = *(const bf16x8*)(Bb + j * 32 * 72 + ks * 16);
        acc[0][j] = MFMA32(a0, b0, acc[0][j]);
        acc[1][j] = MFMA32(a1, b0, acc[1][j]);
      }
    }
    if (kt + 1 < nk) {
      const int nb = buf ^ 1;
#pragma unroll
      for (int i = 0; i < 4; ++i) *(uint4*)(Asw + (nb * 256 + 64 * i) * 72) = ra[i];
#pragma unroll
      for (int i = 0; i < NJ; ++i) *(uint4*)(Bsw + (nb * 64 * NJ + 64 * i) * 72) = rb[i];
    }
    __syncthreads();
  }
}

template <int NJ>
DI void store_tile_bf16(const f32x16 (&acc)[2][NJ], bf16_t* dst, int ld, int ncols) {
  const int tid = get_tid(), lane = tid & 63, w = tid >> 6, r = lane & 31, h = lane >> 5;
  const int wm = w >> 1, wn = w & 1;
#pragma unroll
  for (int i = 0; i < 2; ++i)
#pragma unroll
    for (int j = 0; j < NJ; ++j) {
      const int col = 32 * NJ * wn + 32 * j + r;
      if (col < ncols) {
        bf16_t* d0 = dst + (size_t)(64 * wm + 32 * i + 4 * h) * ld + col;
#pragma unroll
        for (int e = 0; e < 16; ++e) d0[(size_t)((e & 3) + 8 * (e >> 2)) * ld] = f2bf(acc[i][j][e]);
      }
    }
}

namespace pg8 {
#define PG8_LAS __attribute__((address_space(3)))
typedef unsigned short bf16_t;
typedef short bf16x8 __attribute__((ext_vector_type(8)));
typedef float f32x4 __attribute__((ext_vector_type(4)));
typedef unsigned u32x4 __attribute__((ext_vector_type(4)));
constexpr int BM = 256, BK = 64, HALF = 128, HTB = HALF * BK * 2  , STAGE_BYTES = 8 * HTB, NXCD = 8, WGM = 8;

__host__ __device__ __forceinline__ int lds_byte(int r, int c) { const int st = (r >> 4) * 2 + (c >> 5), rr = r & 15, cc = c & 31, ob = rr * 64 + cc * 2; return st * 1024 + (ob ^ (((ob >> 9) & 1) << 5)); }
__host__ __device__ __forceinline__ void stage_rc(int b, int& R, int& C) { const int st = b / 1024, sb = b % 1024, swz = sb ^ (((sb >> 9) & 1) << 5); R = (st >> 1) * 16 + swz / 64; C = (st & 1) * 32 + (swz % 64) / 2; }
__host__ __device__ __forceinline__ int perm32(int rho) { const int n = rho >> 4, i = rho & 15; return 8 * (i >> 2) + 4 * n + (i & 3); }

struct Unit { int pm, pn; };
struct Gemm { const bf16_t* A; const bf16_t* Bt; int M, N, K, lda; };

struct StaticOrder {
    int nM, nN, nwg, G, c;
    __host__ __device__ void init(int M, int N, int G_, int c_) { nM = M / BM; nN = N / BM; nwg = nM * nN; G = G_; c = c_; }
    __host__ __device__ bool next(int i, Unit& u) const {
        const long L = (long)i * G + c; if (L >= nwg) return false;
        int wgid = (int)L; { const int q = nwg / NXCD, r = nwg % NXCD, xcd = wgid % NXCD, off = wgid / NXCD; wgid = (xcd < r ? xcd * (q + 1) : r * (q + 1) + (xcd - r) * q) + off; }
        const int nig = WGM * nN, gid = wgid / nig, fm = gid * WGM, gsz = (nM - fm) < WGM ? (nM - fm) : WGM;
        u.pm = fm + ((wgid % nig) % gsz); u.pn = (wgid % nig) / gsz; return true;
    }
    __device__ __forceinline__ void a_ready(const Unit&) const {}
    __device__ __forceinline__ void done(const Unit&) const {}
    __device__ __forceinline__ size_t a_off(const Unit&) const { return 0; }
};
template <class Epi, class Sched, bool STAMP = false>
__device__ __forceinline__ void gemm_phase(PG8_LAS unsigned char* lds, const Gemm g, const Sched& S, const Epi& E, unsigned long long* stamps) {
    const int tid = get_tid(), wid = __builtin_amdgcn_readfirstlane(tid >> 6), lane = tid & 63, wr = wid >> 2, wc = wid & 3, fr = lane & 15, fq = lane >> 4;
    const int K = g.K, nt = K / BK;
    int ts_lo = 0, ts_hi = 0, nts = 0; const unsigned long long rt_entry = STAMP ? (unsigned long long)wall_clock64() : 0ull;
#define PG8_STAMP() do { if (STAMP && wid == 0 && nts < 64) { const unsigned long long _c = (unsigned long long)clock64(); \
        ts_lo = (lane == nts) ? (int)(unsigned)_c : ts_lo; ts_hi = (lane == nts) ? (int)(unsigned)(_c >> 32) : ts_hi; ++nts; } } while (0)
    PG8_STAMP();
    unsigned voffA[2], voffB[2];
#pragma unroll
    for (int i = 0; i < 2; ++i) { int R, C; stage_rc(tid * 16 + i * 8192, R, C); const int Rb = Epi::PERM ? ((R & ~31) + perm32(R & 31)) : R;
        voffA[i] = (unsigned)(R * g.lda + C) * 2u; voffB[i] = (unsigned)(Rb * K + C) * 2u; }
    const size_t kstep = (size_t)(BK * 2);
    const size_t hstep = (size_t)HALF * K * 2; const size_t hstepA = (size_t)HALF * g.lda * 2; const size_t tstepA = 2 * hstepA;
    const size_t tstep = 2 * hstep;
    const unsigned ldsw = (unsigned)wid * 1024u;
    const int aoff = lds_byte(wr * 64 + fr, fq * 8), boff = lds_byte(wc * 32 + fr, fq * 8);
#define PG8_SA(b, h) (((b) * 2 + (h)) * HTB)
#define PG8_SB(b, h) ((4 + (b) * 2 + (h)) * HTB)
#define PG8_STAGE(bufoff, gbase, voff) do { _Pragma("unroll") for (int _i = 0; _i < 2; ++_i) \
        __builtin_amdgcn_global_load_lds((const unsigned*)((const char*)(gbase) + (voff)[_i]), (PG8_LAS unsigned*)(lds + (bufoff) + ldsw + _i * 8192), 16, 0, 0); } while (0)
#define PG8_LDA(dst, b, h) do { _Pragma("unroll") for (int m = 0; m < 4; ++m) _Pragma("unroll") for (int k = 0; k < 2; ++k) dst[m][k] = *(const PG8_LAS bf16x8*)(lds + PG8_SA(b, h) + aoff + m * 2048 + k * 1024); } while (0)
#define PG8_LDB(dst, b, h) do { _Pragma("unroll") for (int n = 0; n < 2; ++n) _Pragma("unroll") for (int k = 0; k < 2; ++k) dst[n][k] = *(const PG8_LAS bf16x8*)(lds + PG8_SB(b, h) + boff + n * 2048 + k * 1024); } while (0)
#define PG8_MMA(ai, bj, At, Bt) do { __builtin_amdgcn_s_setprio(1); _Pragma("unroll") for (int m = 0; m < 4; ++m) _Pragma("unroll") for (int n = 0; n < 2; ++n) _Pragma("unroll") for (int k = 0; k < 2; ++k) \
        acc[ai][bj][m][n] = __builtin_amdgcn_mfma_f32_16x16x32_bf16(Bt[n][k], At[m][k], acc[ai][bj][m][n], 0, 0, 0); __builtin_amdgcn_s_setprio(0); } while (0)
#define PG8_WAIT_V(n) asm volatile("s_waitcnt vmcnt(" #n ")" ::: "memory")
#define PG8_WAIT_L(n) asm volatile("s_waitcnt lgkmcnt(" #n ")" ::: "memory")
#define PG8_BAR __builtin_amdgcn_s_barrier()
#define PG8_SCHED __builtin_amdgcn_sched_barrier(0)
    Unit cur, nxt; int ui = 0;
    if (!S.next(0, cur)) return;
    f32x4 acc[2][2][4][2];
#pragma unroll
    for (int a = 0; a < 2; ++a)
#pragma unroll
        for (int b = 0; b < 2; ++b)
#pragma unroll
            for (int m = 0; m < 4; ++m)
#pragma unroll
                for (int n = 0; n < 2; ++n) acc[a][b][m][n] = (f32x4){0.f, 0.f, 0.f, 0.f};
    bf16x8 At[4][2], B0[2][2], B1[2][2];
    const char* cA = (const char*)g.A + (size_t)cur.pm * tstepA + S.a_off(cur); const char* cB = (const char*)g.Bt + (size_t)cur.pn * tstep;
    S.a_ready(cur);
    PG8_STAGE(PG8_SB(0, 0), cB, voffB); PG8_STAGE(PG8_SA(0, 0), cA, voffA); PG8_STAGE(PG8_SB(0, 1), cB + hstep, voffB); PG8_STAGE(PG8_SA(0, 1), cA + hstepA, voffA);
    if (wr == 1) PG8_BAR;
    PG8_WAIT_V(4); PG8_BAR;
    PG8_STAGE(PG8_SB(1, 0), cB + kstep, voffB); PG8_STAGE(PG8_SA(1, 0), cA + kstep, voffA); PG8_STAGE(PG8_SB(1, 1), cB + hstep + kstep, voffB);
    PG8_WAIT_V(6); PG8_BAR;
    PG8_STAMP();
    for (;;) {
        const bool has_next = S.next(ui + 1, nxt);
        const char* nA = has_next ? (const char*)g.A + (size_t)nxt.pm * tstepA + S.a_off(nxt) : cA; const char* nB = has_next ? (const char*)g.Bt + (size_t)nxt.pn * tstep : cB;
        for (int t = 0; t < nt; t += 2) {
            const bool last = (t == nt - 2);
            const char* a1 = cA + (size_t)(t + 1) * kstep;
            const char* a2 = last ? nA : cA + (size_t)(t + 2) * kstep; const char* b2 = last ? nB : cB + (size_t)(t + 2) * kstep;
            const char* a3 = a2 + kstep; const char* b3 = b2 + kstep;
            if (last && has_next) S.a_ready(nxt);
            PG8_LDB(B0, 0, 0); PG8_SCHED; PG8_LDA(At, 0, 0); PG8_STAGE(PG8_SA(1, 1), a1 + hstepA, voffA);
            PG8_WAIT_L(8); PG8_BAR; PG8_WAIT_L(0); PG8_MMA(0, 0, At, B0); PG8_BAR; PG8_SCHED;
            PG8_LDB(B1, 0, 1); PG8_STAGE(PG8_SB(0, 0), b2, voffB);
            PG8_BAR; PG8_WAIT_L(0); PG8_MMA(0, 1, At, B1); PG8_BAR;
            PG8_LDA(At, 0, 1); PG8_STAGE(PG8_SA(0, 0), a2, voffA);
            PG8_BAR; PG8_WAIT_L(0); PG8_MMA(1, 0, At, B0); PG8_BAR; PG8_SCHED;
            PG8_STAGE(PG8_SB(0, 1), b2 + hstep, voffB);
            PG8_WAIT_V(6); PG8_BAR; PG8_MMA(1, 1, At, B1); PG8_BAR;
            PG8_LDB(B0, 1, 0); PG8_SCHED; PG8_LDA(At, 1, 0); PG8_STAGE(PG8_SA(0, 1), a2 + hstepA, voffA);
            PG8_WAIT_L(8); PG8_BAR; PG8_WAIT_L(0); PG8_MMA(0, 0, At, B0); PG8_BAR; PG8_SCHED;
            PG8_LDB(B1, 1, 1); PG8_STAGE(PG8_SB(1, 0), b3, voffB);
            PG8_BAR; PG8_WAIT_L(0); PG8_MMA(0, 1, At, B1); PG8_BAR;
            PG8_LDA(At, 1, 1); PG8_STAGE(PG8_SA(1, 0), a3, voffA);
            PG8_BAR; PG8_WAIT_L(0); PG8_MMA(1, 0, At, B0); PG8_BAR; PG8_SCHED;
            PG8_STAGE(PG8_SB(1, 1), b3 + hstep, voffB);
            PG8_WAIT_V(6); PG8_BAR; PG8_MMA(1, 1, At, B1); PG8_BAR;
        }
        PG8_STAMP();
        if constexpr (!Epi::AFTER_DRAIN) { E(acc, cur, wr, wc, fr, fq); S.done(cur); }
        PG8_STAMP();
        if (!has_next) break;
#pragma unroll
        for (int a = 0; a < 2; ++a)
#pragma unroll
            for (int b = 0; b < 2; ++b)
#pragma unroll
                for (int m = 0; m < 4; ++m)
#pragma unroll
                    for (int n = 0; n < 2; ++n) acc[a][b][m][n] = (f32x4){0.f, 0.f, 0.f, 0.f};
        cur = nxt; cA = nA; cB = nB; ++ui;
    }
    PG8_WAIT_V(0);
    if (wr == 0) PG8_BAR;
    PG8_BAR;
    if constexpr (Epi::AFTER_DRAIN) { E.fused(acc, cur, wr, wc, fr, fq, lds, wid, lane); S.done(cur); }
    PG8_STAMP();
    if (STAMP && wid == 0) { stamps[lane] = lane < nts ? (((unsigned long long)(unsigned)ts_hi << 32) | (unsigned)ts_lo) : 0ull;
        if (lane == 62) stamps[62] = rt_entry; if (lane == 63) stamps[63] = (unsigned long long)wall_clock64(); }
#undef PG8_STAMP
#undef PG8_SA
#undef PG8_SB
#undef PG8_STAGE
#undef PG8_LDA
#undef PG8_LDB
#undef PG8_MMA
#undef PG8_WAIT_V
#undef PG8_WAIT_L
#undef PG8_BAR
#undef PG8_SCHED
}
}

struct EpiStoreBf16 {
  static constexpr bool PERM = true, AFTER_DRAIN = false;
  bf16_t* O; int ldc;
  DI void operator()(const pg8::f32x4 (&acc)[2][2][4][2], const pg8::Unit& u, int wr, int wc, int fr, int fq) const {
    const int row0 = u.pm * 256 + wr * 64 + fr, col0 = u.pn * 256 + wc * 32 + 8 * fq;
#pragma unroll
    for (int ai = 0; ai < 2; ++ai)
#pragma unroll
      for (int m = 0; m < 4; ++m) {
        bf16_t* rowp = O + (size_t)(row0 + ai * 128 + m * 16) * ldc + col0;
#pragma unroll
        for (int bj = 0; bj < 2; ++bj) {
          const pg8::f32x4 v0 = acc[ai][bj][m][0], v1 = acc[ai][bj][m][1];
          uint4 o; o.x = pack2(v0[0], v0[1]); o.y = pack2(v0[2], v0[3]); o.z = pack2(v1[0], v1[1]); o.w = pack2(v1[2], v1[3]);
          *(uint4*)(rowp + bj * 128) = o;
        }
      }
  }
};
struct EpiGate {
  static constexpr bool PERM = true, AFTER_DRAIN = false;
  bf16_t* O; int ldc; const float* bias;
  DI void operator()(const pg8::f32x4 (&acc)[2][2][4][2], const pg8::Unit& u, int wr, int wc, int fr, int fq) const {
    const int row0 = u.pm * 256 + wr * 64 + fr, col0 = u.pn * 256 + wc * 32 + 8 * fq;
#pragma unroll
    for (int bj = 0; bj < 2; ++bj) {
      const float4 b0 = *(const float4*)(bias + col0 + bj * 128), b1 = *(const float4*)(bias + col0 + bj * 128 + 4);
#pragma unroll
      for (int ai = 0; ai < 2; ++ai)
#pragma unroll
        for (int m = 0; m < 4; ++m) {
          bf16_t* rowp = O + (size_t)(row0 + ai * 128 + m * 16) * ldc + col0 + bj * 128;
          const pg8::f32x4 v0 = acc[ai][bj][m][0], v1 = acc[ai][bj][m][1];
          uint4 o;
          o.x = pack2(fast_sigmoid(v0[0] + b0.x), fast_sigmoid(v0[1] + b0.y));
          o.y = pack2(fast_sigmoid(v0[2] + b0.z), fast_sigmoid(v0[3] + b0.w));
          o.z = pack2(fast_sigmoid(v1[0] + b1.x), fast_sigmoid(v1[1] + b1.y));
          o.w = pack2(fast_sigmoid(v1[2] + b1.z), fast_sigmoid(v1[3] + b1.w));
          *(uint4*)rowp = o;
        }
    }
  }
};
template <int FIRST>
struct EpiZ {
  static constexpr bool PERM = true, AFTER_DRAIN = false;
  bf16_t* ACC; const bf16_t* SG;
  DI void operator()(const pg8::f32x4 (&acc)[2][2][4][2], const pg8::Unit& u, int wr, int wc, int fr, int fq) const {
    const int row0 = u.pm * 256 + wr * 64 + fr, col0 = u.pn * 256 + wc * 32 + 8 * fq;
#pragma unroll
    for (int ai = 0; ai < 2; ++ai)
#pragma unroll
      for (int m = 0; m < 4; ++m) {
        const size_t row = (size_t)(row0 + ai * 128 + m * 16);
#pragma unroll
        for (int bj = 0; bj < 2; ++bj) {
          const int col = col0 + bj * 128;
          float g[8], a[8];
          unpack8(*(const uint4*)(SG + row * 4096 + col), g);
          const pg8::f32x4 v0 = acc[ai][bj][m][0], v1 = acc[ai][bj][m][1];
          const float z[8] = {v0[0], v0[1], v0[2], v0[3], v1[0], v1[1], v1[2], v1[3]};
          if (FIRST) {
#pragma unroll
            for (int e = 0; e < 8; ++e) a[e] = g[e] * z[e];
          } else {
            {
              const unsigned long long* ap = (const unsigned long long*)(ACC + row * 1024 + col);
              const unsigned long long q0 = __hip_atomic_load(ap, __ATOMIC_RELAXED, __HIP_MEMORY_SCOPE_AGENT);
              const unsigned long long q1 = __hip_atomic_load(ap + 1, __ATOMIC_RELAXED, __HIP_MEMORY_SCOPE_AGENT);
              uint4 av; av.x = (unsigned)q0; av.y = (unsigned)(q0 >> 32); av.z = (unsigned)q1; av.w = (unsigned)(q1 >> 32);
              unpack8(av, a);
            }
#pragma unroll
            for (int e = 0; e < 8; ++e) a[e] += g[e] * z[e];
          }
          *(uint4*)(ACC + row * 1024 + col) = pack8(a);
        }
      }
  }
};
struct EpiOut {
  static constexpr bool PERM = false, AFTER_DRAIN = false;
  const float* src; float* dst; const float* gt;
  DI void operator()(const pg8::f32x4 (&acc)[2][2][4][2], const pg8::Unit& u, int wr, int wc, int fr, int fq) const {
    const int row0 = u.pm * 256 + wr * 64 + fr, col0 = u.pn * 256 + wc * 32 + 4 * fq;
#pragma unroll
    for (int bj = 0; bj < 2; ++bj)
#pragma unroll
      for (int n = 0; n < 2; ++n) {
        const int col = col0 + bj * 128 + n * 16;
        const float4 gv = *(const float4*)(gt + col);
#pragma unroll
        for (int ai = 0; ai < 2; ++ai)
#pragma unroll
          for (int m = 0; m < 4; ++m) {
            const size_t idx = (size_t)(row0 + ai * 128 + m * 16) * 1024 + col;
            const float4 sv = *(const float4*)(src + idx);
            const pg8::f32x4 v = acc[ai][bj][m][n];
            float4 o; o.x = sv.x + gv.x * v[0]; o.y = sv.y + gv.y * v[1]; o.z = sv.z + gv.z * v[2]; o.w = sv.w + gv.w * v[3];
            *(float4*)(dst + idx) = o;
          }
      }
  }
};
template <class Epi>
DI void run_gemm(char* smem, const bf16_t* A, int lda, const bf16_t* Bt, int M, int N, int K, const Epi& E) {
  pg8::Gemm g; g.A = A; g.Bt = Bt; g.M = M; g.N = N; g.K = K; g.lda = lda;
  pg8::StaticOrder S; S.init(M, N, (int)gridDim.x, get_bid());
  __syncthreads();
  pg8::gemm_phase<Epi, pg8::StaticOrder, false>((PG8_LAS unsigned char*)smem, g, S, E, nullptr);
  __syncthreads();
}

DI void transpose_job(const float* __restrict__ src, int K, int N, bf16_t* __restrict__ dst, int Npad, char* smem) {
  float* tS = (float*)smem;
  const int tid = get_tid();
  const int ntk = K >> 6, ntn = Npad >> 6;
  for (int tile = get_bid(); tile < ntk * ntn; tile += gridDim.x) {
    const int kt = tile % ntk, nt = tile / ntk;
    __syncthreads();
    {
      const int kk = tid >> 3, c8 = (tid & 7) * 8;
      const int col = nt * 64 + c8;
      float v[8];
      if (col < N) {
        const float4 a = *(const float4*)(src + (size_t)(kt * 64 + kk) * N + col);
        const float4 b = *(const float4*)(src + (size_t)(kt * 64 + kk) * N + col + 4);
        v[0] = a.x; v[1] = a.y; v[2] = a.z; v[3] = a.w; v[4] = b.x; v[5] = b.y; v[6] = b.z; v[7] = b.w;
      } else {
#pragma unroll
        for (int e = 0; e < 8; ++e) v[e] = 0.f;
      }
#pragma unroll
      for (int e = 0; e < 8; ++e) tS[kk * 65 + c8 + e] = v[e];
    }
    __syncthreads();
    {
      const int n = tid >> 3, k8 = (tid & 7) * 8;
      float v[8];
#pragma unroll
      for (int e = 0; e < 8; ++e) v[e] = tS[(k8 + e) * 65 + n];
      *(uint4*)(dst + (size_t)(nt * 64 + n) * K + kt * 64 + k8) = pack8(v);
    }
  }
}

DI void phase_prep(const Params& p, char* smem) {
  const int tid = get_tid();
  char* ws = p.ws;
  if (get_bid() == 0 && tid < 64) ((int*)(ws + OFF_CTR))[tid] = 0;
  for (int l = 0; l < 2; ++l) {
    transpose_job(p.in[I_WIN] + (size_t)l * 1024 * NIN, 1024, NIN, (bf16_t*)(ws + OFF_WINT) + (size_t)l * NPAD * 1024, NPAD, smem);
    for (int i = 0; i < 4; ++i) {
      transpose_job(p.in[I_MGW] + (size_t)(l * 4 + i) * 1024 * 1024, 1024, 1024, (bf16_t*)(ws + OFF_MGT) + (size_t)(l * 4 + i) * 1024 * 1024, 1024, smem);
      transpose_job(p.in[I_WBR] + (size_t)(l * 4 + i) * 512 * 1024, 512, 1024, (bf16_t*)(ws + OFF_BRT) + (size_t)(l * 4 + i) * 1024 * 512, 1024, smem);
    }
    transpose_job(p.in[I_WOUT] + (size_t)l * 1024 * 1024, 1024, 1024, (bf16_t*)(ws + OFF_OUTT) + (size_t)l * 1024 * 1024, 1024, smem);
    transpose_job(p.in[I_MLAWUQ] + (size_t)l * 256 * 768, 256, 768, (bf16_t*)(ws + OFF_WUQT) + (size_t)l * 768 * 256, 768, smem);
    transpose_job(p.in[I_MLAWUKV] + (size_t)l * 256 * 1024, 256, 1024, (bf16_t*)(ws + OFF_WUKVT) + (size_t)l * 1024 * 256, 1024, smem);
  }
  {
    float* sv = (float*)smem;
    float* red = sv + 3 * 1024;
    float* modv = (float*)(ws + OFF_MODV);
    for (int job = get_bid(); job < 96; job += gridDim.x) {
      const int l = job / 48, cg0 = (job % 48) * 64;
      __syncthreads();
      for (int i = tid; i < 3072; i += 512) {
        const int rr = i >> 10, k = i & 1023;
        const float cv = (rr < 2) ? p.in[I_C][rr * 1024 + k] : p.in[I_CCTX][k];
        sv[i] = siluf_(cv);
      }
      __syncthreads();
      const int cl = tid & 63, ks = tid >> 6;
      float a0 = 0.f, a1 = 0.f, a2 = 0.f;
      const float* mw = p.in[I_MODW] + (size_t)l * 1024 * 3072 + cg0 + cl;
      for (int k = ks * 128; k < ks * 128 + 128; ++k) {
        const float wv = mw[(size_t)k * 3072];
        a0 += sv[k] * wv; a1 += sv[1024 + k] * wv; a2 += sv[2048 + k] * wv;
      }
      red[(ks * 3 + 0) * 64 + cl] = a0; red[(ks * 3 + 1) * 64 + cl] = a1; red[(ks * 3 + 2) * 64 + cl] = a2;
      __syncthreads();
      if (tid < 192) {
        const int rr = tid >> 6, c = tid & 63;
        float s = 0.f;
        for (int q = 0; q < 8; ++q) s += red[(q * 3 + rr) * 64 + c];
        modv[(l * 3 + rr) * 3072 + cg0 + c] = s + p.in[I_MODB][l * 3072 + cg0 + c];
      }
    }
  }
  {
    float* cosH = (float*)(ws + OFF_ROPE);
    float* sinH = cosH + SEQ * 32;
    float* cosM = sinH + SEQ * 32;
    float* sinM = cosM + SEQ * 16;
    for (int idx = get_bid() * 512 + tid; idx < SEQ * 48; idx += gridDim.x * 512) {
      if (idx < SEQ * 32) {
        const int t = idx >> 5, i = idx & 31, f = i & 15;
        const float pos = (i < 16) ? (float)(t >> 6) : (float)(t & 63);
        const float inv = exp2f(-(float)f * (13.287712379549449f / 16.f));
        const float ang = pos * inv;
        cosH[idx] = cosf(ang); sinH[idx] = sinf(ang);
      } else {
        const int j = idx - SEQ * 32;
        const int t = j >> 4, i = j & 15, f = i & 7;
        const float pos = (i < 8) ? (float)(t >> 6) : (float)(t & 63);
        const float inv = exp2f(-(float)f * (13.287712379549449f / 8.f));
        const float ang = pos * inv;
        cosM[j] = cosf(ang); sinM[j] = sinf(ang);
      }
    }
  }
}

DI void phase_h(const Params& p, int l, int b) {
  const int tid = get_tid(), lane = tid & 63, w = tid >> 6;
  const float* xin = (l == 0) ? p.in[I_X] : p.out;
  const float* cin = (l == 0) ? p.in[I_CTX] : (const float*)(p.ws + OFF_CX1);
  const float* ng = p.in[I_NORMG] + l * 1024;
  const float* modv = (const float*)(p.ws + OFF_MODV);
  bf16_t* H = (bf16_t*)(p.ws + OFF_H);
  for (int row = get_bid() * 8 + w; row < TR; row += gridDim.x * 8) {
    const float* src; const float* mv;
    if (row < 256) { src = cin + ((size_t)b * 256 + row) * 1024; mv = modv + (l * 3 + 2) * 3072; }
    else { src = xin + ((size_t)b * SEQ + (row - 256)) * 1024; mv = modv + (l * 3 + b) * 3072; }
    float4 v[4];
    float ss = 0.f;
#pragma unroll
    for (int i = 0; i < 4; ++i) {
      v[i] = *(const float4*)(src + i * 256 + lane * 4);
      ss += v[i].x * v[i].x + v[i].y * v[i].y + v[i].z * v[i].z + v[i].w * v[i].w;
    }
    ss = red64(ss);
    const float rs = rsqrtf(ss * (1.f / 1024.f) + 1e-6f);
#pragma unroll
    for (int i = 0; i < 4; ++i) {
      const int c = i * 256 + lane * 4;
      const float4 g = *(const float4*)(ng + c);
      const float4 sh = *(const float4*)(mv + c);
      const float4 sc = *(const float4*)(mv + 1024 + c);
      float o[4];
      o[0] = v[i].x * rs * g.x * (1.f + sc.x) + sh.x;
      o[1] = v[i].y * rs * g.y * (1.f + sc.y) + sh.y;
      o[2] = v[i].z * rs * g.z * (1.f + sc.z) + sh.z;
      o[3] = v[i].w * rs * g.w * (1.f + sc.w) + sh.w;
      *(uint2*)(H + (size_t)row * 1024 + c) = pack4(o);
    }
  }
}

DI void phase_g1(const Params& p, int l, char* smem) {
  EpiStoreBf16 E; E.O = (bf16_t*)(p.ws + OFF_P); E.ldc = LDP;
  run_gemm(smem, (const bf16_t*)(p.ws + OFF_H), 1024, (const bf16_t*)(p.ws + OFF_WINT) + (size_t)l * NPAD * 1024, TR, NPAD, 1024, E);
}

DI int swap23(int p) { return (p & 3) | ((p & 4) << 1) | ((p & 8) >> 1); }
DI void vt_tile(const bf16_t* __restrict__ src, int ld, bf16_t* __restrict__ dst, int tok0, char* smem) {
  bf16_t* tS = (bf16_t*)smem;
  const int tid = get_tid();
  __syncthreads();
  {
    const int tok = tid >> 3, c8 = (tid & 7) * 8;
    *(uint4*)(tS + tok * 72 + c8) = *(const uint4*)(src + (size_t)(tok0 + tok) * ld + c8);
  }
  __syncthreads();
  {
    const int dv = tid >> 3, pc = tid & 7;
    unsigned short v[8];
#pragma unroll
    for (int j = 0; j < 8; ++j) {
      const int pos = 8 * pc + j;
      const int tokoff = (pos & ~15) | swap23(pos & 15);
      v[j] = tS[tokoff * 72 + dv];
    }
    uint4 o;
    o.x = v[0] | ((unsigned)v[1] << 16); o.y = v[2] | ((unsigned)v[3] << 16);
    o.z = v[4] | ((unsigned)v[5] << 16); o.w = v[6] | ((unsigned)v[7] << 16);
    *(uint4*)(dst + (size_t)dv * TR + tok0 + 8 * pc) = o;
  }
}

DI void phase_post(const Params& p, int l, char* smem) {
  const int tid = get_tid(), lane = tid & 63, w = tid >> 6;
  bf16_t* P = (bf16_t*)(p.ws + OFF_P);
  const float* cosH = (const float*)(p.ws + OFF_ROPE);
  const float* sinH = cosH + SEQ * 32;
  const int m = lane & 7;
  for (int row = get_bid() * 8 + w; row < TR; row += gridDim.x * 8) {
    bf16_t* Pr = P + (size_t)row * LDP;
    float x[8];
    const uint4 vaq = *(const uint4*)(Pr + A_Q + lane * 8);
    const uint4 vak = *(const uint4*)(Pr + A_K + lane * 8);
    const uint4 vdq = *(const uint4*)(Pr + D_Q + lane * 8);
    const uint4 vdk = *(const uint4*)(Pr + D_K + (lane & 15) * 8);
    const uint4 vcc = *(const uint4*)(Pr + C_CQ + 256 * (lane >> 5) + (lane & 31) * 8);
    float cs8[8], sn8[8];
    {
      const int t = (row >= 256) ? (row - 256) : 0;
      const float4 c0 = *(const float4*)(cosH + t * 32 + 8 * (m & 3)), c1 = *(const float4*)(cosH + t * 32 + 8 * (m & 3) + 4);
      const float4 s0 = *(const float4*)(sinH + t * 32 + 8 * (m & 3)), s1 = *(const float4*)(sinH + t * 32 + 8 * (m & 3) + 4);
      cs8[0] = c0.x; cs8[1] = c0.y; cs8[2] = c0.z; cs8[3] = c0.w; cs8[4] = c1.x; cs8[5] = c1.y; cs8[6] = c1.z; cs8[7] = c1.w;
      sn8[0] = s0.x; sn8[1] = s0.y; sn8[2] = s0.z; sn8[3] = s0.w; sn8[4] = s1.x; sn8[5] = s1.y; sn8[6] = s1.z; sn8[7] = s1.w;
    }
    {
      unpack8(vaq, x);
      float ss = 0.f;
#pragma unroll
      for (int e = 0; e < 8; ++e) ss += x[e] * x[e];
      ss = red8(ss);
      const float rs = rsqrtf(ss * (1.f / 64.f) + 1e-6f) * SC64;
#pragma unroll
      for (int e = 0; e < 8; ++e) x[e] = x[e] * rs * p.in[I_NAQG][l * 64 + m * 8 + e];
      *(uint4*)(Pr + A_Q + lane * 8) = pack8(x);
    }
    {
      unpack8(vak, x);
      float ss = 0.f;
#pragma unroll
      for (int e = 0; e < 8; ++e) ss += x[e] * x[e];
      ss = red8(ss);
      const float rs = rsqrtf(ss * (1.f / 64.f) + 1e-6f);
#pragma unroll
      for (int e = 0; e < 8; ++e) x[e] = x[e] * rs * p.in[I_NAKG][l * 64 + m * 8 + e];
      *(uint4*)(Pr + A_K + lane * 8) = pack8(x);
    }
#pragma unroll
    for (int which = 0; which < 2; ++which) {
      const int lc = which ? (lane & 15) : lane;
      bf16_t* ptr = Pr + (which ? D_K : D_Q) + lc * 8;
      const float* gg = (which ? p.in[I_GQAKG] : p.in[I_GQAQG]) + l * 64 + m * 8;
      unpack8(which ? vdk : vdq, x);
      float ss = 0.f;
#pragma unroll
      for (int e = 0; e < 8; ++e) ss += x[e] * x[e];
      ss = red8(ss);
      const float rs = rsqrtf(ss * (1.f / 64.f) + 1e-6f);
#pragma unroll
      for (int e = 0; e < 8; ++e) x[e] = x[e] * rs * gg[e];
      if (row >= 256) {
        const float sgn = (m < 4) ? -1.f : 1.f;
#pragma unroll
        for (int e = 0; e < 8; ++e) {
          const float pr = __shfl_xor(x[e], 4);
          x[e] = x[e] * cs8[e] + sgn * pr * sn8[e];
        }
      }
      if (!which) {
#pragma unroll
        for (int e = 0; e < 8; ++e) x[e] *= SC64;
      }
      if (!which || lane < 16) *(uint4*)ptr = pack8(x);
    }
    {
      const int hh = lane >> 5, li = lane & 31;
      bf16_t* ptr = Pr + C_CQ + 256 * hh + li * 8;
      const float* gg = (hh ? p.in[I_MLAKVAG] : p.in[I_MLAQAG]) + l * 256 + li * 8;
      unpack8(vcc, x);
      float ss = 0.f;
#pragma unroll
      for (int e = 0; e < 8; ++e) ss += x[e] * x[e];
      ss = red32(ss);
      const float rs = rsqrtf(ss * (1.f / 256.f) + 1e-6f);
#pragma unroll
      for (int e = 0; e < 8; ++e) x[e] = x[e] * rs * gg[e];
      *(uint4*)ptr = pack8(x);
    }
  }
  {
    bf16_t* XWA = (bf16_t*)(p.ws + OFF_XWA);
    const float* mu = p.in[I_RWMU] + l * 1792;
    const int dd = lane >> 5, which = (lane >> 4) & 1, c4 = (lane & 15) * 4;
    const int col = B_U + 1536 + 128 * which + 64 * dd + c4;
    for (int row = get_bid() * 8 + w; row < TR; row += gridDim.x * 8) {
      const int segb = (row < 256) ? 0 : 256, sege = (row < 256) ? 256 : TR;
      const bf16_t* pc = P + (size_t)row * LDP + col;
      float u0[4], um[4], up[4], o[4];
      unpack4(*(const uint2*)pc, u0);
      if (row > segb) unpack4(*(const uint2*)(pc - LDP), um); else { um[0] = um[1] = um[2] = um[3] = 0.f; }
      if (row < sege - 1) unpack4(*(const uint2*)(pc + LDP), up); else { up[0] = up[1] = up[2] = up[3] = 0.f; }
      const float4 m4 = *(const float4*)(mu + (col - B_U));
      const float mm[4] = {m4.x, m4.y, m4.z, m4.w};
#pragma unroll
      for (int e = 0; e < 4; ++e) {
        const float v = u0[e] + mm[e] * (0.5f * (um[e] + up[e]) - u0[e]);
        o[e] = which ? v : fast_tanh(v);
      }
      *(uint2*)(XWA + ((size_t)dd * TR + row) * 128 + 64 * which + c4) = pack4(o);
    }
  }
  for (int tile = get_bid(); tile < 260 * 10; tile += gridDim.x) {
    const int tt = tile % 260, hd = tile / 260;
    if (hd < 8) vt_tile(P + A_V + hd * 64, LDP, (bf16_t*)(p.ws + OFF_VTA) + (size_t)hd * 64 * TR, tt * 64, smem);
    else vt_tile(P + D_V + (hd - 8) * 64, LDP, (bf16_t*)(p.ws + OFF_VTD) + (size_t)(hd - 8) * 64 * TR, tt * 64, smem);
  }
}

DI void phase_mlaproj(const Params& p, int l, char* smem) {
  const bf16_t* P = (const bf16_t*)(p.ws + OFF_P);
  EpiStoreBf16 E;
  E.O = (bf16_t*)(p.ws + OFF_QM); E.ldc = 768;
  run_gemm(smem, P + C_CQ, LDP, (const bf16_t*)(p.ws + OFF_WUQT) + (size_t)l * 768 * 256, TR, 768, 256, E);
  E.O = (bf16_t*)(p.ws + OFF_KVRAW); E.ldc = 1024;
  run_gemm(smem, P + C_CKV, LDP, (const bf16_t*)(p.ws + OFF_WUKVT) + (size_t)l * 1024 * 256, TR, 1024, 256, E);
}

DI void phase_mlapost(const Params& p, int l, char* smem) {
  const int tid = get_tid(), lane = tid & 63, w = tid >> 6;
  const bf16_t* P = (const bf16_t*)(p.ws + OFF_P);
  bf16_t* Qm = (bf16_t*)(p.ws + OFF_QM);
  const bf16_t* KV = (const bf16_t*)(p.ws + OFF_KVRAW);
  bf16_t* Km = (bf16_t*)(p.ws + OFF_KM);
  const float* cosM = (const float*)(p.ws + OFF_ROPE) + SEQ * 64;
  const float* sinM = cosM + SEQ * 16;
  const int hh = lane >> 3, m = lane & 7;
  for (int row = get_bid() * 8 + w; row < TR; row += gridDim.x * 8) {
    const uint4 vnq = *(const uint4*)(Qm + (size_t)row * 768 + hh * 96 + 8 * m);
    const uint2 vtq = *(const uint2*)(Qm + (size_t)row * 768 + hh * 96 + 64 + 4 * m);
    const uint4 vnk = *(const uint4*)(KV + (size_t)row * 1024 + hh * 128 + 8 * m);
    const uint2 vtk = *(const uint2*)(P + (size_t)row * LDP + C_KR + 4 * m);
    float4 c4, s4;
    {
      const int t = (row >= 256) ? (row - 256) : 0;
      c4 = *(const float4*)(cosM + t * 16 + 4 * (m & 3));
      s4 = *(const float4*)(sinM + t * 16 + 4 * (m & 3));
    }
    const float cc[4] = {c4.x, c4.y, c4.z, c4.w}, sn[4] = {s4.x, s4.y, s4.z, s4.w};
#pragma unroll
    for (int which = 0; which < 2; ++which) {
      float x[12];
      const float* gg = (which ? p.in[I_MLAKG] : p.in[I_MLAQG]) + l * 96;
      unpack8(which ? vnk : vnq, x); unpack4(which ? vtk : vtq, x + 8);
      float ss = 0.f;
#pragma unroll
      for (int e = 0; e < 12; ++e) ss += x[e] * x[e];
      ss = red8(ss);
      const float rs = rsqrtf(ss * (1.f / 96.f) + 1e-6f);
#pragma unroll
      for (int e = 0; e < 8; ++e) x[e] = x[e] * rs * gg[8 * m + e];
#pragma unroll
      for (int e = 0; e < 4; ++e) x[8 + e] = x[8 + e] * rs * gg[64 + 4 * m + e];
      if (row >= 256) {
        const float sgn = (m < 4) ? -1.f : 1.f;
#pragma unroll
        for (int e = 0; e < 4; ++e) {
          const float pr = __shfl_xor(x[8 + e], 4);
          x[8 + e] = x[8 + e] * cc[e] + sgn * pr * sn[e];
        }
      }
      if (!which) {
#pragma unroll
        for (int e = 0; e < 12; ++e) x[e] *= SC96;
      }
      bf16_t* dn = which ? (Km + (size_t)row * 768 + hh * 96 + 8 * m) : (Qm + (size_t)row * 768 + hh * 96 + 8 * m);
      bf16_t* dt = which ? (Km + (size_t)row * 768 + hh * 96 + 64 + 4 * m) : (Qm + (size_t)row * 768 + hh * 96 + 64 + 4 * m);
      *(uint4*)dn = pack8(x);
      *(uint2*)dt = pack4(x + 8);
    }
  }
  for (int tile = get_bid(); tile < 260 * 8; tile += gridDim.x) {
    const int tt = tile % 260, hd = tile / 260;
    vt_tile(KV + hd * 128 + 64, 1024, (bf16_t*)(p.ws + OFF_VTM) + (size_t)hd * 64 * TR, tt * 64, smem);
  }
}

template <int DK, int SUB, bool HALF = false>
DI void attn_item(const bf16_t* __restrict__ Qp, int ldq, const bf16_t* __restrict__ Kp, int ldk,
                  const bf16_t* __restrict__ Vt, bf16_t* __restrict__ Gp, int ldg, int q0,
                  int r0a, int n0, int r1a, int n1, int na_mode, const float* __restrict__ rpb, char* smem) {
  constexpr int KS = DK / 16, LK = DK + 8, CPR = DK / 8;
  constexpr int KR = SUB * 64;
  constexpr int LV = KR + 8;
  constexpr int NKC = KR * CPR / 512;
  constexpr int NKR = (KR * CPR) % 512;
  const int tid = get_tid(), lane = tid & 63, w = tid >> 6, r = lane & 31, h = lane >> 5;
  const int grp = w >> 2;
  bf16_t* Ks = (bf16_t*)smem;
  bf16_t* Vs = Ks + 2 * KR * LK;
  float* rpbS = (float*)(Vs + 3 * 64 * LV);
  __syncthreads();
  if (na_mode) for (int i = tid; i < 466; i += 512) rpbS[i] = (i < 465) ? rpb[i] * LOG2E : -1e30f;
  const int qrow = q0 + 32 * (HALF ? (w & 3) : w) + r;
  bf16x8 qf[KS];
#pragma unroll
  for (int ks = 0; ks < KS; ++ks) qf[ks] = *(const bf16x8*)(Qp + (size_t)qrow * ldq + ks * 16 + h * 8);
  f32x16 o[2]; o[0] = zero16(); o[1] = zero16();
  f32x16 s[2]; s[0] = zero16(); s[1] = zero16();
  float mrun = 0.f;
  bool first = true;
  f32x16 negm = zero16();
  float lsa = 0.f, lsb = 0.f;
  const int nsteps = n0 + n1;
  const int nsup = nsteps / SUB;
  const int tq = qrow - 256;
  const int qr = tq >> 6, qc = tq & 63;
  const int rs = min(max(qr - 4, 0), 248), cs = min(max(qc - 8, 0), 48);
  constexpr int NK = NKC + (NKR ? 1 : 0);
  uint4 k0 = make_uint4(0, 0, 0, 0), k1 = k0, k2 = k0, v0 = k0, v1 = k0;
  auto kaddr = [&](int rowstart, int i) { const int c = tid + 512 * i; return Kp + (size_t)(rowstart + c / CPR) * ldk + (c % CPR) * 8; };
  auto vaddr = [&](int rowstart, int i) { const int c = tid + 512 * i; return Vt + (size_t)(c / (8 * SUB)) * TR + rowstart + (c % (8 * SUB)) * 8; };
  auto klds = [&](int kb, int i) { const int c = tid + 512 * i; return Ks + (kb * KR + c / CPR) * LK + (c % CPR) * 8; };
  auto vlds = [&](int vb, int i) { const int c = tid + 512 * i; return Vs + (vb * 64 + c / (8 * SUB)) * LV + (c % (8 * SUB)) * 8; };
  auto gload = [&](int T) {
    const int t64 = T * SUB;
    const int rowstart = (t64 < n0) ? (r0a + 64 * t64) : (r1a + 64 * (t64 - n0));
    k0 = *(const uint4*)kaddr(rowstart, 0);
    if (NK >= 2) { if (NKC >= 2 || tid < NKR) k1 = *(const uint4*)kaddr(rowstart, 1); }
    if (NK >= 3) { if (NKC >= 3 || tid < NKR) k2 = *(const uint4*)kaddr(rowstart, 2); }
    v0 = *(const uint4*)vaddr(rowstart, 0);
    if (SUB >= 2) v1 = *(const uint4*)vaddr(rowstart, 1);
  };
  auto sstore = [&](int kb, int vb) {
    *(uint4*)klds(kb, 0) = k0;
    if (NK >= 2) { if (NKC >= 2 || tid < NKR) *(uint4*)klds(kb, 1) = k1; }
    if (NK >= 3) { if (NKC >= 3 || tid < NKR) *(uint4*)klds(kb, 2) = k2; }
    *(uint4*)vlds(vb, 0) = v0;
    if (SUB >= 2) *(uint4*)vlds(vb, 1) = v1;
  };
  auto do_qk = [&](int u, int kb) {
    const int sub = u % SUB;
#pragma unroll
    for (int kt2 = 0; kt2 < 2; ++kt2) {
      const bf16_t* kbp = Ks + (kb * KR + 64 * sub + 32 * kt2 + r) * LK + h * 8;
#pragma unroll
      for (int ks = 0; ks < KS; ++ks) {
        bf16x8 a = *(const bf16x8*)(kbp + ks * 16);
        s[kt2] = (ks == 0) ? MFMA32(a, qf[ks], negm) : MFMA32(a, qf[ks], s[kt2]);
      }
    }
    if (na_mode && u >= n0) {
      const int kr = ((r1a - 256) >> 6) + (u - n0);
      const bool rowok = (kr >= rs) && (kr <= rs + 7);
      const int rbase = rowok ? ((kr - qr + 7) * 31 - qc + 15) : -100000;
      const int clo = cs, chi = cs + 15;
#pragma unroll
      for (int kt2 = 0; kt2 < 2; ++kt2)
#pragma unroll
        for (int e = 0; e < 16; ++e) {
          const int kc = 32 * kt2 + crow(e, h);
          const bool ok = (rbase >= -1000) && (kc >= clo) && (kc <= chi);
          const int idx = ok ? (rbase + kc) : 465;
          s[kt2][e] += rpbS[idx];
        }
    }
  };
  auto do_sm_pv = [&](int u, int vb) {
    const int sub = u % SUB;
    float mx = __builtin_elementwise_maximum(s[0][0], s[1][0]);
#pragma unroll
    for (int e = 1; e < 16; ++e) mx = __builtin_elementwise_maximum(__builtin_elementwise_maximum(mx, s[0][e]), s[1][e]);
    mx = __builtin_elementwise_maximum(mx, __shfl_xor(mx, 32));
    if (first || __builtin_amdgcn_ballot_w64(mx > 8.f) != 0ull) {
      const float mnew = first ? (mrun + mx) : fmaxf(mrun, mrun + mx);
      const float dlt = mrun - mnew;
      const float alpha = first ? 1.f : __builtin_amdgcn_exp2f(dlt);
      mrun = mnew;
      lsa *= alpha; lsb *= alpha;
#pragma unroll
      for (int e = 0; e < 16; ++e) {
        o[0][e] *= alpha; o[1][e] *= alpha;
        s[0][e] += dlt; s[1][e] += dlt;
        negm[e] = -mnew;
      }
      first = false;
    }
#pragma unroll
    for (int kt2 = 0; kt2 < 2; ++kt2)
#pragma unroll
      for (int sx = 0; sx < 2; ++sx) {
        unsigned pk[4];
#pragma unroll
        for (int jj = 0; jj < 4; ++jj) {
          const float p0 = __builtin_amdgcn_exp2f(s[kt2][8 * sx + 2 * jj]);
          const float p1 = __builtin_amdgcn_exp2f(s[kt2][8 * sx + 2 * jj + 1]);
          lsa += p0; lsb += p1;
          pk[jj] = pack2(p0, p1);
        }
        uint4 pk4; pk4.x = pk[0]; pk4.y = pk[1]; pk4.z = pk[2]; pk4.w = pk[3];
        const bf16x8 pf = __builtin_bit_cast(bf16x8, pk4);
#pragma unroll
        for (int d2 = 0; d2 < 2; ++d2) {
          bf16x8 a = *(const bf16x8*)(Vs + (vb * 64 + 32 * d2 + r) * LV + 64 * sub + 32 * kt2 + 16 * sx + 8 * h);
          o[d2] = MFMA32(a, pf, o[d2]);
        }
      }
  };
  gload(0); sstore(0, 0);
  __syncthreads();
  int vcur = 0;
  for (int T = 0; T < nsup; ++T) {
    const int vprev = (vcur == 0) ? 2 : (vcur - 1);
    const int vnext = (vcur == 2) ? 0 : (vcur + 1);
    if (T + 1 < nsup) gload(T + 1);
    if (HALF) {
      const int u = T * SUB + grp;
      do_qk(u, T & 1); do_sm_pv(u, vcur);
    } else {
#pragma unroll
      for (int sub = 0; sub < SUB; ++sub) {
        const int u = T * SUB + sub;
        if (grp == 0) { do_qk(u, T & 1); do_sm_pv(u, vcur); }
        else { if (u > 0) do_sm_pv(u - 1, (sub == 0) ? vprev : vcur); do_qk(u, T & 1); }
      }
    }
    if (T + 1 < nsup) sstore((T + 1) & 1, vnext);
    __syncthreads();
    vcur = vnext;
  }
  if (!HALF) {
    if (grp == 1) {
      const int vlast = (vcur == 0) ? 2 : (vcur - 1);
      do_sm_pv(nsteps - 1, vlast);
    }
  }
  float lsum = lsa + lsb;
  if (HALF) {
    float* xch = (float*)smem + ((w & 3) * 64 + lane) * 36;
    if (grp == 1) {
#pragma unroll
      for (int d2 = 0; d2 < 2; ++d2)
#pragma unroll
        for (int q4 = 0; q4 < 4; ++q4)
          *(float4*)(xch + d2 * 16 + q4 * 4) = make_float4(o[d2][4 * q4], o[d2][4 * q4 + 1], o[d2][4 * q4 + 2], o[d2][4 * q4 + 3]);
      xch[32] = mrun; xch[33] = lsum;
    }
    __syncthreads();
    if (grp == 0) {
      const float m1 = xch[32], l1 = xch[33];
      const float mm = fmaxf(mrun, m1);
      const float a0 = __builtin_amdgcn_exp2f(mrun - mm), a1 = __builtin_amdgcn_exp2f(m1 - mm);
      lsum = lsum * a0 + l1 * a1;
#pragma unroll
      for (int d2 = 0; d2 < 2; ++d2)
#pragma unroll
        for (int q4 = 0; q4 < 4; ++q4) {
          const float4 ov = *(const float4*)(xch + d2 * 16 + q4 * 4);
          o[d2][4 * q4] = o[d2][4 * q4] * a0 + ov.x * a1;
          o[d2][4 * q4 + 1] = o[d2][4 * q4 + 1] * a0 + ov.y * a1;
          o[d2][4 * q4 + 2] = o[d2][4 * q4 + 2] * a0 + ov.z * a1;
          o[d2][4 * q4 + 3] = o[d2][4 * q4 + 3] * a0 + ov.w * a1;
        }
    }
  }
  const float lt = lsum + __shfl_xor(lsum, 32);
  const float inv = 1.f / lt;
  if (!HALF || grp == 0)
#pragma unroll
  for (int d2 = 0; d2 < 2; ++d2)
#pragma unroll
    for (int gq = 0; gq < 4; ++gq) {
      const int dv0 = 32 * d2 + 8 * gq + 4 * h;
      bf16_t* ptr = Gp + (size_t)qrow * ldg + dv0;
      uint2 gv = *(const uint2*)ptr;
      float g[4]; unpack4(gv, g);
      float y[4];
#pragma unroll
      for (int e = 0; e < 4; ++e) y[e] = o[d2][4 * gq + e] * inv * siluf_(g[e]);
      *(uint2*)ptr = pack4(y);
    }
}

DI float dpp_x1(float v) { return __builtin_bit_cast(float, __builtin_amdgcn_update_dpp(0, __builtin_bit_cast(int, v), 0xB1, 0xF, 0xF, true)); }
DI float dpp_x2(float v) { return __builtin_bit_cast(float, __builtin_amdgcn_update_dpp(0, __builtin_bit_cast(int, v), 0x4E, 0xF, 0xF, true)); }
DI float dpp_hm(float v) { return __builtin_bit_cast(float, __builtin_amdgcn_update_dpp(0, __builtin_bit_cast(int, v), 0x141, 0xF, 0xF, true)); }
DI float dpp_rm(float v) { return __builtin_bit_cast(float, __builtin_amdgcn_update_dpp(0, __builtin_bit_cast(int, v), 0x140, 0xF, 0xF, true)); }
DI float dpp_red8(float v) { v += dpp_x1(v); v += dpp_x2(v); v += dpp_hm(v); return v; }
DI float dpp_red16(float v) { v += dpp_x1(v); v += dpp_x2(v); v += dpp_hm(v); v += dpp_rm(v); return v; }

struct ScanVec { float4 w, k, b, n, r; float v; };
DI void scan_load(ScanVec& sv, const float* cb, const float* vb) {
  sv.w = *(const float4*)(cb);
  sv.k = *(const float4*)(cb + 2048);
  sv.b = *(const float4*)(cb + 2 * 2048);
  sv.n = *(const float4*)(cb + 3 * 2048);
  sv.r = *(const float4*)(cb + 4 * 2048);
  sv.v = *vb;
}

DI void scan_item(const Params& p, int l, int hd, int d, int rp, char* smem) {
  const int tid = get_tid(), lane = tid & 63, w = tid >> 6;
  float* CH = (float*)smem;
  float* YC = CH + 2 * 6 * 2048;
  bf16_t* W2T = (bf16_t*)(YC + 4096);
  bf16_t* XW = W2T + 2 * 64 * 72;
  float* LO = (float*)(XW + 4 * 2 * 8 * 72);
  const bf16_t* P = (const bf16_t*)(p.ws + OFF_P);
  bf16_t* Yd = (bf16_t*)(p.ws + (d ? OFF_Y1 : OFF_Y0));
  float* Cb = (float*)(p.ws + OFF_CB) + (size_t)d * TR * 8;
  __syncthreads();
  {
    const float* w2 = p.in[I_RWW2] + (size_t)(l * 2 + d) * 64 * 512 + hd * 64;
    const float* a2 = p.in[I_RWA2] + (size_t)(l * 2 + d) * 64 * 512 + hd * 64;
    for (int i = tid; i < 4096; i += 512) {
      const int j = i >> 6, c = i & 63;
      W2T[c * 72 + j] = f2bf(w2[(size_t)j * 512 + c]);
      W2T[64 * 72 + c * 72 + j] = f2bf(a2[(size_t)j * 512 + c]);
    }
  }
  __syncthreads();
  const int NCH = 520;
  const float* mu = p.in[I_RWMU] + l * 1792;
#ifdef PROBE_SCAN2
  for (int rep = 0; rep < 2; ++rep) {
#endif
  v2f S01 = {0.f, 0.f}, S23 = {0.f, 0.f};
  for (int ci = 0; ci <= NCH + 1; ++ci) {
    if (w >= 4) {
      const int pw = w - 4;
      if (ci < NCH) {
        const int buf = ci & 1;
        int segbase, seglen, cs;
        if (ci < 8) { segbase = 0; seglen = 256; cs = d ? (7 - ci) : ci; }
        else { segbase = 256; seglen = SEQ; cs = d ? (511 - (ci - 8)) : (ci - 8); }
        const int tl = lane >> 3, m = lane & 7;
        const int tc = 8 * pw + tl;
        const int t = 32 * cs + tc;
        const size_t row = (size_t)(segbase + t);
        const bool hm = t > 0, hp = t < seglen - 1;
        float xr[8], xk[8], xv[8];
        const int cols[3] = {B_U + hd * 64 + 8 * m, B_U + 512 + hd * 64 + 8 * m, B_U + 1024 + hd * 64 + 8 * m};
        uint4 r0[3], rm[3], rq[3];
#pragma unroll
        for (int vv = 0; vv < 3; ++vv) {
          const bf16_t* pc = P + row * LDP + cols[vv];
          r0[vv] = *(const uint4*)pc;
          rm[vv] = hm ? *(const uint4*)(pc - LDP) : make_uint4(0, 0, 0, 0);
          rq[vv] = hp ? *(const uint4*)(pc + LDP) : make_uint4(0, 0, 0, 0);
        }
        const bf16_t* xsrc = (const bf16_t*)(p.ws + OFF_XWA) + ((size_t)d * TR + row) * 128 + 8 * m;
        const uint4 xw16 = *(const uint4*)xsrc, xa16 = *(const uint4*)(xsrc + 64);
#pragma unroll
        for (int vv = 0; vv < 3; ++vv) {
          float* dst = (vv == 0) ? xr : (vv == 1) ? xk : xv;
          float u0[8], um[8], up[8];
          unpack8(r0[vv], u0); unpack8(rm[vv], um); unpack8(rq[vv], up);
          const float* mp = mu + (cols[vv] - B_U);
          const float4 m0 = *(const float4*)mp, m1 = *(const float4*)(mp + 4);
          const float mm[8] = {m0.x, m0.y, m0.z, m0.w, m1.x, m1.y, m1.z, m1.w};
#pragma unroll
          for (int e = 0; e < 8; ++e) dst[e] = u0[e] + mm[e] * (0.5f * (um[e] + up[e]) - u0[e]);
        }
        const int c0 = hd * 64 + 8 * m;
        float kk[8];
        {
          const float4 q0 = *(const float4*)(p.in[I_RWKK] + l * 512 + c0), q1 = *(const float4*)(p.in[I_RWKK] + l * 512 + c0 + 4);
          const float qq[8] = {q0.x, q0.y, q0.z, q0.w, q1.x, q1.y, q1.z, q1.w};
          float ss = 0.f;
#pragma unroll
          for (int e = 0; e < 8; ++e) { kk[e] = xk[e] * qq[e]; ss += kk[e] * kk[e]; }
          ss = dpp_red8(ss);
          const float rn = rsqrtf(ss + 1e-12f);
#pragma unroll
          for (int e = 0; e < 8; ++e) kk[e] *= rn;
        }
        bf16_t* xwp = XW + pw * (2 * 8 * 72);
        *(uint4*)(xwp + tl * 72 + 8 * m) = xw16;
        *(uint4*)(xwp + 8 * 72 + tl * 72 + 8 * m) = xa16;
        __builtin_amdgcn_fence(__ATOMIC_RELEASE, "wavefront");
        __builtin_amdgcn_wave_barrier();
        __builtin_amdgcn_fence(__ATOMIC_ACQUIRE, "wavefront");
        {
          const int r = lane & 31, h = lane >> 5;
          float* lop = LO + pw * (2 * 8 * 64);
#pragma unroll
          for (int mat = 0; mat < 2; ++mat) {
            f32x16 acc[2]; acc[0] = zero16(); acc[1] = zero16();
#pragma unroll
            for (int ks = 0; ks < 4; ++ks) {
              bf16x8 a;
              if (r < 8) a = *(const bf16x8*)(xwp + mat * 8 * 72 + r * 72 + ks * 16 + h * 8);
              else {
#pragma unroll
                for (int e = 0; e < 8; ++e) a[e] = 0;
              }
#pragma unroll
              for (int nt = 0; nt < 2; ++nt) {
                bf16x8 bb = *(const bf16x8*)(W2T + mat * 64 * 72 + (32 * nt + r) * 72 + ks * 16 + h * 8);
                acc[nt] = MFMA32(a, bb, acc[nt]);
              }
            }
#pragma unroll
            for (int nt = 0; nt < 2; ++nt)
#pragma unroll
              for (int e = 0; e < 4; ++e) lop[mat * 8 * 64 + (4 * h + e) * 64 + 32 * nt + r] = acc[nt][e];
          }
        }
        __builtin_amdgcn_fence(__ATOMIC_RELEASE, "wavefront");
        __builtin_amdgcn_wave_barrier();
        __builtin_amdgcn_fence(__ATOMIC_ACQUIRE, "wavefront");
        {
          const float* lop = LO + pw * (2 * 8 * 64);
          float* chb = CH + buf * (6 * 2048) + tc * 64 + 8 * m;
          const float4 lw0 = *(const float4*)(lop + tl * 64 + 8 * m), lw1 = *(const float4*)(lop + tl * 64 + 8 * m + 4);
          const float4 la0 = *(const float4*)(lop + 512 + tl * 64 + 8 * m), la1 = *(const float4*)(lop + 512 + tl * 64 + 8 * m + 4);
          const float lw[8] = {lw0.x, lw0.y, lw0.z, lw0.w, lw1.x, lw1.y, lw1.z, lw1.w};
          const float la[8] = {la0.x, la0.y, la0.z, la0.w, la1.x, la1.y, la1.z, la1.w};
          const float* pw0 = p.in[I_RWW0] + (l * 2 + d) * 512 + c0;
          const float* pa0 = p.in[I_RWA0] + (l * 2 + d) * 512 + c0;
          const float* pka = p.in[I_RWKA] + l * 512 + c0;
          const float* prk = p.in[I_RWRK] + l * 512 + c0;
          float bon = 0.f;
          float ow[8], okd[8], obd[8], onk[8];
#pragma unroll
          for (int e = 0; e < 8; ++e) {
            const float xwl = pw0[e] + lw[e];
            const float xal = pa0[e] + la[e];
            const float dec = __expf(-0.6065306597126334f * fast_sigmoid(xwl));
            const float a = fast_sigmoid(xal);
            const float kd = xk[e] * (1.f + (a - 1.f) * pka[e]);
            ow[e] = dec; okd[e] = kd; obd[e] = kk[e] * a; onk[e] = -kk[e];
            bon += xr[e] * kd * prk[e];
          }
          bon = dpp_red8(bon);
          if (m == 0 && rp == 0) Cb[row * 8 + hd] = bon;
          *(float4*)(chb + 0 * 2048) = make_float4(ow[0], ow[1], ow[2], ow[3]);
          *(float4*)(chb + 0 * 2048 + 4) = make_float4(ow[4], ow[5], ow[6], ow[7]);
          *(float4*)(chb + 1 * 2048) = make_float4(okd[0], okd[1], okd[2], okd[3]);
          *(float4*)(chb + 1 * 2048 + 4) = make_float4(okd[4], okd[5], okd[6], okd[7]);
          *(float4*)(chb + 2 * 2048) = make_float4(obd[0], obd[1], obd[2], obd[3]);
          *(float4*)(chb + 2 * 2048 + 4) = make_float4(obd[4], obd[5], obd[6], obd[7]);
          *(float4*)(chb + 3 * 2048) = make_float4(onk[0], onk[1], onk[2], onk[3]);
          *(float4*)(chb + 3 * 2048 + 4) = make_float4(onk[4], onk[5], onk[6], onk[7]);
          *(float4*)(chb + 4 * 2048) = make_float4(xr[0], xr[1], xr[2], xr[3]);
          *(float4*)(chb + 4 * 2048 + 4) = make_float4(xr[4], xr[5], xr[6], xr[7]);
          *(float4*)(chb + 5 * 2048) = make_float4(xv[0], xv[1], xv[2], xv[3]);
          *(float4*)(chb + 5 * 2048 + 4) = make_float4(xv[4], xv[5], xv[6], xv[7]);
        }
      }
      if (ci >= 2) {
        const int cj = ci - 2;
        int segbase, cs;
        if (cj < 8) { segbase = 0; cs = d ? (7 - cj) : cj; }
        else { segbase = 256; cs = d ? (511 - (cj - 8)) : (cj - 8); }
        const int ptid = tid - 256;
        const int tf = ptid >> 3, i2 = (ptid & 7) * 2;
        const float* yc = YC + (cj & 1) * 2048 + tf * 64 + i2 * 4;
        const float4 ya = *(const float4*)yc, yb = *(const float4*)(yc + 4);
        const size_t row = (size_t)(segbase + 32 * cs + tf);
        *(unsigned*)(Yd + row * 512 + hd * 64 + 16 * rp + i2) = pack2((ya.x + ya.y) + (ya.z + ya.w), (yb.x + yb.y) + (yb.z + yb.w));
      }
    } else {
      if (ci >= 1 && ci <= NCH) {
        __builtin_amdgcn_s_setprio(3);
        const int cj = ci - 1;
        const int il = tid >> 4, js = tid & 15;
        const float* chb = CH + (cj & 1) * (6 * 2048) + 4 * js;
        const float* vb = CH + (cj & 1) * (6 * 2048) + 5 * 2048 + 16 * rp + il;
        float* yc = YC + (cj & 1) * 2048 + il * 4 + (js >> 2);
        const int tstep = d ? -64 : 64;
        const int t0 = d ? 31 * 64 : 0;
        ScanVec cur, nxt;
        scan_load(cur, chb + t0, vb + t0);
        int toff = t0;
#pragma unroll 8
        for (int sidx = 0; sidx < 32; ++sidx) {
          const int tn = (sidx < 31) ? (toff + tstep) : toff;
          scan_load(nxt, chb + tn, vb + tn);
          const v2f n01 = {cur.n.x, cur.n.y}, n23 = {cur.n.z, cur.n.w};
          v2f pa = S01 * n01;
          pa = S23 * n23 + pa;
          float sa = dpp_red16(pa.x + pa.y);
          const v2f k01 = {cur.k.x, cur.k.y}, k23 = {cur.k.z, cur.k.w};
          const v2f b01 = {cur.b.x, cur.b.y}, b23 = {cur.b.z, cur.b.w};
          const v2f w01 = {cur.w.x, cur.w.y}, w23 = {cur.w.z, cur.w.w};
          const v2f vv2 = {cur.v, cur.v}, sa2 = {sa, sa};
          v2f t01 = vv2 * k01, t23 = vv2 * k23;
          t01 = sa2 * b01 + t01; t23 = sa2 * b23 + t23;
          S01 = S01 * w01 + t01; S23 = S23 * w23 + t23;
          const v2f r01 = {cur.r.x, cur.r.y}, r23 = {cur.r.z, cur.r.w};
          v2f qa = S01 * r01;
          qa = S23 * r23 + qa;
          float y = qa.x + qa.y;
          y += dpp_x1(y); y += dpp_x2(y);
          yc[(toff >> 6) * 64] = y;
          cur = nxt;
          toff = tn;
        }
        __builtin_amdgcn_s_setprio(0);
      }
    }
    __syncthreads();
  }
#ifdef PROBE_SCAN2
  }
#endif
}

DI void phase_mix(const Params& p, int l, int lb, char* smem, int* s_item) {
  const int tid = get_tid();
  int* ctr = (int*)(p.ws + OFF_CTR) + lb;
  const bf16_t* P = (const bf16_t*)(p.ws + OFF_P);
  bf16_t* Pw = (bf16_t*)(p.ws + OFF_P);
  const int nctx = (l == 0) ? 24 : 0;
  constexpr int NSPLIT = 128;
  constexpr int E_MLA = 64 + 512, E_GQF = E_MLA + (512 - NSPLIT), E_GQH = E_GQF + 2 * NSPLIT, E_NA = E_GQH + 512;
  const int total = E_NA + nctx;
  while (true) {
    __syncthreads();
    if (tid == 0) *s_item = atomicAdd(ctr, 1);
    __syncthreads();
    const int item = *s_item;
    if (item >= total) break;
    if (item < 64) {
      scan_item(p, l, item >> 3, (item >> 2) & 1, item & 3, smem);
    } else {
      int ty, hd, q0, n0 = 4, r1a = 0, n1 = 0, na = 0, half = 0;
      if (item < E_MLA) { const int it = item - 64; ty = 0; hd = it >> 6; q0 = 256 + 256 * (it & 63); n0 = 260; }
      else if (item < E_GQF) { const int it = item - E_MLA; ty = 1; hd = it >> 6; q0 = 256 + 256 * (it & 63); n0 = 260; }
      else if (item < E_GQH) { const int it = item - E_GQF + 2 * (512 - NSPLIT); ty = 1; hd = it >> 7; q0 = 256 + 128 * (it & 127); n0 = 260; half = 1; }
      else if (item < E_NA) {
        const int it = item - E_GQH; ty = 2; hd = it >> 6; const int qt = it & 63; q0 = 256 + 256 * qt;
        const int rsmin = min(max(4 * qt - 4, 0), 248);
        const int rsend = min(max(4 * qt + 3 - 4, 0), 248) + 7;
        r1a = 256 + 64 * rsmin; n1 = rsend - rsmin + 1; na = 1;
      } else { const int it = item - E_NA; ty = it >> 3; hd = it & 7; q0 = 0; }
      if (ty == 0) {
        attn_item<96, 2>((const bf16_t*)(p.ws + OFF_QM) + hd * 96, 768, (const bf16_t*)(p.ws + OFF_KM) + hd * 96, 768,
                         (const bf16_t*)(p.ws + OFF_VTM) + (size_t)hd * 64 * TR, Pw + C_G + hd * 64, LDP, q0,
                         0, n0, 0, 0, 0, nullptr, smem);
      } else {
        const bf16_t* Qp = (ty == 1) ? (P + D_Q + hd * 64) : (P + A_Q + hd * 64);
        const bf16_t* Kp = (ty == 1) ? (P + D_K + (hd >> 2) * 64) : (P + A_K + hd * 64);
        const bf16_t* Vt = (ty == 1) ? ((const bf16_t*)(p.ws + OFF_VTD) + (size_t)(hd >> 2) * 64 * TR)
                                     : ((const bf16_t*)(p.ws + OFF_VTA) + (size_t)hd * 64 * TR);
        bf16_t* Gp = (ty == 1) ? (Pw + D_G + hd * 64) : (Pw + A_G + hd * 64);
        if (na)
          attn_item<64, 1>(Qp, LDP, Kp, LDP, Vt, Gp, LDP, q0, 0, n0, r1a, n1, 1, p.in[I_NARPB] + (size_t)(l * 8 + hd) * 465, smem);
        else if (half)
          attn_item<64, 2, true>(Qp, LDP, Kp, LDP, Vt, Gp, LDP, q0, 0, n0, 0, 0, 0, nullptr, smem);
        else
          attn_item<64, 2>(Qp, LDP, Kp, LDP, Vt, Gp, LDP, q0, 0, n0, 0, 0, 0, nullptr, smem);
      }
    }
  }
}

DI void phase_fin(const Params& p, int l) {
  const int tid = get_tid(), lane = tid & 63, w = tid >> 6;
  bf16_t* P = (bf16_t*)(p.ws + OFF_P);
  const bf16_t* Y0 = (const bf16_t*)(p.ws + OFF_Y0);
  const bf16_t* Y1 = (const bf16_t*)(p.ws + OFF_Y1);
  const float* Cb = (const float*)(p.ws + OFF_CB);
  const float* mu = p.in[I_RWMU] + l * 1792 + 1024;
  const int hh = lane >> 3, c = lane * 8;
  for (int row = get_bid() * 8 + w; row < TR; row += gridDim.x * 8) {
    float a[8], b2[8], ys[8];
    unpack8(*(const uint4*)(Y0 + (size_t)row * 512 + c), a);
    unpack8(*(const uint4*)(Y1 + (size_t)row * 512 + c), b2);
    float sm = 0.f;
#pragma unroll
    for (int e = 0; e < 8; ++e) { ys[e] = a[e] + b2[e]; sm += ys[e]; }
    const float mean = red8(sm) * (1.f / 64.f);
    float vs = 0.f;
#pragma unroll
    for (int e = 0; e < 8; ++e) { const float dd = ys[e] - mean; vs += dd * dd; }
    const float var = red8(vs) * (1.f / 64.f);
    const float rstd = rsqrtf(var + 64e-5f);
    const int segb = (row < 256) ? 0 : 256, sege = (row < 256) ? 256 : TR;
    bf16_t* Pr = P + (size_t)row * LDP;
    float u0[8], um[8], up[8];
    unpack8(*(const uint4*)(Pr + B_U + 1024 + c), u0);
    if (row > segb) unpack8(*(const uint4*)(Pr - LDP + B_U + 1024 + c), um); else {
#pragma unroll
      for (int e = 0; e < 8; ++e) um[e] = 0.f;
    }
    if (row < sege - 1) unpack8(*(const uint4*)(Pr + LDP + B_U + 1024 + c), up); else {
#pragma unroll
      for (int e = 0; e < 8; ++e) up[e] = 0.f;
    }
    const float bon = Cb[(size_t)row * 8 + hh] + Cb[(size_t)TR * 8 + (size_t)row * 8 + hh];
    float g[8], o[8];
    unpack8(*(const uint4*)(Pr + B_G + c), g);
#pragma unroll
    for (int e = 0; e < 8; ++e) {
      const float v = u0[e] + mu[c + e] * (0.5f * (um[e] + up[e]) - u0[e]);
      const float yn = (ys[e] - mean) * rstd * p.in[I_RWGNW][l * 512 + c + e] + p.in[I_RWGNB][l * 512 + c + e];
      o[e] = (yn + bon * v) * siluf_(g[e]);
    }
    *(uint4*)(Pr + B_G + c) = pack8(o);
  }
}

DI void phase_gate(const Params& p, int l, char* smem) {
  const bf16_t* H = (const bf16_t*)(p.ws + OFF_H);
  const bf16_t* W = (const bf16_t*)(p.ws + OFF_MGT) + (size_t)l * 4096 * 1024;
  bf16_t* SG = (bf16_t*)(p.ws + OFF_SG);
#ifdef PROBE_GATE
  { EpiStoreBf16 E0; E0.O = SG + (size_t)256 * 4096; E0.ldc = 4096; run_gemm(smem, H + (size_t)256 * 1024, 1024, W, SEQ, 4096, 1024, E0); }
#endif
  float* sb = (float*)(smem + 131072);
  __syncthreads();
  for (int i = get_tid(); i < 4096; i += 512) sb[i] = p.in[I_MGB][l * 4096 + i];
  __syncthreads();
  EpiGate E; E.ldc = 4096; E.bias = sb;
  E.O = SG + (size_t)256 * 4096;
  run_gemm(smem, H + (size_t)256 * 1024, 1024, W, SEQ, 4096, 1024, E);
  if (l == 0) { E.O = SG; run_gemm(smem, H, 1024, W, 256, 4096, 1024, E); }
}

struct ZOrder {
  int ntile, G, c;
  DI bool next(int i, pg8::Unit& u) const {
    int tile;
    if (((ntile | G) & 7) == 0) {
      const int per = ntile >> 3, local = (c >> 3) + (i >> 2) * (G >> 3);
      if (local >= per) return false;
      tile = (c & 7) * per + local;
    } else {
      tile = c + (i >> 2) * G;
      if (tile >= ntile) return false;
    }
    u.pm = tile >> 2; u.pn = ((i & 3) << 2) | (tile & 3); return true;
  }
  DI size_t a_off(const pg8::Unit& u) const {
    const int i = u.pn >> 2;
    const int ycol = (i == 0) ? A_G : (i == 1) ? B_G : (i == 2) ? C_G : D_G;
    return (size_t)ycol * 2;
  }
  DI void a_ready(const pg8::Unit&) const {}
  DI void done(const pg8::Unit&) const {}
};
DI unsigned z_touch(const bf16_t* Abase, const bf16_t* SG, int pm, int ct, int br, int tid) {
  const int ycol = (br == 0) ? A_G : (br == 1) ? B_G : (br == 2) ? C_G : D_G;
  const unsigned a = *(const unsigned*)(Abase + (size_t)(pm * 256 + 64 * ct + (tid >> 3)) * LDP + ycol + (tid & 7) * 64);
  const bf16_t* sgp = SG + (size_t)(pm * 256) * 4096 + br * 1024 + ct * 256;
  const unsigned g0 = *(const unsigned*)(sgp + (size_t)(tid >> 2) * 4096 + (tid & 3) * 64);
  const unsigned g1 = *(const unsigned*)(sgp + (size_t)(128 + (tid >> 2)) * 4096 + (tid & 3) * 64);
  return a ^ g0 ^ g1;
}
struct EpiZ2 {
  static constexpr bool PERM = true, AFTER_DRAIN = false;
  bf16_t* ACC; const bf16_t* SG;
  const bf16_t* Abase;
  DI void operator()(const pg8::f32x4 (&acc)[2][2][4][2], const pg8::Unit& u, int wr, int wc, int fr, int fq) const {
    const int br = u.pn >> 2;
    unsigned touched = 0;
    if (br < 3) touched = z_touch(Abase, SG, u.pm, u.pn & 3, br + 1, (wr * 4 + wc) * 64 + fq * 16 + fr);
    const int row0 = u.pm * 256 + wr * 64 + fr, col0 = (u.pn & 3) * 256 + wc * 32 + 8 * fq;
#pragma unroll
    for (int ai = 0; ai < 2; ++ai)
#pragma unroll
      for (int m = 0; m < 4; ++m) {
        const size_t row = (size_t)(row0 + ai * 128 + m * 16);
#pragma unroll
        for (int bj = 0; bj < 2; ++bj) {
          const int col = col0 + bj * 128;
          float g[8], a[8];
          unpack8(*(const uint4*)(SG + row * 4096 + br * 1024 + col), g);
          const pg8::f32x4 v0 = acc[ai][bj][m][0], v1 = acc[ai][bj][m][1];
          const float z[8] = {v0[0], v0[1], v0[2], v0[3], v1[0], v1[1], v1[2], v1[3]};
          if (br == 0) {
#pragma unroll
            for (int e = 0; e < 8; ++e) a[e] = g[e] * z[e];
          } else {
            unpack8(*(const uint4*)(ACC + row * 1024 + col), a);
#pragma unroll
            for (int e = 0; e < 8; ++e) a[e] += g[e] * z[e];
          }
          *(uint4*)(ACC + row * 1024 + col) = pack8(a);
        }
      }
    asm volatile("" :: "v"(touched));
  }
};
struct EpiZdry {
  static constexpr bool PERM = true, AFTER_DRAIN = false;
  bf16_t* ACC;
  DI void operator()(const pg8::f32x4 (&acc)[2][2][4][2], const pg8::Unit& u, int wr, int wc, int fr, int fq) const {
    const int row0 = u.pm * 256 + wr * 64 + fr, col0 = (u.pn & 3) * 256 + wc * 32 + 8 * fq;
#pragma unroll
    for (int ai = 0; ai < 2; ++ai)
#pragma unroll
      for (int m = 0; m < 4; ++m) {
        const size_t row = (size_t)(row0 + ai * 128 + m * 16);
#pragma unroll
        for (int bj = 0; bj < 2; ++bj) {
          const int col = col0 + bj * 128;
          const pg8::f32x4 v0 = acc[ai][bj][m][0], v1 = acc[ai][bj][m][1];
          const float z[8] = {v0[0], v0[1], v0[2], v0[3], v1[0], v1[1], v1[2], v1[3]};
          *(uint4*)(ACC + row * 1024 + col) = pack8(z);
        }
      }
  }
};
DI void z_stream(const Params& p, int l, int row0, int M, char* smem) {
#ifdef PROBE_ZDRY
  {
    EpiZdry E0; E0.ACC = (bf16_t*)(p.ws + OFF_ACC) + (size_t)row0 * 1024;
    pg8::Gemm g0; g0.A = (const bf16_t*)(p.ws + OFF_P) + (size_t)row0 * LDP; g0.Bt = (const bf16_t*)(p.ws + OFF_BRT) + (size_t)l * 4096 * 512;
    g0.M = M; g0.N = 4096; g0.K = 512; g0.lda = LDP;
    ZOrder S0; S0.ntile = (M >> 8) * 4; S0.G = (int)gridDim.x; S0.c = get_bid();
    __syncthreads();
    pg8::gemm_phase<EpiZdry, ZOrder, false>((PG8_LAS unsigned char*)smem, g0, S0, E0, nullptr);
    __syncthreads();
  }
#endif
  EpiZ2 E;
  E.ACC = (bf16_t*)(p.ws + OFF_ACC) + (size_t)row0 * 1024;
  E.SG = (const bf16_t*)(p.ws + OFF_SG) + (size_t)row0 * 4096;
  pg8::Gemm g; g.A = (const bf16_t*)(p.ws + OFF_P) + (size_t)row0 * LDP; g.Bt = (const bf16_t*)(p.ws + OFF_BRT) + (size_t)l * 4096 * 512;
  g.M = M; g.N = 4096; g.K = 512; g.lda = LDP;
  ZOrder S; S.ntile = (M >> 8) * 4; S.G = (int)gridDim.x; S.c = get_bid();
  E.Abase = g.A;
  {
    pg8::Unit u0;
    if (S.next(0, u0)) { const unsigned t0 = z_touch(E.Abase, E.SG, u0.pm, u0.pn & 3, 0, get_tid()); asm volatile("" :: "v"(t0)); }
  }
  __syncthreads();
  pg8::gemm_phase<EpiZ2, ZOrder, false>((PG8_LAS unsigned char*)smem, g, S, E, nullptr);
  __syncthreads();
}
DI void phase_z(const Params& p, int l, char* smem) {
  z_stream(p, l, 256, SEQ, smem);
  if (l == 0) z_stream(p, l, 0, 256, smem);
}

DI void phase_merge2(const Params& p, int l, int b, char* smem) {
  const bf16_t* ACC = (const bf16_t*)(p.ws + OFF_ACC);
  const bf16_t* W = (const bf16_t*)(p.ws + OFF_OUTT) + (size_t)l * 1024 * 1024;
  const float* modv = (const float*)(p.ws + OFF_MODV);
  EpiOut E;
  E.src = ((l == 0) ? p.in[I_X] : p.out) + (size_t)b * SEQ * 1024;
  E.dst = p.out + (size_t)b * SEQ * 1024;
  E.gt = modv + (l * 3 + b) * 3072 + 2048;
  run_gemm(smem, ACC + (size_t)256 * 1024, 1024, W, SEQ, 1024, 1024, E);
  if (l == 0) {
    E.src = p.in[I_CTX] + (size_t)b * 256 * 1024;
    E.dst = (float*)(p.ws + OFF_CX1) + (size_t)b * 256 * 1024;
    E.gt = modv + (l * 3 + 2) * 3072 + 2048;
    run_gemm(smem, ACC, 1024, W, 256, 1024, 1024, E);
  }
}

__global__ void __launch_bounds__(512) mk_forward(Params p, int ph_lo, int ph_hi) {
  __shared__ __attribute__((aligned(16))) char smem[158720];
  __shared__ int s_item;
  cg::grid_group grid = cg::this_grid();
#ifdef TMASK
  unsigned long long t_acc = 0;
#define TIMED(bit, call) do { if ((TMASK >> (bit)) & 1) { const unsigned long long t0_ = wall_clock64(); call; __syncthreads(); t_acc += wall_clock64() - t0_; } else { call; } } while (0)
#else
#define TIMED(bit, call) do { call; } while (0)
#endif
  for (int ph = ph_lo; ph < ph_hi; ++ph) {
    if (ph == 0) {
      if (PH_ON(9)) TIMED(10, phase_prep(p, smem));
    } else if (ph == 1) {
      if (PH_ON(0)) TIMED(0, phase_h(p, 0, 0));
    } else {
      const int q = ph - 2;
      const int lb = q / 8, k = q % 8 + 1;
      const int l = lb >> 1, b = lb & 1;
      if (k == 1) { if (PH_ON(1)) TIMED(1, phase_g1(p, l, smem)); }
      else if (k == 2) { if (PH_ON(2)) TIMED(2, phase_post(p, l, smem)); }
      else if (k == 3) { if (PH_ON(3)) TIMED(3, phase_mlaproj(p, l, smem)); }
      else if (k == 4) { if (PH_ON(4)) TIMED(4, phase_mlapost(p, l, smem)); }
      else if (k == 5) { if (PH_ON(5)) TIMED(5, phase_mix(p, l, lb, smem, &s_item)); }
      else if (k == 6) { if (PH_ON(6)) { TIMED(6, phase_fin(p, l)); TIMED(7, phase_gate(p, l, smem)); } }
      else if (k == 7) { if (PH_ON(7)) TIMED(8, phase_z(p, l, smem)); }
      else {
        if (PH_ON(8)) TIMED(9, phase_merge2(p, l, b, smem));
        if (lb < 3) { const int nl = (lb + 1) >> 1, nb = (lb + 1) & 1; if (PH_ON(0)) TIMED(0, phase_h(p, nl, nb)); }
      }
    }
    if (ph + 1 < ph_hi) grid.sync();
  }
#ifdef TMASK
  { const unsigned long long t0_ = wall_clock64(); while (wall_clock64() - t0_ < t_acc) { __builtin_amdgcn_s_sleep(8); } }
#endif
}

extern "C" void kernel_launch(void* const* d_in, const int* in_sizes, int n_in, void* d_out, int out_size, void* d_ws,
                              size_t ws_size, hipStream_t stream) {
  Params p{};
  for (int i = 0; i < 33; ++i) p.in[i] = (const float*)d_in[i];
  p.out = (float*)d_out;
  p.ws = (char*)d_ws;
  const int NPH = 2 + 4 * 8;
#if MULTI
  for (int ph = 0; ph < NPH; ++ph) {
    hipLaunchKernelGGL(mk_forward, dim3(256), dim3(512), 0, stream, p, ph, ph + 1);
  }
#else
  static int grid_blocks = 0;
  if (!grid_blocks) {
    int dev = 0, cus = 0, per_cu = 0;
    hipGetDevice(&dev);
    hipDeviceGetAttribute(&cus, hipDeviceAttributeMultiprocessorCount, dev);
    hipOccupancyMaxActiveBlocksPerMultiprocessor(&per_cu, mk_forward, 512, 0);
    if (per_cu < 1) per_cu = 1;
    grid_blocks = cus * per_cu;
  }
  int lo = 0, hi = NPH;
  void* args[] = {&p, &lo, &hi};
  hipError_t e = hipLaunchCooperativeKernel((void*)mk_forward, dim3(grid_blocks), dim3(512), args, 0, stream);
  if (e != hipSuccess) fprintf(stderr, "cooperative launch failed: %s (grid %d)\n", hipGetErrorString(e), grid_blocks);
#endif
}
```
